# Optimizing an MI355X kernel written in HIP

```python
import math
import jax, jax.numpy as jnp
from jax import lax
import numpy as np

D_MODEL = 1024
BATCH = 2
SEQ = 8192
DEPTH = 2
DEC_BATCH = 128
DEC_SEQ = 4
PAST_LEN = 2048
PAGE_SIZE = 128

N_EVEN = (DEPTH + 1) // 2
N_ODD = DEPTH // 2
PLE_DIM = 256
D_FF = 4 * D_MODEL
EPS = 1e-6
ROPE_THETA = 10000.0

POOL_WINDOWS = (2, 4, 8, 16)
POOL_GROUP = D_MODEL // 8
POOL_WIDTH = POOL_GROUP * len(POOL_WINDOWS)
POOL_STATE = max(POOL_WINDOWS) - 1
DIL_CFG = ((128, 1), (512, 4), (2048, 16))
B_HEADS = 8
B_HEAD_DIM = 64
B_WIDTH = B_HEADS * B_HEAD_DIM
ATT_BLOCK = 128
CHUNK = 128
C_GROUPS = 4
C_WIDTH = D_MODEL // 2
C_GROUP_DIM = C_WIDTH // C_GROUPS
CONV_W = 3
D_WIDTH = D_MODEL // 2

EV_IN = POOL_WIDTH + 3 * len(DIL_CFG) * B_WIDTH
EV_OUT = POOL_WIDTH + B_WIDTH
OD_IN = 2 * C_WIDTH + 3 * D_WIDTH
OD_OUT = C_WIDTH + D_WIDTH

kernel_name = "hybrid_pool_dilattn_gmlp_shortconv_step"


def rmsnorm(x, g):
    xf = x.astype(jnp.float32)
    y = xf * lax.rsqrt(jnp.mean(xf * xf, axis=-1, keepdims=True) + EPS)
    return (y * g.astype(jnp.float32)).astype(x.dtype)


def rope(x, pos):
    half = x.shape[-1] // 2
    inv = jnp.power(jnp.float32(ROPE_THETA), -jnp.arange(half, dtype=jnp.float32) / half)
    ang = pos.astype(jnp.float32)[:, None] * inv[None, :]
    cos = jnp.cos(ang)[None, :, None, :]
    sin = jnp.sin(ang)[None, :, None, :]
    xf = x.astype(jnp.float32)
    x1, x2 = xf[..., :half], xf[..., half:]
    return jnp.concatenate([x1 * cos - x2 * sin, x2 * cos + x1 * sin], axis=-1).astype(x.dtype)


def causal_pool_mix(ext, n_ctx, pos, pool_w, pool_scale):
    N, Le, _ = ext.shape
    L = Le - n_ctx
    xf = ext.astype(jnp.float32)
    csum = jnp.concatenate([jnp.zeros((N, 1, POOL_WIDTH), jnp.float32), jnp.cumsum(xf, axis=1)], axis=1)
    end = n_ctx + 1 + jnp.arange(L)
    outs = []
    for gi, w in enumerate(POOL_WINDOWS):
        sl = slice(gi * POOL_GROUP, (gi + 1) * POOL_GROUP)
        cg = csum[..., sl]
        wsum = cg[:, end] - cg[:, jnp.maximum(end - w, 0)]
        cnt = jnp.minimum(w, pos + 1).astype(jnp.float32)
        outs.append(wsum / cnt[None, :, None] - xf[:, n_ctx:, sl])
    pooled = jnp.stack(outs, axis=2)
    mixed = jnp.einsum('nlgc,gcd->nlgd', pooled, pool_w.astype(jnp.float32))
    return (mixed.reshape(N, L, POOL_WIDTH) * pool_scale.astype(jnp.float32)).astype(ext.dtype)


def dilated_attn_prompt(q, k, v, window, dil):
    N, S, H, Dh = q.shape
    span = window // dil
    unit = dil * ATT_BLOCK
    Sp = -(-S // unit) * unit
    M = Sp // dil
    nb = M // ATT_BLOCK

    def to_blocks(t):
        t = jnp.pad(t, ((0, 0), (0, Sp - S), (0, 0), (0, 0)))
        t = t.reshape(N, M, dil, H, Dh).transpose(0, 2, 1, 3, 4)
        return t.reshape(N, dil, nb, ATT_BLOCK, H, Dh)

    def with_prev(t):
        prev = jnp.pad(t, ((0, 0), (0, 0), (1, 0), (0, 0), (0, 0), (0, 0)))[:, :, :-1]
        return jnp.concatenate([prev, t], axis=3)

    qb = to_blocks(q)
    kk = with_prev(to_blocks(k))
    vv = with_prev(to_blocks(v))
    s = jnp.einsum('nrbqhd,nrbkhd->nrbhqk', qb, kk, preferred_element_type=jnp.float32) * (Dh ** -0.5)
    qi = jnp.arange(ATT_BLOCK)[:, None]
    ki = jnp.arange(2 * ATT_BLOCK)[None, :]
    rel = qi + ATT_BLOCK - ki
    blk = jnp.arange(nb)[:, None, None]
    valid = (rel >= 0) & (rel <= span) & (blk * ATT_BLOCK + ki - ATT_BLOCK >= 0)
    s = jnp.where(valid[:, None], s, -jnp.inf)
    m = jnp.max(s, axis=-1, keepdims=True)
    e = jnp.exp(s - m)
    l = jnp.sum(e, axis=-1, keepdims=True)
    o = jnp.einsum('nrbhqk,nrbkhd->nrbqhd', e / l, vv.astype(jnp.float32))
    lse = (m + jnp.log(l))[..., 0]
    o = o.reshape(N, dil, M, H, Dh).transpose(0, 2, 1, 3, 4).reshape(N, Sp, H, Dh)[:, :S]
    lse = lse.transpose(0, 1, 2, 4, 3).reshape(N, dil, M, H).transpose(0, 2, 1, 3).reshape(N, Sp, H)[:, :S]
    return o, lse


def dilated_attn_sample(q, k_new, v_new, kv_buf, window, dil):
    N, T, H, Dh = q.shape
    Lb = kv_buf.shape[1]
    span = window // dil
    kc = jnp.concatenate([kv_buf[:, :, 0].astype(k_new.dtype), k_new], axis=1)
    vc = jnp.concatenate([kv_buf[:, :, 1].astype(v_new.dtype), v_new], axis=1)
    idx = Lb + jnp.arange(T)[:, None] - dil * jnp.arange(span + 1)[None, :]
    valid = idx >= 0
    idx_c = jnp.maximum(idx, 0)
    kg = kc[:, idx_c]
    vg = vc[:, idx_c]
    s = jnp.einsum('nthd,ntjhd->nthj', q, kg, preferred_element_type=jnp.float32) * (Dh ** -0.5)
    s = jnp.where(valid[:, None, :], s, -jnp.inf)
    m = jnp.max(s, axis=-1, keepdims=True)
    e = jnp.exp(s - m)
    l = jnp.sum(e, axis=-1, keepdims=True)
    o = jnp.einsum('nthj,ntjhd->nthd', e / l, vg.astype(jnp.float32))
    return o, (m + jnp.log(l))[..., 0]


def even_mixer(h, pos, pool_ctx, kv_bufs, w_in, pool_w, pool_scale, w_out):
    N, L, _ = h.shape
    z = jnp.einsum('nld,de->nle', h, w_in)
    a = z[..., :POOL_WIDTH]
    qkv = z[..., POOL_WIDTH:].reshape(N, L, len(DIL_CFG), 3, B_HEADS, B_HEAD_DIM)
    if pool_ctx is None:
        ext, n_ctx = a, 0
    else:
        ext, n_ctx = jnp.concatenate([pool_ctx.astype(a.dtype), a], axis=1), pool_ctx.shape[1]
    ya = causal_pool_mix(ext, n_ctx, pos, pool_w, pool_scale)
    outs, lses, new_kv = [], [], []
    for g, (win, dil) in enumerate(DIL_CFG):
        q = rope(qkv[:, :, g, 0], pos)
        k = rope(qkv[:, :, g, 1], pos)
        v = qkv[:, :, g, 2]
        if kv_bufs is None:
            o, lse = dilated_attn_prompt(q, k, v, win, dil)
            keep = min(win, L)
            new_kv.append(jnp.stack([k[:, L - keep:], v[:, L - keep:]], axis=2))
        else:
            o, lse = dilated_attn_sample(q, k, v, kv_bufs[g], win, dil)
            new_kv.append(jnp.stack([k, v], axis=2))
        outs.append(o)
        lses.append(lse)
    wts = jax.nn.softmax(jnp.stack(lses, axis=0), axis=0)
    yb = jnp.einsum('gnlh,gnlhd->nlhd', wts, jnp.stack(outs, axis=0)).reshape(N, L, B_WIDTH).astype(h.dtype)
    y = jnp.einsum('nle,ed->nld', jnp.concatenate([ya, yb], axis=-1), w_out)
    return y, new_kv, ext[:, -POOL_STATE:]


def odd_mixer(h, pos, conv_ctx, is_prompt, w_in, ln_g, ln_b, ws, bs, conv_w, w_out):
    N, L, _ = h.shape
    z = jnp.einsum('nld,de->nle', h, w_in)
    u = jax.nn.gelu(z[..., :C_WIDTH])
    v = jax.nn.gelu(z[..., C_WIDTH:2 * C_WIDTH])
    vg = v.reshape(N, L, C_GROUPS, C_GROUP_DIM).astype(jnp.float32)
    mu = jnp.mean(vg, axis=-1, keepdims=True)
    var = jnp.mean(jnp.square(vg - mu), axis=-1, keepdims=True)
    vn = ((vg - mu) * lax.rsqrt(var + EPS)).reshape(N, L, C_WIDTH) * ln_g.astype(jnp.float32) + ln_b.astype(jnp.float32)
    vn = vn.astype(h.dtype)
    vn_g = vn.reshape(N, L, C_GROUPS, C_GROUP_DIM)
    w_mask = ws * jnp.tril(jnp.ones((CHUNK, CHUNK), ws.dtype))
    if is_prompt:
        vc = vn_g.reshape(N, L // CHUNK, CHUNK, C_GROUPS, C_GROUP_DIM)
        sp = jnp.einsum('gts,nksgc->nktgc', w_mask, vc) + bs.T[None, None, :, :, None]
        sp = sp.reshape(N, L, C_WIDTH)
    else:
        local = pos % CHUNK
        same = (pos[:, None] // CHUNK) == (pos[None, :] // CHUNK)
        mix = w_mask[:, local[:, None], local[None, :]] * same.astype(ws.dtype)
        sp = jnp.einsum('gts,nsgc->ntgc', mix, vn_g) + bs[:, local].T[None, :, :, None]
        sp = sp.reshape(N, L, C_WIDTH)
    yc = u * sp.astype(u.dtype)
    o0 = 2 * C_WIDTH
    g_out = z[..., o0:o0 + D_WIDTH]
    g_in = z[..., o0 + D_WIDTH:o0 + 2 * D_WIDTH]
    xin = z[..., o0 + 2 * D_WIDTH:]
    hd = g_in * xin
    ctx = jnp.zeros((N, CONV_W - 1, D_WIDTH), hd.dtype) if conv_ctx is None else conv_ctx.astype(hd.dtype)
    ext = jnp.concatenate([ctx, hd], axis=1)
    conv = sum(conv_w[j] * ext[:, j:j + L] for j in range(CONV_W))
    yd = g_out * conv
    y = jnp.einsum('nle,ed->nld', jnp.concatenate([yc, yd], axis=-1), w_out)
    return y, ext[:, -(CONV_W - 1):], vn


def setup_inputs(seed: int = 0) -> dict:
    key = jax.random.key(seed)
    ks = jax.random.split(key, 32)

    def nrm(i, shape, scale=1.0):
        return jax.random.normal(ks[i], shape, jnp.float32) * scale

    d = D_MODEL
    buf = [min(w, PAST_LEN) for w, _ in DIL_CFG]
    return {
        "x_prompt": nrm(0, (BATCH, SEQ, d)),
        "x_sample": nrm(1, (DEC_BATCH, DEC_SEQ, d)),
        "cache_kv_w128": nrm(2, (N_EVEN, DEC_BATCH, buf[0], 2, B_HEADS, B_HEAD_DIM)),
        "cache_kv_w512": nrm(3, (N_EVEN, DEC_BATCH, buf[1], 2, B_HEADS, B_HEAD_DIM)),
        "cache_kv_w2048": nrm(4, (N_EVEN, DEC_BATCH, buf[2], 2, B_HEADS, B_HEAD_DIM)),
        "state_pool": nrm(5, (N_EVEN, DEC_BATCH, POOL_STATE, POOL_WIDTH)),
        "state_conv": nrm(6, (N_ODD, DEC_BATCH, CONV_W - 1, D_WIDTH)),
        "p_prompt": nrm(7, (DEPTH, BATCH, SEQ, PLE_DIM)),
        "p_sample": nrm(8, (DEPTH, DEC_BATCH, DEC_SEQ, PLE_DIM)),
        "ev_w_in": nrm(9, (N_EVEN, d, EV_IN), d ** -0.5),
        "ev_pool_w": nrm(10, (N_EVEN, len(POOL_WINDOWS), POOL_GROUP, POOL_GROUP), POOL_GROUP ** -0.5),
        "ev_pool_scale": 1.0 + nrm(11, (N_EVEN, POOL_WIDTH), 0.01),
        "ev_w_out": nrm(12, (N_EVEN, EV_OUT, d), EV_OUT ** -0.5),
        "od_w_in": nrm(13, (N_ODD, d, OD_IN), d ** -0.5),
        "od_ln_g": 1.0 + nrm(14, (N_ODD, C_WIDTH), 0.01),
        "od_ln_b": nrm(15, (N_ODD, C_WIDTH), 0.01),
        "od_ws": nrm(16, (N_ODD, C_GROUPS, CHUNK, CHUNK), CHUNK ** -0.5),
        "od_bs": 1.0 + nrm(17, (N_ODD, C_GROUPS, CHUNK), 0.01),
        "od_conv_w": nrm(18, (N_ODD, CONV_W, D_WIDTH), CONV_W ** -0.5),
        "od_w_out": nrm(19, (N_ODD, OD_OUT, d), OD_OUT ** -0.5),
        "norm_mix": 1.0 + nrm(20, (DEPTH, d), 0.01),
        "norm_ffn": 1.0 + nrm(21, (DEPTH, d), 0.01),
        "norm_ple": 1.0 + nrm(22, (DEPTH, d), 0.01),
        "ffn_w1": nrm(23, (DEPTH, d, D_FF), d ** -0.5),
        "ffn_w2": nrm(24, (DEPTH, D_FF, d), D_FF ** -0.5),
        "ple_w_proj": nrm(25, (DEPTH, PLE_DIM, d), PLE_DIM ** -0.5),
        "ple_w_gate": nrm(26, (DEPTH, d, d), d ** -0.5),
        "norm_final": 1.0 + nrm(27, (d,), 0.01),
    }


def reference(x_prompt, x_sample, cache_kv_w128, cache_kv_w512, cache_kv_w2048, state_pool, state_conv,
              p_prompt, p_sample, ev_w_in, ev_pool_w, ev_pool_scale, ev_w_out, od_w_in, od_ln_g, od_ln_b,
              od_ws, od_bs, od_conv_w, od_w_out, norm_mix, norm_ffn, norm_ple, ffn_w1, ffn_w2,
              ple_w_proj, ple_w_gate, norm_final):
    def run(x, p, pos, cache_kv, st_pool, st_conv):
        is_prompt = cache_kv is None
        r = x
        new_kv = [[] for _ in DIL_CFG]
        new_pool, new_conv, new_cv = [], [], []
        for i in range(DEPTH):
            h = rmsnorm(r, norm_mix[i])
            if i % 2 == 0:
                e = i // 2
                bufs = None if is_prompt else tuple(c[e] for c in cache_kv)
                pctx = None if is_prompt else st_pool[e]
                y, kvs, pst = even_mixer(h, pos, pctx, bufs, ev_w_in[e], ev_pool_w[e], ev_pool_scale[e], ev_w_out[e])
                for g in range(len(DIL_CFG)):
                    new_kv[g].append(kvs[g])
                new_pool.append(pst)
            else:
                o = i // 2
                cctx = None if is_prompt else st_conv[o]
                y, cst, cv = odd_mixer(h, pos, cctx, is_prompt, od_w_in[o], od_ln_g[o], od_ln_b[o],
                                       od_ws[o], od_bs[o], od_conv_w[o], od_w_out[o])
                new_conv.append(cst)
                new_cv.append(cv)
            r = r + y
            h = rmsnorm(r, norm_ffn[i])
            r = r + jnp.einsum('nlf,fd->nld', jnp.square(jax.nn.relu(jnp.einsum('nld,df->nlf', h, ffn_w1[i]))), ffn_w2[i])
            h = rmsnorm(r, norm_ple[i])
            gate = jax.nn.sigmoid(jnp.einsum('nld,de->nle', h, ple_w_gate[i]))
            r = r + gate * jnp.einsum('nlp,pd->nld', p[i], ple_w_proj[i])
        out = rmsnorm(r, norm_final)
        kv_out = [jnp.stack(lst, axis=0) for lst in new_kv]
        return out, kv_out, jnp.stack(new_pool, axis=0), jnp.stack(new_conv, axis=0), jnp.stack(new_cv, axis=0)

    pos_p = jnp.arange(SEQ)
    pos_s = PAST_LEN + jnp.arange(DEC_SEQ)
    y_prompt, kv_p, pool_p, conv_p, _ = run(x_prompt, p_prompt, pos_p, None, None, None)
    y_sample, kv_s, pool_s, conv_s, cv_s = run(x_sample, p_sample, pos_s,
                                               (cache_kv_w128, cache_kv_w512, cache_kv_w2048),
                                               state_pool, state_conv)
    return (y_prompt, y_sample, kv_p[0], kv_p[1], kv_p[2], kv_s[0], kv_s[1], kv_s[2],
            pool_p, pool_s, conv_p, conv_s, cv_s)
```

```cpp
#include <hip/hip_runtime.h>
#include <cstdio>
#include <cstdint>
#include <cmath>
#define P3_PART 3
namespace pg8 {
#define PG8_LAS __attribute__((address_space(3)))
typedef unsigned short bf16_t;
typedef short bf16x8 __attribute__((ext_vector_type(8)));
typedef float f32x4 __attribute__((ext_vector_type(4)));
typedef unsigned u32x4 __attribute__((ext_vector_type(4)));
constexpr int BM = 256, BK = 64, HALF = 128, HTB = HALF * BK * 2  , STAGE_BYTES = 8 * HTB, NXCD = 8, WGM = 8;

__host__ __device__ __forceinline__ int lds_byte(int r, int c) { const int st = (r >> 4) * 2 + (c >> 5), rr = r & 15, cc = c & 31, ob = rr * 64 + cc * 2; return st * 1024 + (ob ^ (((ob >> 9) & 1) << 5)); }
__host__ __device__ __forceinline__ void stage_rc(int b, int& R, int& C) { const int st = b / 1024, sb = b % 1024, swz = sb ^ (((sb >> 9) & 1) << 5); R = (st >> 1) * 16 + swz / 64; C = (st & 1) * 32 + (swz % 64) / 2; }
__host__ __device__ __forceinline__ int perm32(int rho) { const int n = rho >> 4, i = rho & 15; return 8 * (i >> 2) + 4 * n + (i & 3); }

struct Unit { int pm, pn; };
struct Gemm { const bf16_t* A; const bf16_t* Bt; int M, N, K; };

struct StaticOrder {
    int nM, nN, nwg, G, c;
    __host__ __device__ void init(int M, int N, int G_, int c_) { nM = M / BM; nN = N / BM; nwg = nM * nN; G = G_; c = c_; }
    __host__ __device__ bool next(int i, Unit& u) const {
        const long L = (long)i * G + c; if (L >= nwg) return false;
        int wgid = (int)L; { const int q = nwg / NXCD, r = nwg % NXCD, xcd = wgid % NXCD, off = wgid / NXCD; wgid = (xcd < r ? xcd * (q + 1) : r * (q + 1) + (xcd - r) * q) + off; }
        const int nig = WGM * nN, gid = wgid / nig, fm = gid * WGM, gsz = (nM - fm) < WGM ? (nM - fm) : WGM;
        u.pm = fm + ((wgid % nig) % gsz); u.pn = (wgid % nig) / gsz; return true;
    }
    __device__ __forceinline__ void a_ready(const Unit&) const {}
    __device__ __forceinline__ void done(const Unit&) const {}
};

typedef float f32x2c __attribute__((ext_vector_type(2))); typedef __bf16 bf16x2c __attribute__((ext_vector_type(2)));
__device__ __forceinline__ unsigned cvt_pk_bf16(float lo, float hi) { const f32x2c v = {lo, hi}; return __builtin_bit_cast(unsigned, __builtin_convertvector(v, bf16x2c)); }
typedef float f32x2 __attribute__((ext_vector_type(2)));
typedef unsigned u32x2 __attribute__((ext_vector_type(2)));
constexpr int DM = 1024, SEQ = 8192, MP = 2 * SEQ, MS = 512, MALL = MP + MS;
constexpr int EVIN = 5120, ODIN = 2560, FFD = 4096;
constexpr float C2 = 0.125f * 1.4426950408889634f;
constexpr size_t O_YP = 0, O_YS = O_YP + (size_t)MP * DM, O_KVP0 = O_YS + (size_t)MS * DM, O_KVP1 = O_KVP0 + 2 * 128 * 1024, O_KVP2 = O_KVP1 + 2 * 512 * 1024,
                 O_KVS0 = O_KVP2 + 2 * 2048 * 1024, O_KVS1 = O_KVS0 + (size_t)MS * 1024, O_KVS2 = O_KVS1 + (size_t)MS * 1024, O_POOLP = O_KVS2 + (size_t)MS * 1024,
                 O_POOLS = O_POOLP + 2 * 15 * 512, O_CONVP = O_POOLS + 128 * 15 * 512, O_CONVS = O_CONVP + 2 * 2 * 512, O_CVS = O_CONVS + 128 * 2 * 512, O_END = O_CVS + (size_t)MS * 512;
static_assert(O_END == 25773056, "output size");

__device__ __forceinline__ float row_rs(const float* SS, int row) {
    const f32x4* p = (const f32x4*)(SS + (size_t)row * 16);
    const f32x4 a = p[0], b = p[1], c = p[2], d = p[3];
    const float s = (((a[0] + a[1]) + (a[2] + a[3])) + ((b[0] + b[1]) + (b[2] + b[3]))) + (((c[0] + c[1]) + (c[2] + c[3])) + ((d[0] + d[1]) + (d[2] + d[3])));
    return __builtin_amdgcn_rsqf(s * (1.0f / 1024.0f) + 1e-6f);
}
__device__ __forceinline__ u32x4 pack8(const f32x4 v0, const f32x4 v1) { u32x4 w; w.x = cvt_pk_bf16(v0[0], v0[1]); w.y = cvt_pk_bf16(v0[2], v0[3]); w.z = cvt_pk_bf16(v1[0], v1[1]); w.w = cvt_pk_bf16(v1[2], v1[3]); return w; }
__device__ __forceinline__ u32x2 pack4(const f32x4 v) { u32x2 w; w.x = cvt_pk_bf16(v[0], v[1]); w.y = cvt_pk_bf16(v[2], v[3]); return w; }
__device__ __forceinline__ float bf_lo(unsigned w) { return __builtin_bit_cast(float, w << 16); }
__device__ __forceinline__ float bf_hi(unsigned w) { return __builtin_bit_cast(float, w & 0xffff0000u); }

struct EpiEvIn {
    static constexpr bool PERM = false, AFTER_DRAIN = false;
    bf16_t* Z; const float* SS; const float* rope; float* out;
    __device__ __forceinline__ void operator()(const f32x4 (&acc)[2][2][4][2], const Unit& u, int wr_, int wc_, int fr_, int fq_) const {
        int wr = wr_, wc = wc_, fr = fr_, fq = fq_; asm volatile("" : "+s"(wr), "+s"(wc), "+v"(fr), "+v"(fq));
        const int pn = u.pn;
        const int part = pn < 2 ? 0 : (pn - 2) % 6, g = pn < 2 ? 0 : (pn - 2) / 6;
        const int kind = pn < 2 ? 3 : (part >> 1);
        const int hoff = (part & 1) * 4;
        const int keep = 128 << (2 * g);
        float* kvp = out + (g == 0 ? O_KVP0 : (g == 1 ? O_KVP1 : O_KVP2));
        float* kvs = out + (g == 0 ? O_KVS0 : (g == 1 ? O_KVS1 : O_KVS2));
#pragma unroll
        for (int ai = 0; ai < 2; ++ai)
#pragma unroll
            for (int m = 0; m < 4; ++m) {
                const int row = u.pm * BM + ai * HALF + wr * 64 + m * 16 + fr;
                const float rs = row_rs(SS, row);
                const bool samp = row >= MP; const int ms = row - MP;
                const int t = samp ? (ms & 3) : (row & (SEQ - 1));
                const int nb = samp ? (ms >> 2) : (row >> 13);
                bf16_t* zrow = Z + (size_t)row * EVIN + pn * BM;
                if (kind == 3) {
#pragma unroll
                    for (int bj = 0; bj < 2; ++bj)
#pragma unroll
                        for (int n = 0; n < 2; ++n) {
                            const int ct = bj * HALF + wc * 32 + n * 16 + 4 * fq; const f32x4 v = acc[ai][bj][m][n] * rs;
                            *(u32x2*)(zrow + ct) = pack4(v);
                            const int ch = pn * BM + ct;
                            if (samp) *(f32x4*)(out + O_POOLS + (size_t)(nb * 15 + 11 + t) * 512 + ch) = v;
                            else if (t >= SEQ - 15) *(f32x4*)(out + O_POOLP + (size_t)(nb * 15 + (t - (SEQ - 15))) * 512 + ch) = v;
                        }
                } else if (kind == 2) {
#pragma unroll
                    for (int bj = 0; bj < 2; ++bj)
#pragma unroll
                        for (int n = 0; n < 2; ++n) {
                            const int ct = bj * HALF + wc * 32 + n * 16 + 4 * fq; const f32x4 v = acc[ai][bj][m][n] * rs;
                            *(u32x2*)(zrow + ct) = pack4(v);
                            const int hd = hoff * 64 + ct;
                            if (samp) *(f32x4*)(kvs + ((size_t)ms * 2 + 1) * 512 + hd) = v;
                            else if (t >= SEQ - keep) *(f32x4*)(kvp + ((size_t)(nb * keep + (t - (SEQ - keep))) * 2 + 1) * 512 + hd) = v;
                        }
                } else {
                    const int pos = samp ? 2048 + t : t;
                    const int i0 = 16 * (wc & 1) + 4 * fq;
                    const f32x4* tp = (const f32x4*)(rope + ((size_t)pos * 32 + i0) * 2);
                    const f32x4 cs0 = tp[0], cs1 = tp[1];
                    const float sc = (kind == 0) ? C2 * rs : rs;
#pragma unroll
                    for (int bj = 0; bj < 2; ++bj) {
                        const f32x4 x1 = acc[ai][bj][m][0] * sc, x2 = acc[ai][bj][m][1] * sc;
                        f32x4 o1, o2;
                        o1[0] = x1[0] * cs0[0] - x2[0] * cs0[1]; o2[0] = x2[0] * cs0[0] + x1[0] * cs0[1];
                        o1[1] = x1[1] * cs0[2] - x2[1] * cs0[3]; o2[1] = x2[1] * cs0[2] + x1[1] * cs0[3];
                        o1[2] = x1[2] * cs1[0] - x2[2] * cs1[1]; o2[2] = x2[2] * cs1[0] + x1[2] * cs1[1];
                        o1[3] = x1[3] * cs1[2] - x2[3] * cs1[3]; o2[3] = x2[3] * cs1[2] + x1[3] * cs1[3];
                        const int hh = 2 * bj + (wc >> 1);
                        *(u32x2*)(zrow + hh * 64 + i0) = pack4(o1); *(u32x2*)(zrow + hh * 64 + 32 + i0) = pack4(o2);
                        if (kind == 1) {
                            const int hd = (hoff + hh) * 64 + i0;
                            if (samp) { float* p = kvs + ((size_t)ms * 2) * 512 + hd; *(f32x4*)p = o1; *(f32x4*)(p + 32) = o2; }
                            else if (t >= SEQ - keep) { float* p = kvp + ((size_t)(nb * keep + (t - (SEQ - keep))) * 2) * 512 + hd; *(f32x4*)p = o1; *(f32x4*)(p + 32) = o2; }
                        }
                    }
                }
            }
    }
};
struct EpiPlain {
    static constexpr bool PERM = true, AFTER_DRAIN = false;
    bf16_t* O; int ldc;
    __device__ __forceinline__ void operator()(const f32x4 (&acc)[2][2][4][2], const Unit& u, int wr_, int wc_, int fr_, int fq_) const {
        int wr = wr_, wc = wc_, fr = fr_, fq = fq_; asm volatile("" : "+s"(wr), "+s"(wc), "+v"(fr), "+v"(fq));
        const int col0 = u.pn * BM + wc * 32 + 8 * fq;
#pragma unroll
        for (int ai = 0; ai < 2; ++ai)
#pragma unroll
            for (int m = 0; m < 4; ++m) { bf16_t* rowp = O + (size_t)(u.pm * BM + ai * HALF + wr * 64 + m * 16 + fr) * ldc + col0;
#pragma unroll
                for (int bj = 0; bj < 2; ++bj) *(u32x4*)(rowp + bj * HALF) = pack8(acc[ai][bj][m][0], acc[ai][bj][m][1]); }
    }
};
template <int MODE> struct EpiScaled {
    static constexpr bool PERM = true, AFTER_DRAIN = false;
    bf16_t* O; int ldc; const float* SS;
    __device__ __forceinline__ void operator()(const f32x4 (&acc)[2][2][4][2], const Unit& u, int wr_, int wc_, int fr_, int fq_) const {
        int wr = wr_, wc = wc_, fr = fr_, fq = fq_; asm volatile("" : "+s"(wr), "+s"(wc), "+v"(fr), "+v"(fq));
        const int col0 = u.pn * BM + wc * 32 + 8 * fq; const bool act = (MODE == 0) || (u.pn < 4);
#pragma unroll
        for (int ai = 0; ai < 2; ++ai)
#pragma unroll
            for (int m = 0; m < 4; ++m) { const int row = u.pm * BM + ai * HALF + wr * 64 + m * 16 + fr; const float rs = row_rs(SS, row);
                bf16_t* rowp = O + (size_t)row * ldc + col0;
#pragma unroll
                for (int bj = 0; bj < 2; ++bj) { f32x4 v[2] = {acc[ai][bj][m][0] * rs, acc[ai][bj][m][1] * rs};
                    if (MODE == 0) {
#pragma unroll
                        for (int n = 0; n < 2; ++n)
#pragma unroll
                            for (int j = 0; j < 4; ++j) { const float x = __builtin_fmaxf(v[n][j], 0.f); v[n][j] = x * x; }
                    } else if (act) {
#pragma unroll
                        for (int n = 0; n < 2; ++n)
#pragma unroll
                            for (int j = 0; j < 4; ++j) { const float x = v[n][j]; const float uu = x * (0.7978845608028654f + 0.035677408136300125f * x * x);
                                v[n][j] = x * __builtin_amdgcn_rcpf(1.0f + __builtin_amdgcn_exp2f(-2.8853900817779268f * uu)); }
                    }
                    *(u32x4*)(rowp + bj * HALF) = pack8(v[0], v[1]); } }
    }
};
struct EpiResid {
    static constexpr bool PERM = true, AFTER_DRAIN = false;
    const float* baseP; const float* baseS; float* R; bf16_t* RB; float* SSo;
    __device__ __forceinline__ void operator()(const f32x4 (&acc)[2][2][4][2], const Unit& u, int wr_, int wc_, int fr_, int fq_) const {
        int wr = wr_, wc = wc_, fr = fr_, fq = fq_; asm volatile("" : "+s"(wr), "+s"(wc), "+v"(fr), "+v"(fq));
        const int col0 = u.pn * BM + wc * 32 + 8 * fq;
#pragma unroll
        for (int ai = 0; ai < 2; ++ai)
#pragma unroll
            for (int m = 0; m < 4; ++m) { const int row = u.pm * BM + ai * HALF + wr * 64 + m * 16 + fr;
                const float* bp = (row < MP ? baseP + (size_t)row * DM : baseS + (size_t)(row - MP) * DM) + col0;
                float sq = 0.f;
#pragma unroll
                for (int bj = 0; bj < 2; ++bj) { const f32x4 v0 = *(const f32x4*)(bp + bj * HALF) + acc[ai][bj][m][0], v1 = *(const f32x4*)(bp + bj * HALF + 4) + acc[ai][bj][m][1];
                    float* rp = R + (size_t)row * DM + col0 + bj * HALF; *(f32x4*)rp = v0; *(f32x4*)(rp + 4) = v1;
                    *(u32x4*)(RB + (size_t)row * DM + col0 + bj * HALF) = pack8(v0, v1);
                    sq += ((v0[0] * v0[0] + v0[1] * v0[1]) + (v0[2] * v0[2] + v0[3] * v0[3])) + ((v1[0] * v1[0] + v1[1] * v1[1]) + (v1[2] * v1[2] + v1[3] * v1[3])); }
                sq += __shfl_xor(sq, 16); sq += __shfl_xor(sq, 32);
                if (fq == 0) SSo[(size_t)row * 16 + u.pn * 4 + wc] = sq; }
    }
};
struct EpiPle {
    static constexpr bool PERM = true, AFTER_DRAIN = false;
    const float* SSi; const bf16_t* PROJ; float* R; bf16_t* RB; float* SSo;
    __device__ __forceinline__ void operator()(const f32x4 (&acc)[2][2][4][2], const Unit& u, int wr_, int wc_, int fr_, int fq_) const {
        int wr = wr_, wc = wc_, fr = fr_, fq = fq_; asm volatile("" : "+s"(wr), "+s"(wc), "+v"(fr), "+v"(fq));
        const int col0 = u.pn * BM + wc * 32 + 8 * fq;
#pragma unroll
        for (int ai = 0; ai < 2; ++ai)
#pragma unroll
            for (int m = 0; m < 4; ++m) { const int row = u.pm * BM + ai * HALF + wr * 64 + m * 16 + fr; const float rs = row_rs(SSi, row) * (-1.4426950408889634f);
                float sq = 0.f;
#pragma unroll
                for (int bj = 0; bj < 2; ++bj) { const size_t off = (size_t)row * DM + col0 + bj * HALF;
                    const u32x4 pj = *(const u32x4*)(PROJ + off); float* rp = R + off;
                    const f32x4 b0 = *(const f32x4*)rp, b1 = *(const f32x4*)(rp + 4);
                    const f32x4 a0 = acc[ai][bj][m][0] * rs, a1 = acc[ai][bj][m][1] * rs;
                    f32x4 g0, g1;
#pragma unroll
                    for (int j = 0; j < 4; ++j) { g0[j] = __builtin_amdgcn_rcpf(1.0f + __builtin_amdgcn_exp2f(a0[j])); g1[j] = __builtin_amdgcn_rcpf(1.0f + __builtin_amdgcn_exp2f(a1[j])); }
                    f32x4 v0, v1;
                    v0[0] = b0[0] + g0[0] * bf_lo(pj.x); v0[1] = b0[1] + g0[1] * bf_hi(pj.x); v0[2] = b0[2] + g0[2] * bf_lo(pj.y); v0[3] = b0[3] + g0[3] * bf_hi(pj.y);
                    v1[0] = b1[0] + g1[0] * bf_lo(pj.z); v1[1] = b1[1] + g1[1] * bf_hi(pj.z); v1[2] = b1[2] + g1[2] * bf_lo(pj.w); v1[3] = b1[3] + g1[3] * bf_hi(pj.w);
                    *(f32x4*)rp = v0; *(f32x4*)(rp + 4) = v1;
                    *(u32x4*)(RB + off) = pack8(v0, v1);
                    sq += ((v0[0] * v0[0] + v0[1] * v0[1]) + (v0[2] * v0[2] + v0[3] * v0[3])) + ((v1[0] * v1[0] + v1[1] * v1[1]) + (v1[2] * v1[2] + v1[3] * v1[3])); }
                sq += __shfl_xor(sq, 16); sq += __shfl_xor(sq, 32);
                if (fq == 0) SSo[(size_t)row * 16 + u.pn * 4 + wc] = sq; }
    }
};
template <class Epi, class Sched, bool ALIGN_EPI = false, bool SP2 = false>
__device__ __forceinline__ void gemm_phase(PG8_LAS unsigned char* lds, const Gemm g, const Sched& S, const Epi& E) {
    int tid_ = threadIdx.x; asm volatile("" : "+v"(tid_));
    const int tid = tid_, wid = __builtin_amdgcn_readfirstlane(tid >> 6), lane = tid & 63, wr = wid >> 2, wc = wid & 3, fr = lane & 15, fq = lane >> 4;
    int K_ = g.K; asm volatile("" : "+s"(K_));
    const int K = K_, nt = K / BK;
    unsigned voffA[2], voffB[2];
#pragma unroll
    for (int i = 0; i < 2; ++i) { int R, C; stage_rc(tid * 16 + i * 8192, R, C); const int Rb = Epi::PERM ? ((R & ~31) + perm32(R & 31)) : R;
        voffA[i] = (unsigned)(R * K + C) * 2u; voffB[i] = (unsigned)(Rb * K + C) * 2u; }
    const size_t kstep = (size_t)(BK * 2);
    const size_t hstep = (size_t)HALF * K * 2;
    const size_t tstep = 2 * hstep;
    const unsigned ldsw = (unsigned)wid * 1024u;
    const int aoff = lds_byte(wr * 64 + fr, fq * 8), boff = lds_byte(wc * 32 + fr, fq * 8);
#define PG8_SA(b, h) (((b) * 2 + (h)) * HTB)
#define PG8_SB(b, h) ((4 + (b) * 2 + (h)) * HTB)
#define PG8_STAGE(bufoff, gbase, voff) do { _Pragma("unroll") for (int _i = 0; _i < 2; ++_i) \
        __builtin_amdgcn_global_load_lds((const unsigned*)((const char*)(gbase) + (voff)[_i]), (PG8_LAS unsigned*)(lds + (bufoff) + ldsw + _i * 8192), 16, 0, 0); } while (0)
#define PG8_LDA(dst, b, h) do { _Pragma("unroll") for (int m = 0; m < 4; ++m) _Pragma("unroll") for (int k = 0; k < 2; ++k) dst[m][k] = *(const PG8_LAS bf16x8*)(lds + PG8_SA(b, h) + aoff + m * 2048 + k * 1024); } while (0)
#define PG8_LDB(dst, b, h) do { _Pragma("unroll") for (int n = 0; n < 2; ++n) _Pragma("unroll") for (int k = 0; k < 2; ++k) dst[n][k] = *(const PG8_LAS bf16x8*)(lds + PG8_SB(b, h) + boff + n * 2048 + k * 1024); } while (0)
#define PG8_MMA(ai, bj, At, Bt) do { __builtin_amdgcn_s_setprio(1); _Pragma("unroll") for (int m = 0; m < 4; ++m) _Pragma("unroll") for (int n = 0; n < 2; ++n) _Pragma("unroll") for (int k = 0; k < 2; ++k) \
        acc[ai][bj][m][n] = __builtin_amdgcn_mfma_f32_16x16x32_bf16(Bt[n][k], At[m][k], acc[ai][bj][m][n], 0, 0, 0); __builtin_amdgcn_s_setprio(0); } while (0)
#define PG8_WAIT_V(n) asm volatile("s_waitcnt vmcnt(" #n ")" ::: "memory")
#define PG8_WAIT_L(n) asm volatile("s_waitcnt lgkmcnt(" #n ")" ::: "memory")
#define PG8_BAR __builtin_amdgcn_s_barrier()
#define PG8_SCHED __builtin_amdgcn_sched_barrier(0)
    Unit cur, nxt; int ui = 0;
    if (!S.next(0, cur)) return;
    f32x4 acc[2][2][4][2];
#pragma unroll
    for (int a = 0; a < 2; ++a)
#pragma unroll
        for (int b = 0; b < 2; ++b)
#pragma unroll
            for (int m = 0; m < 4; ++m)
#pragma unroll
                for (int n = 0; n < 2; ++n) acc[a][b][m][n] = (f32x4){0.f, 0.f, 0.f, 0.f};
    bf16x8 At[4][2], B0[2][2], B1[2][2];
    const char* cA = (const char*)g.A + (size_t)cur.pm * tstep; const char* cB = (const char*)g.Bt + (size_t)cur.pn * tstep;
    S.a_ready(cur);
    if constexpr (SP2) {
        PG8_STAGE(PG8_SB(0, 0), cB, voffB); PG8_STAGE(PG8_SB(0, 1), cB + hstep, voffB); PG8_STAGE(PG8_SA(0, 0), cA, voffA); PG8_STAGE(PG8_SA(0, 1), cA + hstep, voffA);
        if (wr == 1) PG8_BAR;
        PG8_WAIT_V(2); PG8_BAR;
        PG8_STAGE(PG8_SB(1, 0), cB + kstep, voffB); PG8_STAGE(PG8_SA(1, 0), cA + kstep, voffA); PG8_STAGE(PG8_SB(1, 1), cB + hstep + kstep, voffB);
        PG8_WAIT_V(6); PG8_BAR;
    } else {
        PG8_STAGE(PG8_SB(0, 0), cB, voffB); PG8_STAGE(PG8_SA(0, 0), cA, voffA); PG8_STAGE(PG8_SB(0, 1), cB + hstep, voffB); PG8_STAGE(PG8_SA(0, 1), cA + hstep, voffA);
        if (wr == 1) PG8_BAR;
        PG8_WAIT_V(4); PG8_BAR;
        PG8_STAGE(PG8_SB(1, 0), cB + kstep, voffB); PG8_STAGE(PG8_SA(1, 0), cA + kstep, voffA); PG8_STAGE(PG8_SB(1, 1), cB + hstep + kstep, voffB);
        PG8_WAIT_V(6); PG8_BAR;
    }
    for (;;) {
        const bool has_next = S.next(ui + 1, nxt);
        const char* nA = has_next ? (const char*)g.A + (size_t)nxt.pm * tstep : cA; const char* nB = has_next ? (const char*)g.Bt + (size_t)nxt.pn * tstep : cB;
        for (int t = 0; t < nt; t += 2) {
            const bool last = (t == nt - 2);
            const char* a1 = cA + (size_t)(t + 1) * kstep;
            const char* a2 = last ? nA : cA + (size_t)(t + 2) * kstep; const char* b2 = last ? nB : cB + (size_t)(t + 2) * kstep;
            const char* a3 = a2 + kstep; const char* b3 = b2 + kstep;
            if (last && has_next) S.a_ready(nxt);
            if constexpr (SP2) {
            PG8_LDB(B0, 0, 0); PG8_LDB(B1, 0, 1); PG8_SCHED; PG8_LDA(At, 0, 0); PG8_STAGE(PG8_SA(1, 1), a1 + hstep, voffA);
            PG8_WAIT_V(8); PG8_WAIT_L(0); PG8_BAR; PG8_MMA(0, 0, At, B0); PG8_MMA(0, 1, At, B1); PG8_BAR; PG8_SCHED;
            PG8_LDA(At, 0, 1); PG8_STAGE(PG8_SB(0, 0), b2, voffB); PG8_STAGE(PG8_SB(0, 1), b2 + hstep, voffB); PG8_STAGE(PG8_SA(0, 0), a2, voffA);
            PG8_WAIT_V(8); PG8_WAIT_L(0); PG8_BAR; PG8_MMA(1, 0, At, B0); PG8_MMA(1, 1, At, B1); PG8_BAR; PG8_SCHED;
            PG8_LDB(B0, 1, 0); PG8_LDB(B1, 1, 1); PG8_SCHED; PG8_LDA(At, 1, 0); PG8_STAGE(PG8_SA(0, 1), a2 + hstep, voffA);
            PG8_WAIT_V(8); PG8_WAIT_L(0); PG8_BAR; PG8_MMA(0, 0, At, B0); PG8_MMA(0, 1, At, B1); PG8_BAR; PG8_SCHED;
            PG8_LDA(At, 1, 1); PG8_STAGE(PG8_SB(1, 0), b3, voffB); PG8_STAGE(PG8_SB(1, 1), b3 + hstep, voffB); PG8_STAGE(PG8_SA(1, 0), a3, voffA);
            PG8_WAIT_V(8); PG8_WAIT_L(0); PG8_BAR; PG8_MMA(1, 0, At, B0); PG8_MMA(1, 1, At, B1); PG8_BAR; PG8_SCHED;
            } else {
            PG8_LDB(B0, 0, 0); PG8_SCHED; PG8_LDA(At, 0, 0); PG8_STAGE(PG8_SA(1, 1), a1 + hstep, voffA);
            PG8_WAIT_L(8); PG8_BAR; PG8_WAIT_L(0); PG8_MMA(0, 0, At, B0); PG8_BAR; PG8_SCHED;
            PG8_LDB(B1, 0, 1); PG8_STAGE(PG8_SB(0, 0), b2, voffB);
            PG8_BAR; PG8_WAIT_L(0); PG8_MMA(0, 1, At, B1); PG8_BAR;
            PG8_LDA(At, 0, 1); PG8_STAGE(PG8_SA(0, 0), a2, voffA);
            PG8_BAR; PG8_WAIT_L(0); PG8_MMA(1, 0, At, B0); PG8_BAR; PG8_SCHED;
            PG8_STAGE(PG8_SB(0, 1), b2 + hstep, voffB);
            PG8_WAIT_V(6); PG8_BAR; PG8_MMA(1, 1, At, B1); PG8_BAR;
            PG8_LDB(B0, 1, 0); PG8_SCHED; PG8_LDA(At, 1, 0); PG8_STAGE(PG8_SA(0, 1), a2 + hstep, voffA);
            PG8_WAIT_L(8); PG8_BAR; PG8_WAIT_L(0); PG8_MMA(0, 0, At, B0); PG8_BAR; PG8_SCHED;
            PG8_LDB(B1, 1, 1); PG8_STAGE(PG8_SB(1, 0), b3, voffB);
            PG8_BAR; PG8_WAIT_L(0); PG8_MMA(0, 1, At, B1); PG8_BAR;
            PG8_LDA(At, 1, 1); PG8_STAGE(PG8_SA(1, 0), a3, voffA);
            PG8_BAR; PG8_WAIT_L(0); PG8_MMA(1, 0, At, B0); PG8_BAR; PG8_SCHED;
            PG8_STAGE(PG8_SB(1, 1), b3 + hstep, voffB);
            PG8_WAIT_V(6); PG8_BAR; PG8_MMA(1, 1, At, B1); PG8_BAR;
            }
        }
        if constexpr (ALIGN_EPI) { if (wr == 0) PG8_BAR; }
        if constexpr (!Epi::AFTER_DRAIN) { E(acc, cur, wr, wc, fr, fq); S.done(cur); }
        if (!has_next) break;
#pragma unroll
        for (int a = 0; a < 2; ++a)
#pragma unroll
            for (int b = 0; b < 2; ++b)
#pragma unroll
                for (int m = 0; m < 4; ++m)
#pragma unroll
                    for (int n = 0; n < 2; ++n) acc[a][b][m][n] = (f32x4){0.f, 0.f, 0.f, 0.f};
        cur = nxt; cA = nA; cB = nB; ++ui;
        if constexpr (ALIGN_EPI) { if (wr == 1) PG8_BAR; }
    }
    PG8_WAIT_V(0);
    if constexpr (!ALIGN_EPI) { if (wr == 0) PG8_BAR; }
    PG8_BAR;
    if constexpr (Epi::AFTER_DRAIN) { E.fused(acc, cur, wr, wc, fr, fq, lds, wid, lane); S.done(cur); }
#undef PG8_SA
#undef PG8_SB
#undef PG8_STAGE
#undef PG8_LDA
#undef PG8_LDB
#undef PG8_MMA
#undef PG8_WAIT_V
#undef PG8_WAIT_L
#undef PG8_BAR
#undef PG8_SCHED
}
}
#define GAS __attribute__((address_space(1)))
#define LAS __attribute__((address_space(3)))
typedef unsigned short bf16;
typedef unsigned v4u __attribute__((ext_vector_type(4)));
typedef float f32x4 __attribute__((ext_vector_type(4)));
typedef short bf16x8 __attribute__((ext_vector_type(8)));
typedef GAS unsigned gu32;
typedef GAS unsigned long long gu64;
#define RLX_AGENT __ATOMIC_RELAXED, __HIP_MEMORY_SCOPE_AGENT
#define LDS_WAIT() asm volatile("s_waitcnt lgkmcnt(0)" ::: "memory")
#define VM_WAIT() asm volatile("s_waitcnt vmcnt(0)" ::: "memory")
__device__ __forceinline__ unsigned long long rt() { return __builtin_amdgcn_s_memrealtime(); }
__device__ __forceinline__ unsigned f2bf(float f) { unsigned u = __builtin_bit_cast(unsigned, f); return (u + 0x7fffu + ((u >> 16) & 1u)) >> 16; }
__device__ __forceinline__ unsigned pk2(float lo, float hi) { return f2bf(lo) | (f2bf(hi) << 16); }
#define XB_TMO      128
#define XB_XCNT(j)  (256  + 64 * (j))
#define XB_XSUB(j)  (1280 + 64 * (j))
#define XB_XGEN(j)  (2304 + 64 * (j))
#define XB_TOP      3328
#define XB_TOPGEN   3392
#define XCD_BAR_WORDS 3456
#define XB_SPIN_CAP (1u << 18)

__device__ __forceinline__ unsigned xb_ld(unsigned* p)              { return __hip_atomic_load(p, __ATOMIC_RELAXED, __HIP_MEMORY_SCOPE_AGENT); }
__device__ __forceinline__ unsigned xb_add(unsigned* p, unsigned v) { return __hip_atomic_fetch_add(p, v, __ATOMIC_RELAXED, __HIP_MEMORY_SCOPE_AGENT); }
__device__ __forceinline__ unsigned xb_xcc_id() { return (unsigned)__builtin_amdgcn_s_getreg((3 << 11) | 20) & 0xFu; }
#define XB_SPIN(cond, bar) do { unsigned _sp = 0; while (cond) { __builtin_amdgcn_s_sleep(1); \
    if ((++_sp & 255u) == 0u) { if (xb_ld(&(bar)[XB_TMO])) break; if (_sp > XB_SPIN_CAP) { atomicAdd(&(bar)[XB_TMO], 1u); break; } } } } while (0)

struct XcdBarrier {
    unsigned* bar; unsigned x;
    volatile LAS unsigned* st;
};

__device__ __forceinline__ XcdBarrier xcd_barrier_post(unsigned* bar, volatile LAS unsigned* st) {
    XcdBarrier b; b.bar = bar; b.x = xb_xcc_id(); b.st = st;
    if (threadIdx.x == 0) (void)xb_add(&bar[XB_XCNT(b.x)], 1u);
    return b;
}
__device__ __forceinline__ void xcd_barrier_complete(unsigned* bar, unsigned x, unsigned& nloc, unsigned& nx) {
    const unsigned G = gridDim.x * gridDim.y * gridDim.z;
    unsigned sum, cnt, mine, sp = 0u;
    for (;;) {
        sum = 0u; cnt = 0u; mine = 0u;
#pragma unroll
        for (unsigned j = 0; j < 16; ++j) { const unsigned c = xb_ld(&bar[XB_XCNT(j)]); sum += c; cnt += (c > 0u) ? 1u : 0u; mine = (j == x) ? c : mine; }
        if (sum == G) break;
        __builtin_amdgcn_s_sleep(1);
        if ((++sp & 255u) == 0u) { if (xb_ld(&bar[XB_TMO])) break; if (sp > XB_SPIN_CAP) { atomicAdd(&bar[XB_TMO], 1u); break; } }
    }
    nloc = mine > 0u ? mine : 1u; nx = cnt > 0u ? cnt : 1u;
}

__device__ __forceinline__ void xcd_barrier(const XcdBarrier& b) {
    asm volatile("s_waitcnt vmcnt(0)" ::: "memory");
    __syncthreads();
    if (threadIdx.x == 0) {
        unsigned* bar = b.bar;
        __builtin_amdgcn_s_waitcnt(0);
        unsigned nloc = b.st[0], nx = b.st[1];
        if (nloc == 0u) { xcd_barrier_complete(bar, b.x, nloc, nx); b.st[0] = nloc; b.st[1] = nx; }
        const unsigned old = xb_add(&bar[XB_XSUB(b.x)], 1u);
        const unsigned gen = old / nloc;
        if (old + 1u == (gen + 1u) * nloc) {
            __builtin_amdgcn_fence(__ATOMIC_RELEASE, "agent");
            asm volatile("s_waitcnt vmcnt(0)" ::: "memory");
            const unsigned og = xb_add(&bar[XB_TOP], 1u);
            const unsigned tg = og / nx;
            if (og + 1u == (tg + 1u) * nx) xb_add(&bar[XB_TOPGEN], 1u);
            else XB_SPIN(xb_ld(&bar[XB_TOPGEN]) == tg, bar);
            __builtin_amdgcn_fence(__ATOMIC_ACQUIRE, "agent");
            xb_add(&bar[XB_XGEN(b.x)], 1u);
            asm volatile("s_waitcnt vmcnt(0)" ::: "memory");
        } else {
            XB_SPIN(xb_ld(&bar[XB_XGEN(b.x)]) == gen, bar);
            __builtin_amdgcn_fence(__ATOMIC_ACQUIRE, "agent");
            asm volatile("s_waitcnt vmcnt(0)" ::: "memory");
        }
    }
    __syncthreads();
}
using pg8::MP; using pg8::MS; using pg8::MALL; using pg8::DM; using pg8::SEQ; using pg8::EVIN; using pg8::ODIN; using pg8::FFD;
typedef unsigned u32x2 __attribute__((ext_vector_type(2)));
typedef short v4i16_t __attribute__((ext_vector_type(4)));
constexpr int NWAVES = 8;
constexpr size_t MiB = 1u << 20;
constexpr size_t WS_CTL = 0, CTL_ZERO_BYTES = 1 * MiB;
constexpr size_t WS_WEVIN = 2 * MiB, WS_WEVOUT = 12 * MiB, WS_WODIN = 14 * MiB, WS_WODOUT = 19 * MiB, WS_W1 = 21 * MiB  , WS_W2 = 37 * MiB  , WS_WG = 53 * MiB  ,
                 WS_WP = 57 * MiB  , WS_POOLW = 58 * MiB, WS_WST = 58 * MiB + 256 * 1024, WS_ROPE = 59 * MiB  , WS_SS = 81 * MiB  ;
constexpr size_t WS_PB = 64 * MiB  , WS_R = 84 * MiB  , WS_RB = 150 * MiB  , WS_YAB = 216 * MiB  , WS_PROJ = 249 * MiB  , WS_Z = 282 * MiB  ,
                 WS_F = 447 * MiB  , WS_OG = 579 * MiB  , WS_LSE = 629 * MiB  , WS_END = 632 * MiB;
static_assert(WS_PB + 2 * (size_t)MALL * 256 * 2 <= WS_R && WS_R + (size_t)MALL * DM * 4 <= WS_RB && WS_RB + 2 * (size_t)MALL * DM * 2 <= WS_YAB && WS_Z + (size_t)MALL * EVIN * 2 <= WS_F &&
              WS_F + (size_t)MALL * FFD * 2 <= WS_OG && WS_OG + 3 * (size_t)MALL * 512 * 2 <= WS_LSE && WS_LSE + 3 * (size_t)MALL * 8 * 4 <= WS_END && WS_ROPE + 8196 * 64 * 4 <= WS_PB &&
              WS_SS + 2 * (size_t)MALL * 16 * 4 <= WS_R && WS_PB + 2 * (size_t)MALL * 256 * 2 <= WS_SS, "d_ws map");
constexpr int CW_BAR = 4096;
constexpr int RING_BYTES = 131072, LDSCTL_OFF = RING_BYTES, MISC_OFF = LDSCTL_OFF + 320, LDS_BYTES = 147456;
constexpr int KVS = 144;
constexpr int ATT_K = 0, ATT_V = 272 * KVS, ATT_SC = 2 * 272 * KVS;
constexpr int VNS = 272;

struct Args { const float* in[28]; float* out; unsigned char* ws; int ph_lo, ph_hi, dump, pad; };
struct Frame {
    LAS unsigned char* lds; volatile LAS unsigned* MISC; gu32* ctl;
    int tid, lane, wave, vcu, G;
    float* out; unsigned char* ws;
};
__device__ __forceinline__ float wave_sum(float v) {
#pragma unroll
    for (int o = 1; o < 64; o <<= 1) v += __shfl_xor(v, o);
    return v;
}
__device__ __forceinline__ float wave_max(float v) {
#pragma unroll
    for (int o = 1; o < 64; o <<= 1) v = __builtin_fmaxf(v, __shfl_xor(v, o));
    return v;
}
__device__ __forceinline__ unsigned cvtpk(float lo, float hi) { return pg8::cvt_pk_bf16(lo, hi); }
__device__ __forceinline__ float bflo(unsigned w) { return __builtin_bit_cast(float, w << 16); }
__device__ __forceinline__ float bfhi(unsigned w) { return __builtin_bit_cast(float, w & 0xffff0000u); }
__device__ __forceinline__ f32x4 mfma16(bf16x8 a, bf16x8 b, f32x4 c) { return __builtin_amdgcn_mfma_f32_16x16x32_bf16(a, b, c, 0, 0, 0); }
__device__ __forceinline__ v4i16_t trread(LAS const unsigned char* p) { return __builtin_amdgcn_ds_read_tr16_b64_v4i16((LAS v4i16_t*)p); }

__device__ __forceinline__ void relaunder(Frame& F) { int t = threadIdx.x; asm volatile("" : "+v"(t)); F.tid = t; F.lane = t & 63; F.wave = __builtin_amdgcn_readfirstlane(t >> 6); }
__device__ __forceinline__ void p0_transpose_item(const float* W, int K, int N, bf16* WT, const float* gain, int mode, LAS float* scr, int item, int lane) {
    const int nblk = N / 32, kb = item / nblk, nb = item % nblk, k0 = 64 * kb, n0 = 32 * nb, nl = lane & 31;
    int srcc = n0 + nl;
    if (mode == 1 && n0 >= 512 && ((n0 - 512) % 1536) < 1024) srcc = (n0 & ~63) + 16 * ((n0 >> 5) & 1) + (nl & 15) + 32 * (nl >> 4);
#pragma unroll 8
    for (int i = 0; i < 32; ++i) { const int kk = 2 * i + (lane >> 5); const float gsc = gain ? gain[k0 + kk] : 1.0f; scr[kk * 33 + nl] = W[(size_t)(k0 + kk) * N + srcc] * gsc; }
    LDS_WAIT(); asm volatile("" ::: "memory");
    const int c = lane & 7;
#pragma unroll
    for (int j = 0; j < 4; ++j) { const int n = (lane >> 3) + 8 * j; const LAS float* s = scr + (8 * c) * 33 + n;
        v4u o; o.x = cvtpk(s[0 * 33], s[1 * 33]); o.y = cvtpk(s[2 * 33], s[3 * 33]); o.z = cvtpk(s[4 * 33], s[5 * 33]); o.w = cvtpk(s[6 * 33], s[7 * 33]);
        *(GAS v4u*)(WT + (size_t)(n0 + n) * K + k0 + 8 * c) = o; }
    LDS_WAIT(); asm volatile("" ::: "memory");
}
__device__ __forceinline__ void p0_prologue(Frame& F, const Args& A) {
    LAS float* scr = (LAS float*)(F.lds + F.wave * 16384);
    const int gw = F.vcu * NWAVES + F.wave, NGW = F.G * NWAVES;
    unsigned char* ws = F.ws;
    constexpr int I_EVIN = 16 * 160, I_SQ = 16 * 32, I_ODIN = 16 * 80, I_W1 = 16 * 128, I_W2 = 64 * 32, I_WP = 4 * 32;
    constexpr int NITEMS = I_EVIN + 2 * I_SQ + I_ODIN + 2 * I_W1 + 2 * I_W2 + 2 * I_SQ + 2 * I_WP;
    for (int it = gw; it < NITEMS; it += NGW) {
        int r = it;
        if (r < I_EVIN) { p0_transpose_item(A.in[9], 1024, EVIN, (bf16*)(ws + WS_WEVIN), A.in[20], 1, scr, r, F.lane); continue; } r -= I_EVIN;
        if (r < I_SQ) { p0_transpose_item(A.in[12], 1024, 1024, (bf16*)(ws + WS_WEVOUT), nullptr, 0, scr, r, F.lane); continue; } r -= I_SQ;
        if (r < I_ODIN) { p0_transpose_item(A.in[13], 1024, ODIN, (bf16*)(ws + WS_WODIN), A.in[20] + 1024, 0, scr, r, F.lane); continue; } r -= I_ODIN;
        if (r < I_SQ) { p0_transpose_item(A.in[19], 1024, 1024, (bf16*)(ws + WS_WODOUT), nullptr, 0, scr, r, F.lane); continue; } r -= I_SQ;
        if (r < 2 * I_W1) { const int L = r / I_W1; p0_transpose_item(A.in[23] + (size_t)L * 1024 * FFD, 1024, FFD, (bf16*)(ws + WS_W1) + (size_t)L * 1024 * FFD, A.in[21] + L * 1024, 0, scr, r % I_W1, F.lane); continue; } r -= 2 * I_W1;
        if (r < 2 * I_W2) { const int L = r / I_W2; p0_transpose_item(A.in[24] + (size_t)L * 1024 * FFD, FFD, 1024, (bf16*)(ws + WS_W2) + (size_t)L * 1024 * FFD, nullptr, 0, scr, r % I_W2, F.lane); continue; } r -= 2 * I_W2;
        if (r < 2 * I_SQ) { const int L = r / I_SQ; p0_transpose_item(A.in[26] + (size_t)L * 1024 * 1024, 1024, 1024, (bf16*)(ws + WS_WG) + (size_t)L * 1024 * 1024, A.in[22] + L * 1024, 0, scr, r % I_SQ, F.lane); continue; } r -= 2 * I_SQ;
        { const int L = r / I_WP; p0_transpose_item(A.in[25] + (size_t)L * 256 * 1024, 256, 1024, (bf16*)(ws + WS_WP) + (size_t)L * 256 * 1024, nullptr, 0, scr, r % I_WP, F.lane); }
    }
    {
        bf16* RB0 = (bf16*)(ws + WS_RB); float* SS0 = (float*)(ws + WS_SS);
        for (int m = gw; m < MALL; m += NGW) {
            const float* xrow = m < MP ? A.in[0] + (size_t)m * DM : A.in[1] + (size_t)(m - MP) * DM;
            const GAS f32x4* xr = (const GAS f32x4*)xrow + F.lane; f32x4 v[4]; float s = 0.f;
#pragma unroll
            for (int j = 0; j < 4; ++j) { v[j] = xr[64 * j]; s += (v[j][0] * v[j][0] + v[j][1] * v[j][1]) + (v[j][2] * v[j][2] + v[j][3] * v[j][3]); }
            s = wave_sum(s);
            GAS u32x2* o8 = (GAS u32x2*)(RB0 + (size_t)m * DM) + F.lane;
#pragma unroll
            for (int j = 0; j < 4; ++j) { u32x2 w; w.x = cvtpk(v[j][0], v[j][1]); w.y = cvtpk(v[j][2], v[j][3]); o8[64 * j] = w; }
            if (F.lane < 16) SS0[(size_t)m * 16 + F.lane] = F.lane == 0 ? s : 0.f;
        }
    }
    const int gt = gw * 64 + F.lane, NT = NGW * 64;
    { bf16* PB = (bf16*)(ws + WS_PB);
      for (int i = gt; i < 2 * MALL * 64; i += NT) { const int L = i / (MALL * 64), rem = i % (MALL * 64), row = rem >> 6, c4 = rem & 63;
          const float* src = row < MP ? A.in[7] + ((size_t)L * MP + row) * 256 + c4 * 4 : A.in[8] + ((size_t)L * MS + (row - MP)) * 256 + c4 * 4;
          const f32x4 v = *(const GAS f32x4*)src; u32x2 w; w.x = cvtpk(v[0], v[1]); w.y = cvtpk(v[2], v[3]);
          *(GAS u32x2*)(PB + ((size_t)L * MALL + row) * 256 + c4 * 4) = w; } }
    { float* tab = (float*)(ws + WS_ROPE);
      for (int i = gt; i < 8196 * 32; i += NT) { const int pos = i >> 5, k = i & 31;
          const float inv = (float)exp2(-(double)k * (13.287712379549449 / 32.0));
          const float ang = (float)pos * inv;
          const double rev = (double)ang * 0.15915494309189535; const float fr = (float)(rev - rint(rev));
          tab[2 * i] = __builtin_amdgcn_cosf(fr); tab[2 * i + 1] = __builtin_amdgcn_sinf(fr); } }
    { bf16* PW = (bf16*)(ws + WS_POOLW); bf16* WT = (bf16*)(ws + WS_WST);
      for (int i = gt; i < 4 * 128 * 128; i += NT) { const int g = i >> 14, d = (i >> 7) & 127, c = i & 127;
          PW[i] = (bf16)(cvtpk(A.in[10][(g * 128 + c) * 128 + d] * A.in[11][g * 128 + d], 0.f) & 0xffffu);
          const int t = d, s = c; WT[i] = (bf16)(cvtpk(s <= t ? A.in[16][i] : 0.f, 0.f) & 0xffffu); } }
    { for (int i = gt; i < 128 * 11 * 128; i += NT) { const int n = i / (11 * 128), rem = i % (11 * 128), j = rem >> 7, c4 = rem & 127;
          *(GAS f32x4*)(F.out + pg8::O_POOLS + ((size_t)(n * 15 + j) * 512 + c4 * 4)) = *(const GAS f32x4*)(A.in[5] + ((size_t)(n * 15 + j + 4) * 512 + c4 * 4)); } }
}

__device__ __forceinline__ void attn_prompt_unit(Frame& F, const Args& A, int u) {
    const int rb = u & 63, h = (u >> 6) & 7, ng = u >> 9, g = ng % 3, n = ng / 3;
    const int dsh = 2 * g, nbk = 64 >> dsh, r = rb >> (6 - dsh), b = rb & (nbk - 1);
    const size_t rowbase = (size_t)n * SEQ;
    const bf16* Z = (const bf16*)(F.ws + WS_Z);
    const int colQ = 512 + g * 1536 + h * 64, colK = colQ + 512, colV = colQ + 1024;
    LAS unsigned char* lds = F.lds;
    int tid_ = F.tid; asm volatile("" : "+v"(tid_));
    const int tid = tid_, lane = tid & 63, w = F.wave, fq = lane >> 4, a = lane & 15;
#pragma unroll
    for (int i = 0; i < 4; ++i) { const int c = tid + 512 * i, key = c >> 3, ch = c & 7; const int kb = (b - 1) * 128 + key;
        v4u kv = (v4u){0u, 0u, 0u, 0u}, vv = kv;
        if (kb >= 0) { const bf16* p = Z + (rowbase + ((size_t)kb << dsh) + r) * EVIN; kv = *(const GAS v4u*)(p + colK + ch * 8); vv = *(const GAS v4u*)(p + colV + ch * 8); }
        *(LAS v4u*)(lds + ATT_K + key * KVS + ch * 16) = kv; *(LAS v4u*)(lds + ATT_V + key * KVS + ch * 16) = vv; }
    const int qi = 16 * w + a; const size_t qrow = rowbase + ((size_t)(b * 128 + qi) << dsh) + r;
    const bf16x8 qa = *(const GAS bf16x8*)(Z + qrow * EVIN + colQ + 8 * fq), qb = *(const GAS bf16x8*)(Z + qrow * EVIN + colQ + 32 + 8 * fq);
    __syncthreads();
    f32x4 S[5][2];
    const int krow = 8 * (a >> 2) + (a & 3);
#pragma unroll
    for (int s = 0; s < 5; ++s) { LAS const unsigned char* kp = lds + ATT_K + (16 * w + 32 * s + krow) * KVS + fq * 16;
        const bf16x8 k0a = *(LAS const bf16x8*)kp, k0b = *(LAS const bf16x8*)(kp + 64), k1a = *(LAS const bf16x8*)(kp + 4 * KVS), k1b = *(LAS const bf16x8*)(kp + 4 * KVS + 64);
        const f32x4 z4 = (f32x4){0.f, 0.f, 0.f, 0.f};
        S[s][0] = mfma16(k0a, qa, z4); S[s][0] = mfma16(k0b, qb, S[s][0]); S[s][1] = mfma16(k1a, qa, z4); S[s][1] = mfma16(k1b, qb, S[s][1]); }
    float mx = -INFINITY;
#pragma unroll
    for (int s = 0; s < 5; ++s)
#pragma unroll
        for (int tt = 0; tt < 2; ++tt)
#pragma unroll
            for (int j = 0; j < 4; ++j) { const int kk = 16 * w + 32 * s + 8 * fq + 4 * tt + j; const bool ok = (kk >= qi) && (kk <= qi + 128) && (b > 0 || kk >= 128);
                const float v = ok ? S[s][tt][j] : -INFINITY; S[s][tt][j] = v; mx = __builtin_fmaxf(mx, v); }
    mx = __builtin_fmaxf(mx, __shfl_xor(mx, 16)); mx = __builtin_fmaxf(mx, __shfl_xor(mx, 32));
    float l = 0.f;
#pragma unroll
    for (int s = 0; s < 5; ++s)
#pragma unroll
        for (int tt = 0; tt < 2; ++tt)
#pragma unroll
            for (int j = 0; j < 4; ++j) { const float p = __builtin_amdgcn_exp2f(S[s][tt][j] - mx); S[s][tt][j] = p; l += p; }
    l += __shfl_xor(l, 16); l += __shfl_xor(l, 32);
    f32x4 O[4];
#pragma unroll
    for (int db = 0; db < 4; ++db) O[db] = (f32x4){0.f, 0.f, 0.f, 0.f};
    const int q4 = a >> 2, p4 = a & 3;
#pragma unroll
    for (int s = 0; s < 5; ++s) {
        v4u pw; pw.x = cvtpk(S[s][0][0], S[s][0][1]); pw.y = cvtpk(S[s][0][2], S[s][0][3]); pw.z = cvtpk(S[s][1][0], S[s][1][1]); pw.w = cvtpk(S[s][1][2], S[s][1][3]);
        const bf16x8 pf = __builtin_bit_cast(bf16x8, pw);
        LAS const unsigned char* vp = lds + ATT_V + (16 * w + 32 * s + 8 * fq + q4) * KVS + p4 * 8;
#pragma unroll
        for (int db = 0; db < 4; ++db) { const v4i16_t t0 = trread(vp + db * 32), t1 = trread(vp + 4 * KVS + db * 32);
            const bf16x8 vf = (bf16x8){t0[0], t0[1], t0[2], t0[3], t1[0], t1[1], t1[2], t1[3]};
            O[db] = mfma16(vf, pf, O[db]); } }
    const float inv = 1.0f / l;
    bf16* og = (bf16*)(F.ws + WS_OG) + ((size_t)g * MALL + qrow) * 512 + h * 64 + 4 * fq;
#pragma unroll
    for (int db = 0; db < 4; ++db) { u32x2 o; o.x = cvtpk(O[db][0] * inv, O[db][1] * inv); o.y = cvtpk(O[db][2] * inv, O[db][3] * inv); *(GAS u32x2*)(og + 16 * db) = o; }
    if (fq == 0) ((float*)(F.ws + WS_LSE))[((size_t)g * MALL + qrow) * 8 + h] = (mx + __builtin_amdgcn_logf(l)) * 0.6931471805599453f;
    __syncthreads();
}
template <int NQ> __device__ __forceinline__ void attn_sample_item(Frame& F, const Args& A, int n, int g, int tq) {
    int lane_ = F.lane; asm volatile("" : "+v"(lane_));
    const int lane = lane_, h = F.wave, ks = lane >> 4, dc = lane & 15;
    const int Lb = 128 << (2 * g), stride = 1 << (2 * g), first = NQ == 4 ? 0 : tq;
    const float* cache = A.in[2 + g] + (size_t)n * Lb * 1024 + h * 64 + dc * 4;
    const float* newkv = F.out + (g == 0 ? pg8::O_KVS0 : (g == 1 ? pg8::O_KVS1 : pg8::O_KVS2)) + (size_t)(n * 4) * 1024 + h * 64 + dc * 4;
    const bf16* Z = (const bf16*)(F.ws + WS_Z);
    LAS float* sc = (LAS float*)(F.lds + ATT_SC + h * 2112);
    f32x4 q[NQ];
#pragma unroll
    for (int t = 0; t < NQ; ++t) { const int tt = NQ == 4 ? t : tq; const u32x2 wq = *(const GAS u32x2*)(Z + (size_t)(MP + n * 4 + tt) * EVIN + 512 + g * 1536 + h * 64 + dc * 4);
        q[t] = (f32x4){bflo(wq.x), bfhi(wq.x), bflo(wq.y), bfhi(wq.y)}; }
#pragma unroll 4
    for (int it = 0; it < 33; ++it) { const int m = 4 * it + ks;
        const f32x4 kx = it < 32 ? *(const GAS f32x4*)(cache + (size_t)(first + m * stride) * 1024) : *(const GAS f32x4*)(newkv + (size_t)ks * 1024);
#pragma unroll
        for (int t = 0; t < NQ; ++t) { float d = (q[t][0] * kx[0] + q[t][1] * kx[1]) + (q[t][2] * kx[2] + q[t][3] * kx[3]);
            d += __shfl_xor(d, 8); d += __shfl_xor(d, 4); d += __shfl_xor(d, 2); d += __shfl_xor(d, 1);
            if (dc == 0) sc[t * 132 + m] = d; } }
    LDS_WAIT(); asm volatile("" ::: "memory");
    float mxs[NQ], ls[NQ];
#pragma unroll
    for (int t = 0; t < NQ; ++t) { const int tt = NQ == 4 ? t : tq; float v[3]; float mx = -INFINITY;
#pragma unroll
        for (int k = 0; k < 3; ++k) { const int j = lane + 64 * k; bool ok = j < 132;
            if (NQ == 4) ok = ok && (j < 128 ? j >= tt : (j - 128) <= tt); else ok = ok && (j < 128 || (j - 128) == tt);
            v[k] = ok ? sc[t * 132 + (j < 132 ? j : 0)] : -INFINITY; mx = __builtin_fmaxf(mx, v[k]); }
        mx = wave_max(mx); float l = 0.f;
#pragma unroll
        for (int k = 0; k < 3; ++k) { const float p = __builtin_amdgcn_exp2f(v[k] - mx); l += p; const int j = lane + 64 * k; if (j < 132) sc[t * 132 + j] = p; }
        ls[t] = wave_sum(l); mxs[t] = mx; }
    LDS_WAIT(); asm volatile("" ::: "memory");
    f32x4 o[NQ];
#pragma unroll
    for (int t = 0; t < NQ; ++t) o[t] = (f32x4){0.f, 0.f, 0.f, 0.f};
#pragma unroll 4
    for (int it = 0; it < 33; ++it) { const int m = 4 * it + ks;
        const f32x4 vx = it < 32 ? *(const GAS f32x4*)(cache + (size_t)(first + m * stride) * 1024 + 512) : *(const GAS f32x4*)(newkv + (size_t)ks * 1024 + 512);
#pragma unroll
        for (int t = 0; t < NQ; ++t) { const float p = sc[t * 132 + m]; o[t] += vx * p; } }
#pragma unroll
    for (int t = 0; t < NQ; ++t) { const int tt = NQ == 4 ? t : tq; f32x4 ov = o[t];
#pragma unroll
        for (int j = 0; j < 4; ++j) { ov[j] += __shfl_xor(ov[j], 16); ov[j] += __shfl_xor(ov[j], 32); }
        const float inv = 1.0f / ls[t]; const size_t row = (size_t)MP + n * 4 + tt;
        if (ks == 0) { u32x2 ow; ow.x = cvtpk(ov[0] * inv, ov[1] * inv); ow.y = cvtpk(ov[2] * inv, ov[3] * inv); *(GAS u32x2*)((bf16*)(F.ws + WS_OG) + ((size_t)g * MALL + row) * 512 + h * 64 + dc * 4) = ow; }
        if (lane == 0) ((float*)(F.ws + WS_LSE))[((size_t)g * MALL + row) * 8 + h] = (mxs[t] + __builtin_amdgcn_logf(ls[t])) * 0.6931471805599453f; }
    LDS_WAIT(); asm volatile("" ::: "memory");
}
__device__ __forceinline__ void p2_attention(Frame& F, const Args& A) {
    for (int i = F.tid; i < 2 * 16 * KVS / 4; i += 512) { const int which = i / (16 * KVS / 4), o = i % (16 * KVS / 4); *(LAS unsigned*)(F.lds + (which ? ATT_V : ATT_K) + 256 * KVS + o * 4) = 0u; }
    __syncthreads();
    for (int it = F.vcu; it < 1152; it += F.G) { const int n = it / 9, kind = it % 9;
        if (kind == 0) attn_sample_item<4>(F, A, n, 0, 0); else attn_sample_item<1>(F, A, n, kind < 5 ? 1 : 2, (kind - 1) & 3); }
    __syncthreads();
    for (int u = F.vcu; u < 3072; u += F.G) attn_prompt_unit(F, A, u);
}

__device__ __forceinline__ void p3_combine_pool(Frame& F, const Args& A) {
    const int gw = F.vcu * NWAVES + F.wave, NGW = F.G * NWAVES, lane = F.lane;
    bf16* YAB = (bf16*)(F.ws + WS_YAB); const bf16* OG = (const bf16*)(F.ws + WS_OG); const float* LSE = (const float*)(F.ws + WS_LSE);
#ifndef P3_PART
#define P3_PART 3
#endif
    if (P3_PART & 1)
    for (int row = gw; row < MALL; row += NGW) { const int h = lane >> 3;
        float ls[3]; v4u ov[3];
#pragma unroll
        for (int g = 0; g < 3; ++g) { ls[g] = LSE[((size_t)g * MALL + row) * 8 + h]; ov[g] = *(const GAS v4u*)(OG + ((size_t)g * MALL + row) * 512 + lane * 8); }
        const float mx = __builtin_fmaxf(__builtin_fmaxf(ls[0], ls[1]), ls[2]);
        float wg[3]; float den = 0.f;
#pragma unroll
        for (int g = 0; g < 3; ++g) { wg[g] = __expf(ls[g] - mx); den += wg[g]; }
        const float inv = 1.0f / den; float y[8];
#pragma unroll
        for (int k = 0; k < 8; ++k) y[k] = 0.f;
#pragma unroll
        for (int g = 0; g < 3; ++g) { const float ww = wg[g] * inv; const unsigned* pw = (const unsigned*)&ov[g];
#pragma unroll
            for (int k = 0; k < 4; ++k) { y[2 * k] += ww * bflo(pw[k]); y[2 * k + 1] += ww * bfhi(pw[k]); } }
        v4u o; o.x = cvtpk(y[0], y[1]); o.y = cvtpk(y[2], y[3]); o.z = cvtpk(y[4], y[5]); o.w = cvtpk(y[6], y[7]);
        *(GAS v4u*)(YAB + (size_t)row * DM + 512 + lane * 8) = o; }
    const bf16* Z = (const bf16*)(F.ws + WS_Z); const bf16* PW = (const bf16*)(F.ws + WS_POOLW); const float* SP = A.in[5];
    const int fq = lane >> 4, a = lane & 15;
    if (P3_PART & 2)
    for (int un = gw; un < (MALL / 16) * 4; un += NGW) { const int gi = un & 3, slab = un >> 2; const int w = 2 << gi;
        const int row = slab * 16 + a; const bool samp = row >= MP; const int ms = row - MP; const int t = samp ? (ms & 3) : (row & (SEQ - 1)); const int nsq = ms >> 2;
        const float rc = 1.0f / (float)(samp ? w : (w < t + 1 ? w : t + 1));
        bf16x8 pf[4];
#pragma unroll
        for (int ks = 0; ks < 4; ++ks) { const int c = gi * 128 + 32 * ks + 8 * fq; float acc[8], x0[8];
            { const v4u zz = *(const GAS v4u*)(Z + (size_t)row * EVIN + c); const unsigned* pz = (const unsigned*)&zz;
#pragma unroll
              for (int k = 0; k < 4; ++k) { x0[2 * k] = bflo(pz[k]); x0[2 * k + 1] = bfhi(pz[k]); acc[2 * k] = x0[2 * k]; acc[2 * k + 1] = x0[2 * k + 1]; } }
            for (int j = 1; j < w; ++j) {
                if (j <= t) { const v4u zz = *(const GAS v4u*)(Z + (size_t)(row - j) * EVIN + c); const unsigned* pz = (const unsigned*)&zz;
#pragma unroll
                    for (int k = 0; k < 4; ++k) { acc[2 * k] += bflo(pz[k]); acc[2 * k + 1] += bfhi(pz[k]); } }
                else if (samp) { const float* sp = SP + ((size_t)(nsq * 15 + 15 + t - j)) * 512 + c; const f32x4 s0 = *(const GAS f32x4*)sp, s1 = *(const GAS f32x4*)(sp + 4);
#pragma unroll
                    for (int k = 0; k < 4; ++k) { acc[k] += s0[k]; acc[4 + k] += s1[k]; } } }
            v4u pw; pw.x = cvtpk(acc[0] * rc - x0[0], acc[1] * rc - x0[1]); pw.y = cvtpk(acc[2] * rc - x0[2], acc[3] * rc - x0[3]);
            pw.z = cvtpk(acc[4] * rc - x0[4], acc[5] * rc - x0[5]); pw.w = cvtpk(acc[6] * rc - x0[6], acc[7] * rc - x0[7]);
            pf[ks] = __builtin_bit_cast(bf16x8, pw); }
#pragma unroll
        for (int nb = 0; nb < 8; ++nb) { f32x4 d = (f32x4){0.f, 0.f, 0.f, 0.f};
#pragma unroll
            for (int ks = 0; ks < 4; ++ks) { const bf16x8 wf = *(const GAS bf16x8*)(PW + ((size_t)(gi * 128 + 16 * nb + a)) * 128 + 32 * ks + 8 * fq); d = mfma16(wf, pf[ks], d); }
            u32x2 o; o.x = cvtpk(d[0], d[1]); o.y = cvtpk(d[2], d[3]);
            *(GAS u32x2*)(YAB + (size_t)row * DM + gi * 128 + 16 * nb + 4 * fq) = o; } }
}

__device__ __forceinline__ void p9_oddmix(Frame& F, const Args& A) {
    const int gw = F.vcu * NWAVES + F.wave, NGW = F.G * NWAVES, lane = F.lane, tid = F.tid, wv = F.wave;
    const bf16* Z = (const bf16*)(F.ws + WS_Z); bf16* YAB = (bf16*)(F.ws + WS_YAB);
    const float* lng = A.in[14]; const float* lnb = A.in[15]; const float* bs = A.in[17]; const float* cw = A.in[18];
    for (int row = gw; row < MALL; row += NGW) { const bool samp = row >= MP; const int ms = row - MP; const int t = samp ? (ms & 3) : (row & (SEQ - 1)); const int nb = samp ? (ms >> 2) : (row >> 13);
        const int c = lane * 8; float hd[3][8];
#pragma unroll
        for (int j = 0; j < 3; ++j) { const int dt = 2 - j;
            if (dt <= t) { const bf16* zr = Z + (size_t)(row - dt) * ODIN; const v4u gi = *(const GAS v4u*)(zr + 1536 + c), xi = *(const GAS v4u*)(zr + 2048 + c); const unsigned* pg = (const unsigned*)&gi; const unsigned* px = (const unsigned*)&xi;
#pragma unroll
                for (int k = 0; k < 4; ++k) { hd[j][2 * k] = bflo(pg[k]) * bflo(px[k]); hd[j][2 * k + 1] = bfhi(pg[k]) * bfhi(px[k]); } }
            else if (samp) { const float* sp = A.in[6] + ((size_t)(nb * 2 + (t + 2 - dt))) * 512 + c; const f32x4 s0 = *(const GAS f32x4*)sp, s1 = *(const GAS f32x4*)(sp + 4);
#pragma unroll
                for (int k = 0; k < 4; ++k) { hd[j][k] = s0[k]; hd[j][4 + k] = s1[k]; } }
            else {
#pragma unroll
                for (int k = 0; k < 8; ++k) hd[j][k] = 0.f; } }
        const v4u go = *(const GAS v4u*)(Z + (size_t)row * ODIN + 1024 + c); const unsigned* pgo = (const unsigned*)&go;
        float y[8];
#pragma unroll
        for (int k = 0; k < 8; ++k) { const float cv = cw[c + k] * hd[0][k] + cw[512 + c + k] * hd[1][k] + cw[1024 + c + k] * hd[2][k]; y[k] = ((k & 1) ? bfhi(pgo[k >> 1]) : bflo(pgo[k >> 1])) * cv; }
        v4u o; o.x = cvtpk(y[0], y[1]); o.y = cvtpk(y[2], y[3]); o.z = cvtpk(y[4], y[5]); o.w = cvtpk(y[6], y[7]);
        *(GAS v4u*)(YAB + (size_t)row * DM + 512 + c) = o;
        float* co = nullptr;
        if (samp) { if (t >= 2) co = F.out + pg8::O_CONVS + ((size_t)(nb * 2 + t - 2)) * 512 + c; } else if (t >= SEQ - 2) co = F.out + pg8::O_CONVP + ((size_t)(nb * 2 + t - (SEQ - 2))) * 512 + c;
        if (co) { *(GAS f32x4*)co = (f32x4){hd[2][0], hd[2][1], hd[2][2], hd[2][3]}; *(GAS f32x4*)(co + 4) = (f32x4){hd[2][4], hd[2][5], hd[2][6], hd[2][7]}; } }
    for (int n = gw; n < 128; n += NGW) { const int c = lane * 8, g = lane >> 4; float vn[4][8];
#pragma unroll
        for (int s = 0; s < 4; ++s) { const v4u vv = *(const GAS v4u*)(Z + (size_t)(MP + n * 4 + s) * ODIN + 512 + c); const unsigned* pv = (const unsigned*)&vv; float x[8]; float sm = 0.f;
#pragma unroll
            for (int k = 0; k < 4; ++k) { x[2 * k] = bflo(pv[k]); x[2 * k + 1] = bfhi(pv[k]); sm += x[2 * k] + x[2 * k + 1]; }
            sm += __shfl_xor(sm, 1); sm += __shfl_xor(sm, 2); sm += __shfl_xor(sm, 4); sm += __shfl_xor(sm, 8);
            const float mu = sm * (1.0f / 128.0f); float q = 0.f;
#pragma unroll
            for (int k = 0; k < 8; ++k) { x[k] -= mu; q += x[k] * x[k]; }
            q += __shfl_xor(q, 1); q += __shfl_xor(q, 2); q += __shfl_xor(q, 4); q += __shfl_xor(q, 8);
            const float rstd = __builtin_amdgcn_rsqf(q * (1.0f / 128.0f) + 1e-6f);
#pragma unroll
            for (int k = 0; k < 8; ++k) vn[s][k] = x[k] * rstd * lng[c + k] + lnb[c + k];
            float* cvo = F.out + pg8::O_CVS + ((size_t)(n * 4 + s)) * 512 + c;
            *(GAS f32x4*)cvo = (f32x4){vn[s][0], vn[s][1], vn[s][2], vn[s][3]}; *(GAS f32x4*)(cvo + 4) = (f32x4){vn[s][4], vn[s][5], vn[s][6], vn[s][7]}; }
#pragma unroll
        for (int t = 0; t < 4; ++t) { float sp[8];
#pragma unroll
            for (int k = 0; k < 8; ++k) sp[k] = bs[g * 128 + t];
#pragma unroll
            for (int s = 0; s <= t; ++s) { const float wts = A.in[16][(g * 128 + t) * 128 + s];
#pragma unroll
                for (int k = 0; k < 8; ++k) sp[k] += wts * vn[s][k]; }
            const v4u uu = *(const GAS v4u*)(Z + (size_t)(MP + n * 4 + t) * ODIN + c); const unsigned* pu = (const unsigned*)&uu;
            v4u o; o.x = cvtpk(bflo(pu[0]) * sp[0], bfhi(pu[0]) * sp[1]); o.y = cvtpk(bflo(pu[1]) * sp[2], bfhi(pu[1]) * sp[3]); o.z = cvtpk(bflo(pu[2]) * sp[4], bfhi(pu[2]) * sp[5]); o.w = cvtpk(bflo(pu[3]) * sp[6], bfhi(pu[3]) * sp[7]);
            *(GAS v4u*)(YAB + (size_t)(MP + n * 4 + t) * DM + c) = o; } }
    const bf16* WT = (const bf16*)(F.ws + WS_WST);
    LAS unsigned char* lds = F.lds; const int fq = lane >> 4, a = lane & 15, q4 = a >> 2, p4 = a & 3;
    for (int un = F.vcu; un < 512; un += F.G) { const int g = un & 3, ck = un >> 2; const int row0 = ck * 128;
        { const int rn = tid >> 2, c0 = (tid & 3) * 32; const bf16* zr = Z + (size_t)(row0 + rn) * ODIN + 512 + g * 128 + c0; float x[32]; float sm = 0.f;
#pragma unroll
          for (int k4 = 0; k4 < 4; ++k4) { const v4u vv = *(const GAS v4u*)(zr + 8 * k4); const unsigned* pv = (const unsigned*)&vv;
#pragma unroll
              for (int k = 0; k < 4; ++k) { x[8 * k4 + 2 * k] = bflo(pv[k]); x[8 * k4 + 2 * k + 1] = bfhi(pv[k]); sm += x[8 * k4 + 2 * k] + x[8 * k4 + 2 * k + 1]; } }
          sm += __shfl_xor(sm, 1); sm += __shfl_xor(sm, 2); const float mu = sm * (1.0f / 128.0f); float q = 0.f;
#pragma unroll
          for (int k = 0; k < 32; ++k) { x[k] -= mu; q += x[k] * x[k]; }
          q += __shfl_xor(q, 1); q += __shfl_xor(q, 2); const float rstd = __builtin_amdgcn_rsqf(q * (1.0f / 128.0f) + 1e-6f);
          const float* gp = lng + g * 128 + c0; const float* bp = lnb + g * 128 + c0;
#pragma unroll
          for (int k4 = 0; k4 < 4; ++k4) { v4u o; unsigned* po = (unsigned*)&o;
#pragma unroll
              for (int k = 0; k < 4; ++k) po[k] = cvtpk(x[8 * k4 + 2 * k] * rstd * gp[8 * k4 + 2 * k] + bp[8 * k4 + 2 * k], x[8 * k4 + 2 * k + 1] * rstd * gp[8 * k4 + 2 * k + 1] + bp[8 * k4 + 2 * k + 1]);
              *(LAS v4u*)(lds + rn * VNS + (c0 + 8 * k4) * 2) = o; } }
        __syncthreads();
        const int t = 16 * wv + a; const int nks = (wv >> 1) + 1;
        f32x4 D[8];
#pragma unroll
        for (int cb = 0; cb < 8; ++cb) D[cb] = (f32x4){0.f, 0.f, 0.f, 0.f};
        for (int ks = 0; ks < nks; ++ks) { const bf16x8 wf = *(const GAS bf16x8*)(WT + ((size_t)(g * 128 + t)) * 128 + 32 * ks + 8 * fq);
            LAS const unsigned char* vp = lds + (32 * ks + 8 * fq + q4) * VNS + p4 * 8;
#pragma unroll
            for (int cb = 0; cb < 8; ++cb) { const v4i16_t t0 = trread(vp + cb * 32), t1 = trread(vp + 4 * VNS + cb * 32);
                const bf16x8 vf = (bf16x8){t0[0], t0[1], t0[2], t0[3], t1[0], t1[1], t1[2], t1[3]};
                D[cb] = mfma16(vf, wf, D[cb]); } }
        const float bt = bs[g * 128 + t]; const size_t row = (size_t)row0 + t;
#pragma unroll
        for (int cb = 0; cb < 8; ++cb) { const int c = g * 128 + 16 * cb + 4 * fq; const u32x2 uu = *(const GAS u32x2*)(Z + row * ODIN + c);
            u32x2 o; o.x = cvtpk(bflo(uu.x) * (D[cb][0] + bt), bfhi(uu.x) * (D[cb][1] + bt)); o.y = cvtpk(bflo(uu.y) * (D[cb][2] + bt), bfhi(uu.y) * (D[cb][3] + bt));
            *(GAS u32x2*)(YAB + row * DM + c) = o; }
        __syncthreads(); }
}

__device__ __forceinline__ void p_final(Frame& F, const Args& A, const float* SS) {
    const int gw = F.vcu * NWAVES + F.wave, NGW = F.G * NWAVES;
    const float* R = (const float*)(F.ws + WS_R); const float* gf = A.in[27];
    for (int m = gw; m < MALL; m += NGW) { const float rs = pg8::row_rs(SS, m);
        const GAS f32x4* xr = (const GAS f32x4*)(R + (size_t)m * DM) + F.lane; GAS f32x4* o = (GAS f32x4*)(F.out + (size_t)m * DM) + F.lane; const GAS f32x4* gg = (const GAS f32x4*)gf + F.lane;
#pragma unroll
        for (int j = 0; j < 4; ++j) o[64 * j] = xr[64 * j] * gg[64 * j] * rs; }
}

constexpr int N_PHASES = 15;
__global__ void __launch_bounds__(NWAVES * 64, 2) mk_fwd(Args args) {
    extern __shared__ __attribute__((aligned(16))) unsigned char lds[];
    Frame F;
    F.lds = (LAS unsigned char*)lds; F.MISC = (volatile LAS unsigned*)(F.lds + MISC_OFF);
    F.tid = threadIdx.x; F.lane = F.tid & 63; F.wave = __builtin_amdgcn_readfirstlane(F.tid >> 6);
    F.G = gridDim.x; { const int bx = blockIdx.x; F.vcu = (F.G % 8 == 0) ? (bx % 8) * (F.G / 8) + bx / 8 : bx; }
    F.out = args.out; F.ws = args.ws; F.ctl = (gu32*)(args.ws + WS_CTL);
    for (int u = F.tid; u < (LDS_BYTES - LDSCTL_OFF) / 4; u += NWAVES * 64) ((LAS unsigned*)(F.lds + LDSCTL_OFF))[u] = 0u;
    __syncthreads();
    const int lo = args.ph_lo, hi = args.ph_hi;
    XcdBarrier bar; bar.bar = (unsigned*)(F.ctl + CW_BAR); bar.x = 0; bar.st = nullptr;
    if (hi - lo > 1) bar = xcd_barrier_post((unsigned*)(F.ctl + CW_BAR), F.MISC + 8);
#ifndef SITEMASK
#define SITEMASK 0xfff
#endif
#define SITE(n) (((SITEMASK) >> (n)) & 1)
#define IN(k) (lo <= (k) && (k) < hi)
#define SEAM(k) do { if (IN(k) && IN((k) + 1)) xcd_barrier(bar); } while (0)
    unsigned char* ws = args.ws;
    bf16* RBb = (bf16*)(ws + WS_RB); float* SSb = (float*)(ws + WS_SS); float* R = (float*)(ws + WS_R);
    constexpr size_t RBN = (size_t)MALL * DM, SSN = (size_t)MALL * 16;
    const int cid = (int)blockIdx.x;

    if (SITE(0) && IN(0)) { relaunder(F); p0_prologue(F, args); } SEAM(0);

            if (SITE(1) && IN(1)) {
                pg8::Gemm g{RBb, (const bf16*)(ws + WS_WEVIN), MALL, EVIN, DM}; pg8::StaticOrder S; S.init(MALL, EVIN, F.G, cid);
                pg8::EpiEvIn E{(bf16*)(ws + WS_Z), SSb, (const float*)(ws + WS_ROPE), F.out};
                pg8::gemm_phase<pg8::EpiEvIn, pg8::StaticOrder, true, true>(F.lds, g, S, E);
            } SEAM(1);
            if (SITE(2) && IN(2)) { relaunder(F); p2_attention(F, args); } SEAM(2);
            if (SITE(3) && IN(3)) { relaunder(F); p3_combine_pool(F, args); } SEAM(3);
        if (SITE(6) && IN(4)) {
            pg8::Gemm g{(const bf16*)(ws + WS_YAB), (const bf16*)(ws + WS_WEVOUT), MALL, DM, DM}; pg8::StaticOrder S; S.init(MALL, DM, F.G, cid);
            pg8::EpiResid E{args.in[0], args.in[1], R, RBb + (RBN), SSb + (SSN)};
            pg8::gemm_phase<pg8::EpiResid, pg8::StaticOrder, true, true>(F.lds, g, S, E);
        } SEAM(4);
        if (SITE(7) && IN(4 + 1)) {
            { pg8::Gemm g{RBb + (RBN), (const bf16*)(ws + WS_W1) + (size_t)0 * 1024 * FFD, MALL, FFD, DM}; pg8::StaticOrder S; S.init(MALL, FFD, F.G, cid);
              pg8::EpiScaled<0> E{(bf16*)(ws + WS_F), FFD, SSb + (SSN)};
              pg8::gemm_phase<pg8::EpiScaled<0>, pg8::StaticOrder, true, true>(F.lds, g, S, E); }
        }
        if (SITE(11) && IN(4 + 1)) {
            { pg8::Gemm g{(const bf16*)(ws + WS_PB) + (size_t)0 * MALL * 256, (const bf16*)(ws + WS_WP) + (size_t)0 * 256 * 1024, MALL, DM, 256}; pg8::StaticOrder S; S.init(MALL, DM, F.G, cid);
              pg8::EpiPlain E{(bf16*)(ws + WS_PROJ), DM};
              pg8::gemm_phase<pg8::EpiPlain, pg8::StaticOrder, true, true>(F.lds, g, S, E); }
        } SEAM(4 + 1);
        if (SITE(8) && IN(4 + 2)) {
            pg8::Gemm g{(const bf16*)(ws + WS_F), (const bf16*)(ws + WS_W2) + (size_t)0 * 1024 * FFD, MALL, DM, FFD}; pg8::StaticOrder S; S.init(MALL, DM, F.G, cid);
            pg8::EpiResid E{R, R + (size_t)MP * DM, R, RBb + (0), SSb + (0)};
            pg8::gemm_phase<pg8::EpiResid, pg8::StaticOrder, true, true>(F.lds, g, S, E);
        } SEAM(4 + 2);
        if (SITE(9) && IN(4 + 3)) {
            pg8::Gemm g{RBb + (0), (const bf16*)(ws + WS_WG) + (size_t)0 * 1024 * 1024, MALL, DM, DM}; pg8::StaticOrder S; S.init(MALL, DM, F.G, cid);
            pg8::EpiPle E{SSb + (0), (const bf16*)(ws + WS_PROJ), R, RBb + (RBN), SSb + (SSN)};
            pg8::gemm_phase<pg8::EpiPle, pg8::StaticOrder, true, true>(F.lds, g, S, E);
        } SEAM(4 + 3);
            if (SITE(4) && IN(8)) {
                pg8::Gemm g{RBb + RBN, (const bf16*)(ws + WS_WODIN), MALL, ODIN, DM}; pg8::StaticOrder S; S.init(MALL, ODIN, F.G, cid);
                pg8::EpiScaled<1> E{(bf16*)(ws + WS_Z), ODIN, SSb + SSN};
                pg8::gemm_phase<pg8::EpiScaled<1>, pg8::StaticOrder, true, true>(F.lds, g, S, E);
            } SEAM(8);
            if (SITE(5) && IN(9)) { relaunder(F); p9_oddmix(F, args); } SEAM(9);
        if (SITE(6) && IN(10)) {
            pg8::Gemm g{(const bf16*)(ws + WS_YAB), (const bf16*)(ws + WS_WODOUT), MALL, DM, DM}; pg8::StaticOrder S; S.init(MALL, DM, F.G, cid);
            pg8::EpiResid E{R, R + (size_t)MP * DM, R, RBb + (0), SSb + (0)};
            pg8::gemm_phase<pg8::EpiResid, pg8::StaticOrder, true, true>(F.lds, g, S, E);
        } SEAM(10);
        if (SITE(7) && IN(10 + 1)) {
            { pg8::Gemm g{RBb + (0), (const bf16*)(ws + WS_W1) + (size_t)1 * 1024 * FFD, MALL, FFD, DM}; pg8::StaticOrder S; S.init(MALL, FFD, F.G, cid);
              pg8::EpiScaled<0> E{(bf16*)(ws + WS_F), FFD, SSb + (0)};
              pg8::gemm_phase<pg8::EpiScaled<0>, pg8::StaticOrder, true, true>(F.lds, g, S, E); }
        }
        if (SITE(11) && IN(10 + 1)) {
            { pg8::Gemm g{(const bf16*)(ws + WS_PB) + (size_t)1 * MALL * 256, (const bf16*)(ws + WS_WP) + (size_t)1 * 256 * 1024, MALL, DM, 256}; pg8::StaticOrder S; S.init(MALL, DM, F.G, cid);
              pg8::EpiPlain E{(bf16*)(ws + WS_PROJ), DM};
              pg8::gemm_phase<pg8::EpiPlain, pg8::StaticOrder, true, true>(F.lds, g, S, E); }
        } SEAM(10 + 1);
        if (SITE(8) && IN(10 + 2)) {
            pg8::Gemm g{(const bf16*)(ws + WS_F), (const bf16*)(ws + WS_W2) + (size_t)1 * 1024 * FFD, MALL, DM, FFD}; pg8::StaticOrder S; S.init(MALL, DM, F.G, cid);
            pg8::EpiResid E{R, R + (size_t)MP * DM, R, RBb + (RBN), SSb + (SSN)};
            pg8::gemm_phase<pg8::EpiResid, pg8::StaticOrder, true, true>(F.lds, g, S, E);
        } SEAM(10 + 2);
        if (SITE(9) && IN(10 + 3)) {
            pg8::Gemm g{RBb + (RBN), (const bf16*)(ws + WS_WG) + (size_t)1 * 1024 * 1024, MALL, DM, DM}; pg8::StaticOrder S; S.init(MALL, DM, F.G, cid);
            pg8::EpiPle E{SSb + (SSN), (const bf16*)(ws + WS_PROJ), R, RBb + (0), SSb + (0)};
            pg8::gemm_phase<pg8::EpiPle, pg8::StaticOrder, true, true>(F.lds, g, S, E);
        } SEAM(10 + 3);
    if (SITE(10) && IN(14)) { relaunder(F); p_final(F, args, SSb); }
    if (lo == 15) {
        const int gt = (F.vcu * NWAVES + F.wave) * 64 + F.lane, NT = F.G * NWAVES * 64;
        if (args.dump == 1) { const bf16* src = (const bf16*)(ws + WS_YAB); for (size_t i = gt; i < (size_t)MALL * DM; i += NT) { const float v = __builtin_bit_cast(float, (unsigned)src[i] << 16); F.out[i] = (v == v) ? v : 12345.0f; } }
        else if (args.dump == 2) { const float* src = (const float*)(ws + WS_R); for (size_t i = gt; i < (size_t)MALL * DM; i += NT) F.out[i] = src[i]; }
        else if (args.dump == 4) { const bf16* src = (const bf16*)(ws + WS_OG) + (size_t)MALL * 512; for (size_t i = gt; i < (size_t)MALL * DM; i += NT) F.out[i] = __builtin_bit_cast(float, (unsigned)src[i] << 16); }
        else if (args.dump == 5) { const bf16* src = (const bf16*)(ws + WS_OG); const float* l = (const float*)(ws + WS_LSE); for (size_t i = gt; i < (size_t)MALL * DM; i += NT) F.out[i] = i < (size_t)3 * MALL * 8 ? l[i] : __builtin_bit_cast(float, (unsigned)src[i] << 16); }
        else if (args.dump == 6) { const bf16* src = (const bf16*)(ws + WS_Z); for (size_t i = gt; i < (size_t)MALL * DM; i += NT) F.out[i] = __builtin_bit_cast(float, (unsigned)src[(i >> 10) * EVIN + (i & 1023)] << 16); }
        else if (args.dump == 7) { const bf16* src = (const bf16*)(ws + WS_POOLW); for (size_t i = gt; i < (size_t)MALL * DM; i += NT) F.out[i] = i < 131072 ? __builtin_bit_cast(float, (unsigned)src[i] << 16) : 0.f; }
        else if (args.dump == 3) { const bf16* src = (const bf16*)(ws + WS_Z); for (size_t i = gt; i < (size_t)MALL * DM; i += NT) F.out[i] = __builtin_bit_cast(float, (unsigned)src[i] << 16); }
    }
#undef IN
#undef SEAM
}

#ifndef MK_PER_PHASE
#define MK_PER_PHASE 1
#endif
extern "C" void kernel_launch(void* const* d_in, const int* in_sizes, int n_in, void* d_out, int out_size, void* d_ws, size_t ws_size, hipStream_t stream) {
    static int grid = 0;
    if (grid == 0) {
        if (n_in != 28 || out_size != (int)pg8::O_END || ws_size < WS_END) { fprintf(stderr, "kernel_launch: unexpected shapes n_in %d out %d ws %zu\n", n_in, out_size, ws_size); grid = -1; return; }
        int dev = 0, cus = 0, per_cu = 0;
        if (hipGetDevice(&dev) != hipSuccess || hipDeviceGetAttribute(&cus, hipDeviceAttributeMultiprocessorCount, dev) != hipSuccess) { grid = -1; return; }
        if (hipFuncSetAttribute((const void*)mk_fwd, hipFuncAttributeMaxDynamicSharedMemorySize, LDS_BYTES) != hipSuccess) { fprintf(stderr, "kernel_launch: hipFuncSetAttribute failed\n"); grid = -1; return; }
        if (hipOccupancyMaxActiveBlocksPerMultiprocessor(&per_cu, (const void*)mk_fwd, NWAVES * 64, LDS_BYTES) != hipSuccess || per_cu < 1) fprintf(stderr, "kernel_launch: occupancy query says %d\n", per_cu);
        (void)hipGetLastError();
        grid = cus;
    }
    if (grid < 0) return;
    (void)in_sizes;
    if (hipMemsetAsync((char*)d_ws + WS_CTL, 0, CTL_ZERO_BYTES, stream) != hipSuccess) return;
    Args a{};
    for (int i = 0; i < 28; ++i) a.in[i] = (const float*)d_in[i];
    a.out = (float*)d_out; a.ws = (unsigned char*)d_ws;
#if defined(MK_STOP)
    for (int p = 0; p < MK_STOP; ++p) { a.ph_lo = p; a.ph_hi = p + 1; hipLaunchKernelGGL(mk_fwd, dim3(grid), dim3(NWAVES * 64), LDS_BYTES, stream, a); }
    a.ph_lo = 15; a.ph_hi = 16; a.dump = MK_DUMP; hipLaunchKernelGGL(mk_fwd, dim3(grid), dim3(NWAVES * 64), LDS_BYTES, stream, a);
#elif MK_PER_PHASE
    for (int p = 0; p < N_PHASES; ++p) { a.ph_lo = p; a.ph_hi = p + 1; hipLaunchKernelGGL(mk_fwd, dim3(grid), dim3(NWAVES * 64), LDS_BYTES, stream, a); }
#else
    a.ph_lo = 0; a.ph_hi = N_PHASES;
    hipLaunchKernelGGL(mk_fwd, dim3(grid), dim3(NWAVES * 64), LDS_BYTES, stream, a);
#endif
}
```

```cpp
#include <hip/hip_runtime.h>
#include <cstdio>
#include <cstdint>
#include <cmath>
namespace pg8 {
#define PG8_LAS __attribute__((address_space(3)))
#define PG8_GAS __attribute__((address_space(1)))
typedef unsigned short bf16_t;
typedef short bf16x8 __attribute__((ext_vector_type(8)));
typedef float f32x4 __attribute__((ext_vector_type(4)));
typedef unsigned u32x4 __attribute__((ext_vector_type(4)));
constexpr int BM = 256, BK = 64, HALF = 128, HTB = HALF * BK * 2  , STAGE_BYTES = 8 * HTB, NXCD = 8, WGM = 8;

__host__ __device__ __forceinline__ int lds_byte(int r, int c) { const int st = (r >> 4) * 2 + (c >> 5), rr = r & 15, cc = c & 31, ob = rr * 64 + cc * 2; return st * 1024 + (ob ^ (((ob >> 9) & 1) << 5)); }
__host__ __device__ __forceinline__ void stage_rc(int b, int& R, int& C) { const int st = b / 1024, sb = b % 1024, swz = sb ^ (((sb >> 9) & 1) << 5); R = (st >> 1) * 16 + swz / 64; C = (st & 1) * 32 + (swz % 64) / 2; }
__host__ __device__ __forceinline__ int perm32(int rho) { const int n = rho >> 4, i = rho & 15; return 8 * (i >> 2) + 4 * n + (i & 3); }

struct Unit { int pm, pn; };
struct Gemm { const bf16_t* A; const bf16_t* Bt; int M, N, K; };

struct StaticOrder {
    int nM, nN, nwg, G, c;
    __host__ __device__ void init(int M, int N, int G_, int c_) { nM = M / BM; nN = N / BM; nwg = nM * nN; G = G_; c = c_; }
    __host__ __device__ bool next(int i, Unit& u) const {
        const long L = (long)i * G + c; if (L >= nwg) return false;
        int wgid = (int)L; { const int q = nwg / NXCD, r = nwg % NXCD, xcd = wgid % NXCD, off = wgid / NXCD; wgid = (xcd < r ? xcd * (q + 1) : r * (q + 1) + (xcd - r) * q) + off; }
        const int nig = WGM * nN, gid = wgid / nig, fm = gid * WGM, gsz = (nM - fm) < WGM ? (nM - fm) : WGM;
        u.pm = fm + ((wgid % nig) % gsz); u.pn = (wgid % nig) / gsz; return true;
    }
    __device__ __forceinline__ void a_ready(const Unit&) const {}
    __device__ __forceinline__ void done(const Unit&) const {}
};

typedef float f32x2c __attribute__((ext_vector_type(2))); typedef __bf16 bf16x2c __attribute__((ext_vector_type(2)));
__device__ __forceinline__ unsigned cvt_pk_bf16(float lo, float hi) { const f32x2c v = {lo, hi}; return __builtin_bit_cast(unsigned, __builtin_convertvector(v, bf16x2c)); }
typedef float f32x2 __attribute__((ext_vector_type(2)));
typedef unsigned u32x2 __attribute__((ext_vector_type(2)));
constexpr int DM = 1024, SEQ = 8192, MP = 2 * SEQ, MS = 512, MALL = MP + MS;
constexpr int EVIN = 5120, ODIN = 2560, FFD = 4096;
constexpr float C2 = 0.125f * 1.4426950408889634f;
constexpr size_t O_YP = 0, O_YS = O_YP + (size_t)MP * DM, O_KVP0 = O_YS + (size_t)MS * DM, O_KVP1 = O_KVP0 + 2 * 128 * 1024, O_KVP2 = O_KVP1 + 2 * 512 * 1024,
                 O_KVS0 = O_KVP2 + 2 * 2048 * 1024, O_KVS1 = O_KVS0 + (size_t)MS * 1024, O_KVS2 = O_KVS1 + (size_t)MS * 1024, O_POOLP = O_KVS2 + (size_t)MS * 1024,
                 O_POOLS = O_POOLP + 2 * 15 * 512, O_CONVP = O_POOLS + 128 * 15 * 512, O_CONVS = O_CONVP + 2 * 2 * 512, O_CVS = O_CONVS + 128 * 2 * 512, O_END = O_CVS + (size_t)MS * 512;
static_assert(O_END == 25773056, "output size");

__device__ __forceinline__ float row_rs(const float* SS, int row) {
    const PG8_GAS f32x4* p = (const PG8_GAS f32x4*)(SS + (size_t)row * 16);
    const f32x4 a = p[0], b = p[1], c = p[2], d = p[3];
    const float s = (((a[0] + a[1]) + (a[2] + a[3])) + ((b[0] + b[1]) + (b[2] + b[3]))) + (((c[0] + c[1]) + (c[2] + c[3])) + ((d[0] + d[1]) + (d[2] + d[3])));
    return __builtin_amdgcn_rsqf(s * (1.0f / 1024.0f) + 1e-6f);
}
__device__ __forceinline__ u32x4 pack8(const f32x4 v0, const f32x4 v1) { u32x4 w; w.x = cvt_pk_bf16(v0[0], v0[1]); w.y = cvt_pk_bf16(v0[2], v0[3]); w.z = cvt_pk_bf16(v1[0], v1[1]); w.w = cvt_pk_bf16(v1[2], v1[3]); return w; }
__device__ __forceinline__ u32x2 pack4(const f32x4 v) { u32x2 w; w.x = cvt_pk_bf16(v[0], v[1]); w.y = cvt_pk_bf16(v[2], v[3]); return w; }
__device__ __forceinline__ float bf_lo(unsigned w) { return __builtin_bit_cast(float, w << 16); }
__device__ __forceinline__ float bf_hi(unsigned w) { return __builtin_bit_cast(float, w & 0xffff0000u); }

__device__ __forceinline__ void st16(void* base, size_t off, const u32x4 v) { *(PG8_GAS u32x4*)((PG8_GAS char*)base + off) = v; }
__device__ __forceinline__ void st8(void* base, size_t off, const u32x2 v) { *(PG8_GAS u32x2*)((PG8_GAS char*)base + off) = v; }
__device__ __forceinline__ void stf8(float* p, const f32x4 v0, const f32x4 v1) { *(PG8_GAS f32x4*)p = v0; *(PG8_GAS f32x4*)(p + 4) = v1; }
#define PG8_EPI_CALL \
    __device__ __forceinline__ void operator()(const f32x4 (&acc)[2][2][4][2], const Unit& u, int wr_, int wc_, int fr_, int fq_, bool fresh) const { \
        int wr = wr_, wc = wc_, fr = fr_, fq = fq_; asm volatile("" : "+s"(wr), "+s"(wc), "+v"(fr), "+v"(fq));     \
        float rsv[2][4]; \
        if constexpr (USE_RS) { PG8_LAS float* tab = rstab + (wr * 4 + wc) * 128; const int ln = fq * 16 + fr; \
            if (fresh) { _Pragma("unroll") for (int ai = 0; ai < 2; ++ai) tab[ai * 64 + ln] = row_rs(SS, u.pm * BM + ai * HALF + wr * 64 + ln);     \
                asm volatile("s_waitcnt lgkmcnt(0)" ::: "memory"); } \
            _Pragma("unroll") for (int ai = 0; ai < 2; ++ai) _Pragma("unroll") for (int m = 0; m < 4; ++m) rsv[ai][m] = tab[ai * 64 + m * 16 + fr]; \
        } else { _Pragma("unroll") for (int ai = 0; ai < 2; ++ai) _Pragma("unroll") for (int m = 0; m < 4; ++m) rsv[ai][m] = 0.f; } \
        _Pragma("unroll") for (int ai = 0; ai < 2; ++ai) _Pragma("unroll") for (int m = 0; m < 4; ++m) { \
            const f32x4 a[2][2] = {{acc[ai][0][m][0], acc[ai][0][m][1]}, {acc[ai][1][m][0], acc[ai][1][m][1]}}; \
            rg(a, u.pm * BM + ai * HALF + wr * 64 + m * 16 + fr, u.pn, wc, fq, rsv[ai][m]); } }

struct EpiEvIn {
    static constexpr bool PERM = true, AFTER_DRAIN = false, USE_RS = true;
    bf16_t* Z; const float* SS; const float* rope; float* out; PG8_LAS float* rstab;
    __device__ __forceinline__ void rg(const f32x4 (&a)[2][2], int row, int pn, int wc, int fq, float rs) const {
        const int part = pn < 2 ? 0 : (pn - 2) % 6, g = pn < 2 ? 0 : (pn - 2) / 6;
        const int kind = pn < 2 ? 3 : (part >> 1);
        const int hoff = (part & 1) * 4;
        const int keep = 128 << (2 * g);
        float* kvp = out + (g == 0 ? O_KVP0 : (g == 1 ? O_KVP1 : O_KVP2));
        float* kvs = out + (g == 0 ? O_KVS0 : (g == 1 ? O_KVS1 : O_KVS2));
        const bool samp = row >= MP; const int ms = row - MP;
        const int t = samp ? (ms & 3) : (row & (SEQ - 1));
        const int nb = samp ? (ms >> 2) : (row >> 13);
        const size_t zro = ((size_t)row * EVIN + pn * BM) * 2;
        const int cb = wc * 64 + 8 * fq;
        if (kind == 3) {
#pragma unroll
            for (int bj = 0; bj < 2; ++bj) { const f32x4 v0 = a[bj][0] * rs, v1 = a[bj][1] * rs; const int ct = cb + 32 * bj;
                st16(Z, zro + ct * 2, pack8(v0, v1));
                const int ch = pn * BM + ct;
                if (samp) stf8(out + O_POOLS + (size_t)(nb * 15 + 11 + t) * 512 + ch, v0, v1);
                else if (t >= SEQ - 15) stf8(out + O_POOLP + (size_t)(nb * 15 + (t - (SEQ - 15))) * 512 + ch, v0, v1); }
        } else if (kind == 2) {
#pragma unroll
            for (int bj = 0; bj < 2; ++bj) { const f32x4 v0 = a[bj][0] * rs, v1 = a[bj][1] * rs; const int ct = cb + 32 * bj;
                st16(Z, zro + ct * 2, pack8(v0, v1));
                const int hd = hoff * 64 + ct;
                if (samp) stf8(kvs + ((size_t)ms * 2 + 1) * 512 + hd, v0, v1);
                else if (t >= SEQ - keep) stf8(kvp + ((size_t)(nb * keep + (t - (SEQ - keep))) * 2 + 1) * 512 + hd, v0, v1); }
        } else {
            const int pos = samp ? 2048 + t : t;
            const PG8_GAS f32x4* tp = (const PG8_GAS f32x4*)(rope + ((size_t)pos * 32 + 8 * fq) * 2);
            const float sc = (kind == 0) ? C2 * rs : rs;
            f32x4 o1[2], o2[2];
#pragma unroll
            for (int n = 0; n < 2; ++n) { const f32x4 cs0 = tp[2 * n], cs1 = tp[2 * n + 1];
                const f32x4 x1 = a[0][n] * sc, x2 = a[1][n] * sc;
                o1[n][0] = x1[0] * cs0[0] - x2[0] * cs0[1]; o2[n][0] = x2[0] * cs0[0] + x1[0] * cs0[1];
                o1[n][1] = x1[1] * cs0[2] - x2[1] * cs0[3]; o2[n][1] = x2[1] * cs0[2] + x1[1] * cs0[3];
                o1[n][2] = x1[2] * cs1[0] - x2[2] * cs1[1]; o2[n][2] = x2[2] * cs1[0] + x1[2] * cs1[1];
                o1[n][3] = x1[3] * cs1[2] - x2[3] * cs1[3]; o2[n][3] = x2[3] * cs1[2] + x1[3] * cs1[3]; }
            st16(Z, zro + cb * 2, pack8(o1[0], o1[1])); st16(Z, zro + (cb + 32) * 2, pack8(o2[0], o2[1]));
            if (kind == 1) {
                const int hd = (hoff + wc) * 64 + 8 * fq;
                float* p = nullptr;
                if (samp) p = kvs + ((size_t)ms * 2) * 512 + hd; else if (t >= SEQ - keep) p = kvp + ((size_t)(nb * keep + (t - (SEQ - keep))) * 2) * 512 + hd;
                if (p) { stf8(p, o1[0], o1[1]); stf8(p + 32, o2[0], o2[1]); }
            }
        }
    }
    PG8_EPI_CALL
};
struct EpiPlain {
    static constexpr bool PERM = true, AFTER_DRAIN = false, USE_RS = false;
    bf16_t* O; int ldc; const float* SS; PG8_LAS float* rstab;
    __device__ __forceinline__ void rg(const f32x4 (&a)[2][2], int row, int pn, int wc, int fq, float rs) const {
        const size_t rowo = ((size_t)row * ldc + pn * BM + wc * 64 + 8 * fq) * 2;
#pragma unroll
        for (int bj = 0; bj < 2; ++bj) st16(O, rowo + bj * 32 * 2, pack8(a[bj][0], a[bj][1]));
    }
    PG8_EPI_CALL
};
template <int MODE> struct EpiScaled {
    static constexpr bool PERM = true, AFTER_DRAIN = false, USE_RS = true;
    bf16_t* O; int ldc; const float* SS; PG8_LAS float* rstab;
    __device__ __forceinline__ void rg(const f32x4 (&a)[2][2], int row, int pn, int wc, int fq, float rs) const {
        const bool act = (MODE == 0) || (pn < 4);
        const size_t rowo = ((size_t)row * ldc + pn * BM + wc * 64 + 8 * fq) * 2;
#pragma unroll
        for (int bj = 0; bj < 2; ++bj) { f32x4 v[2] = {a[bj][0] * rs, a[bj][1] * rs};
            if (MODE == 0) {
#pragma unroll
                for (int n = 0; n < 2; ++n)
#pragma unroll
                    for (int j = 0; j < 4; ++j) { const float x = __builtin_fmaxf(v[n][j], 0.f); v[n][j] = x * x; }
            } else if (act) {
#pragma unroll
                for (int n = 0; n < 2; ++n)
#pragma unroll
                    for (int j = 0; j < 4; ++j) { const float x = v[n][j]; const float uu = x * (0.7978845608028654f + 0.035677408136300125f * x * x);
                        v[n][j] = x * __builtin_amdgcn_rcpf(1.0f + __builtin_amdgcn_exp2f(-2.8853900817779268f * uu)); }
            }
            st16(O, rowo + bj * 32 * 2, pack8(v[0], v[1])); }
    }
    PG8_EPI_CALL
};
template <bool BASE_BF16> struct EpiResid {
    static constexpr bool PERM = true, AFTER_DRAIN = false, USE_RS = false;
    const void* baseP; const void* baseS; bf16_t* RB; float* SSo; const float* SS; PG8_LAS float* rstab;
    __device__ __forceinline__ void rg(const f32x4 (&a)[2][2], int row, int pn, int wc, int fq, float rs) const {
        const int col0 = pn * BM + wc * 64 + 8 * fq;
        float sq = 0.f;
#pragma unroll
        for (int bj = 0; bj < 2; ++bj) { f32x4 v0, v1;
            if (BASE_BF16) { const u32x4 b = *(const PG8_GAS u32x4*)((const bf16_t*)baseP + (size_t)row * DM + col0 + bj * 32);
                v0 = (f32x4){bf_lo(b.x), bf_hi(b.x), bf_lo(b.y), bf_hi(b.y)} + a[bj][0]; v1 = (f32x4){bf_lo(b.z), bf_hi(b.z), bf_lo(b.w), bf_hi(b.w)} + a[bj][1]; }
            else { const float* bp = (row < MP ? (const float*)baseP + (size_t)row * DM : (const float*)baseS + (size_t)(row - MP) * DM) + col0 + bj * 32;
                v0 = *(const PG8_GAS f32x4*)bp + a[bj][0]; v1 = *(const PG8_GAS f32x4*)(bp + 4) + a[bj][1]; }
            st16(RB, ((size_t)row * DM + col0 + bj * 32) * 2, pack8(v0, v1));
            sq += ((v0[0] * v0[0] + v0[1] * v0[1]) + (v0[2] * v0[2] + v0[3] * v0[3])) + ((v1[0] * v1[0] + v1[1] * v1[1]) + (v1[2] * v1[2] + v1[3] * v1[3])); }
        sq += __shfl_xor(sq, 16); sq += __shfl_xor(sq, 32);
        if (fq == 0) *(PG8_GAS float*)(SSo + (size_t)row * 16 + pn * 4 + wc) = sq;
    }
    PG8_EPI_CALL
};
struct EpiPle {
    static constexpr bool PERM = true, AFTER_DRAIN = false, USE_RS = true;
    const float* SS; const bf16_t* PROJ; const bf16_t* RBi; bf16_t* RB; float* SSo; PG8_LAS float* rstab;
    __device__ __forceinline__ void rg(const f32x4 (&a)[2][2], int row, int pn, int wc, int fq, float rs) const {
        const int col0 = pn * BM + wc * 64 + 8 * fq;
        rs *= -1.4426950408889634f;
        float sq = 0.f;
#pragma unroll
        for (int bj = 0; bj < 2; ++bj) { const size_t off = (size_t)row * DM + col0 + bj * 32;
            const u32x4 pj = *(const PG8_GAS u32x4*)(PROJ + off), b = *(const PG8_GAS u32x4*)(RBi + off);
            const f32x4 a0 = a[bj][0] * rs, a1 = a[bj][1] * rs;
            f32x4 g0, g1;
#pragma unroll
            for (int j = 0; j < 4; ++j) { g0[j] = __builtin_amdgcn_rcpf(1.0f + __builtin_amdgcn_exp2f(a0[j])); g1[j] = __builtin_amdgcn_rcpf(1.0f + __builtin_amdgcn_exp2f(a1[j])); }
            f32x4 v0, v1;
            v0[0] = bf_lo(b.x) + g0[0] * bf_lo(pj.x); v0[1] = bf_hi(b.x) + g0[1] * bf_hi(pj.x); v0[2] = bf_lo(b.y) + g0[2] * bf_lo(pj.y); v0[3] = bf_hi(b.y) + g0[3] * bf_hi(pj.y);
            v1[0] = bf_lo(b.z) + g1[0] * bf_lo(pj.z); v1[1] = bf_hi(b.z) + g1[1] * bf_hi(pj.z); v1[2] = bf_lo(b.w) + g1[2] * bf_lo(pj.w); v1[3] = bf_hi(b.w) + g1[3] * bf_hi(pj.w);
            st16(RB, off * 2, pack8(v0, v1));
            sq += ((v0[0] * v0[0] + v0[1] * v0[1]) + (v0[2] * v0[2] + v0[3] * v0[3])) + ((v1[0] * v1[0] + v1[1] * v1[1]) + (v1[2] * v1[2] + v1[3] * v1[3])); }
        sq += __shfl_xor(sq, 16); sq += __shfl_xor(sq, 32);
        if (fq == 0) *(PG8_GAS float*)(SSo + (size_t)row * 16 + pn * 4 + wc) = sq;
    }
    PG8_EPI_CALL
};
template <class Epi, class Sched, bool ALIGN_EPI = false, bool SP2 = false>
__device__ __forceinline__ void gemm_phase(PG8_LAS unsigned char* lds, const Gemm g, const Sched& S, const Epi& E) {
    int tid_ = threadIdx.x; asm volatile("" : "+v"(tid_));
    const int tid = tid_, wid = __builtin_amdgcn_readfirstlane(tid >> 6), lane = tid & 63, wr = wid >> 2, wc = wid & 3, fr = lane & 15, fq = lane >> 4;
    int K_ = g.K; asm volatile("" : "+s"(K_));
    const int K = K_, nt = K / BK;
    unsigned voffA[2], voffB[2];
#pragma unroll
    for (int i = 0; i < 2; ++i) { int R, C; stage_rc(tid * 16 + i * 8192, R, C); const int Rb = Epi::PERM ? (64 * (R >> 5) + perm32(R & 31)) : R;
        voffA[i] = (unsigned)(R * K + C) * 2u; voffB[i] = (unsigned)(Rb * K + C) * 2u; }
    const size_t kstep = (size_t)(BK * 2);
    const size_t hstep = (size_t)HALF * K * 2;
    const size_t tstep = 2 * hstep;
    const size_t bstep = Epi::PERM ? (size_t)32 * K * 2 : hstep;
    const unsigned ldsw = (unsigned)wid * 1024u;
    const int aoff = lds_byte(wr * 64 + fr, fq * 8), boff = lds_byte(wc * 32 + fr, fq * 8);
#define PG8_SA(b, h) (((b) * 2 + (h)) * HTB)
#define PG8_SB(b, h) ((4 + (b) * 2 + (h)) * HTB)
#define PG8_STAGE(bufoff, gbase, voff) do { _Pragma("unroll") for (int _i = 0; _i < 2; ++_i) \
        __builtin_amdgcn_global_load_lds((const unsigned*)((const char*)(gbase) + (voff)[_i]), (PG8_LAS unsigned*)(lds + (bufoff) + ldsw + _i * 8192), 16, 0, 0); } while (0)
#define PG8_LDA(dst, b, h) do { _Pragma("unroll") for (int m = 0; m < 4; ++m) _Pragma("unroll") for (int k = 0; k < 2; ++k) dst[m][k] = *(const PG8_LAS bf16x8*)(lds + PG8_SA(b, h) + aoff + m * 2048 + k * 1024); } while (0)
#define PG8_LDB(dst, b, h) do { _Pragma("unroll") for (int n = 0; n < 2; ++n) _Pragma("unroll") for (int k = 0; k < 2; ++k) dst[n][k] = *(const PG8_LAS bf16x8*)(lds + PG8_SB(b, h) + boff + n * 2048 + k * 1024); } while (0)
#define PG8_MMA(ai, bj, At, Bt) do { __builtin_amdgcn_s_setprio(1); _Pragma("unroll") for (int m = 0; m < 4; ++m) _Pragma("unroll") for (int n = 0; n < 2; ++n) _Pragma("unroll") for (int k = 0; k < 2; ++k) \
        acc[ai][bj][m][n] = __builtin_amdgcn_mfma_f32_16x16x32_bf16(Bt[n][k], At[m][k], acc[ai][bj][m][n], 0, 0, 0); __builtin_amdgcn_s_setprio(0); } while (0)
#define PG8_WAIT_V(n) asm volatile("s_waitcnt vmcnt(" #n ")" ::: "memory")
#define PG8_WAIT_L(n) asm volatile("s_waitcnt lgkmcnt(" #n ")" ::: "memory")
#define PG8_BAR __builtin_amdgcn_s_barrier()
#define PG8_SCHED __builtin_amdgcn_sched_barrier(0)
    Unit cur, nxt; int ui = 0, rs_pm = -1;
    if (!S.next(0, cur)) return;
    f32x4 acc[2][2][4][2];
#pragma unroll
    for (int a = 0; a < 2; ++a)
#pragma unroll
        for (int b = 0; b < 2; ++b)
#pragma unroll
            for (int m = 0; m < 4; ++m)
#pragma unroll
                for (int n = 0; n < 2; ++n) acc[a][b][m][n] = (f32x4){0.f, 0.f, 0.f, 0.f};
    bf16x8 At[4][2], B0[2][2], B1[2][2];
    const char* cA = (const char*)g.A + (size_t)cur.pm * tstep; const char* cB = (const char*)g.Bt + (size_t)cur.pn * tstep;
    S.a_ready(cur);
    if constexpr (SP2) {
        PG8_STAGE(PG8_SB(0, 0), cB, voffB); PG8_STAGE(PG8_SB(0, 1), cB + bstep, voffB); PG8_STAGE(PG8_SA(0, 0), cA, voffA); PG8_STAGE(PG8_SA(0, 1), cA + hstep, voffA);
        if (wr == 1) PG8_BAR;
        PG8_WAIT_V(2); PG8_BAR;
        PG8_STAGE(PG8_SB(1, 0), cB + kstep, voffB); PG8_STAGE(PG8_SA(1, 0), cA + kstep, voffA); PG8_STAGE(PG8_SB(1, 1), cB + bstep + kstep, voffB);
        PG8_WAIT_V(6); PG8_BAR;
    } else {
        PG8_STAGE(PG8_SB(0, 0), cB, voffB); PG8_STAGE(PG8_SA(0, 0), cA, voffA); PG8_STAGE(PG8_SB(0, 1), cB + bstep, voffB); PG8_STAGE(PG8_SA(0, 1), cA + hstep, voffA);
        if (wr == 1) PG8_BAR;
        PG8_WAIT_V(4); PG8_BAR;
        PG8_STAGE(PG8_SB(1, 0), cB + kstep, voffB); PG8_STAGE(PG8_SA(1, 0), cA + kstep, voffA); PG8_STAGE(PG8_SB(1, 1), cB + bstep + kstep, voffB);
        PG8_WAIT_V(6); PG8_BAR;
    }
    for (;;) {
        const bool has_next = S.next(ui + 1, nxt);
        const char* nA = has_next ? (const char*)g.A + (size_t)nxt.pm * tstep : cA; const char* nB = has_next ? (const char*)g.Bt + (size_t)nxt.pn * tstep : cB;
        for (int t = 0; t < nt; t += 2) {
            const bool last = (t == nt - 2);
            const char* a1 = cA + (size_t)(t + 1) * kstep;
            const char* a2 = last ? nA : cA + (size_t)(t + 2) * kstep; const char* b2 = last ? nB : cB + (size_t)(t + 2) * kstep;
            const char* a3 = a2 + kstep; const char* b3 = b2 + kstep;
            if (last && has_next) S.a_ready(nxt);
            if constexpr (SP2) {
            PG8_LDB(B0, 0, 0); PG8_LDB(B1, 0, 1); PG8_SCHED; PG8_LDA(At, 0, 0); PG8_STAGE(PG8_SA(1, 1), a1 + hstep, voffA);
            PG8_WAIT_V(8); PG8_WAIT_L(0); PG8_BAR; PG8_MMA(0, 0, At, B0); PG8_MMA(0, 1, At, B1); PG8_BAR; PG8_SCHED;
            PG8_LDA(At, 0, 1); PG8_STAGE(PG8_SB(0, 0), b2, voffB); PG8_STAGE(PG8_SB(0, 1), b2 + bstep, voffB); PG8_STAGE(PG8_SA(0, 0), a2, voffA);
            PG8_WAIT_V(8); PG8_WAIT_L(0); PG8_BAR; PG8_MMA(1, 0, At, B0); PG8_MMA(1, 1, At, B1); PG8_BAR; PG8_SCHED;
            PG8_LDB(B0, 1, 0); PG8_LDB(B1, 1, 1); PG8_SCHED; PG8_LDA(At, 1, 0); PG8_STAGE(PG8_SA(0, 1), a2 + hstep, voffA);
            PG8_WAIT_V(8); PG8_WAIT_L(0); PG8_BAR; PG8_MMA(0, 0, At, B0); PG8_MMA(0, 1, At, B1); PG8_BAR; PG8_SCHED;
            PG8_LDA(At, 1, 1); PG8_STAGE(PG8_SB(1, 0), b3, voffB); PG8_STAGE(PG8_SB(1, 1), b3 + bstep, voffB); PG8_STAGE(PG8_SA(1, 0), a3, voffA);
            PG8_WAIT_V(8); PG8_WAIT_L(0); PG8_BAR; PG8_MMA(1, 0, At, B0); PG8_MMA(1, 1, At, B1); PG8_BAR; PG8_SCHED;
            } else {
            PG8_LDB(B0, 0, 0); PG8_SCHED; PG8_LDA(At, 0, 0); PG8_STAGE(PG8_SA(1, 1), a1 + hstep, voffA);
            PG8_WAIT_L(8); PG8_BAR; PG8_WAIT_L(0); PG8_MMA(0, 0, At, B0); PG8_BAR; PG8_SCHED;
            PG8_LDB(B1, 0, 1); PG8_STAGE(PG8_SB(0, 0), b2, voffB);
            PG8_BAR; PG8_WAIT_L(0); PG8_MMA(0, 1, At, B1); PG8_BAR;
            PG8_LDA(At, 0, 1); PG8_STAGE(PG8_SA(0, 0), a2, voffA);
            PG8_BAR; PG8_WAIT_L(0); PG8_MMA(1, 0, At, B0); PG8_BAR; PG8_SCHED;
            PG8_STAGE(PG8_SB(0, 1), b2 + bstep, voffB);
            PG8_WAIT_V(6); PG8_BAR; PG8_MMA(1, 1, At, B1); PG8_BAR;
            PG8_LDB(B0, 1, 0); PG8_SCHED; PG8_LDA(At, 1, 0); PG8_STAGE(PG8_SA(0, 1), a2 + hstep, voffA);
            PG8_WAIT_L(8); PG8_BAR; PG8_WAIT_L(0); PG8_MMA(0, 0, At, B0); PG8_BAR; PG8_SCHED;
            PG8_LDB(B1, 1, 1); PG8_STAGE(PG8_SB(1, 0), b3, voffB);
            PG8_BAR; PG8_WAIT_L(0); PG8_MMA(0, 1, At, B1); PG8_BAR;
            PG8_LDA(At, 1, 1); PG8_STAGE(PG8_SA(1, 0), a3, voffA);
            PG8_BAR; PG8_WAIT_L(0); PG8_MMA(1, 0, At, B0); PG8_BAR; PG8_SCHED;
            PG8_STAGE(PG8_SB(1, 1), b3 + bstep, voffB);
            PG8_WAIT_V(6); PG8_BAR; PG8_MMA(1, 1, At, B1); PG8_BAR;
            }
        }
        if constexpr (ALIGN_EPI) { if (wr == 0) PG8_BAR; }
        if constexpr (!Epi::AFTER_DRAIN) { E(acc, cur, wr, wc, fr, fq, cur.pm != rs_pm); rs_pm = cur.pm; S.done(cur); }
        if (!has_next) break;
#pragma unroll
        for (int a = 0; a < 2; ++a)
#pragma unroll
            for (int b = 0; b < 2; ++b)
#pragma unroll
                for (int m = 0; m < 4; ++m)
#pragma unroll
                    for (int n = 0; n < 2; ++n) acc[a][b][m][n] = (f32x4){0.f, 0.f, 0.f, 0.f};
        cur = nxt; cA = nA; cB = nB; ++ui;
        if constexpr (ALIGN_EPI) { if (wr == 1) PG8_BAR; }
    }
    PG8_WAIT_V(0);
    if constexpr (!ALIGN_EPI) { if (wr == 0) PG8_BAR; }
    PG8_BAR;
    if constexpr (Epi::AFTER_DRAIN) { E.fused(acc, cur, wr, wc, fr, fq, lds, wid, lane); S.done(cur); }
#undef PG8_SA
#undef PG8_SB
#undef PG8_STAGE
#undef PG8_LDA
#undef PG8_LDB
#undef PG8_MMA
#undef PG8_WAIT_V
#undef PG8_WAIT_L
#undef PG8_BAR
#undef PG8_SCHED
}
}
#define GAS __attribute__((address_space(1)))
#define LAS __attribute__((address_space(3)))
typedef unsigned short bf16;
typedef unsigned v4u __attribute__((ext_vector_type(4)));
typedef float f32x4 __attribute__((ext_vector_type(4)));
typedef short bf16x8 __attribute__((ext_vector_type(8)));
typedef GAS unsigned gu32;
typedef GAS unsigned long long gu64;
#define RLX_AGENT __ATOMIC_RELAXED, __HIP_MEMORY_SCOPE_AGENT
#define LDS_WAIT() asm volatile("s_waitcnt lgkmcnt(0)" ::: "memory")
#define VM_WAIT() asm volatile("s_waitcnt vmcnt(0)" ::: "memory")
__device__ __forceinline__ unsigned long long rt() { return __builtin_amdgcn_s_memrealtime(); }
__device__ __forceinline__ unsigned f2bf(float f) { unsigned u = __builtin_bit_cast(unsigned, f); return (u + 0x7fffu + ((u >> 16) & 1u)) >> 16; }
__device__ __forceinline__ unsigned pk2(float lo, float hi) { return f2bf(lo) | (f2bf(hi) << 16); }
#define XB_TMO      128
#define XB_XCNT(j)  (256  + 64 * (j))
#define XB_XSUB(j)  (1280 + 64 * (j))
#define XB_XGEN(j)  (2304 + 64 * (j))
#define XB_TOP      3328
#define XB_TOPGEN   3392
#define XCD_BAR_WORDS 3456
#define XB_SPIN_CAP (1u << 18)

__device__ __forceinline__ unsigned xb_ld(unsigned* p)              { return __hip_atomic_load(p, __ATOMIC_RELAXED, __HIP_MEMORY_SCOPE_AGENT); }
__device__ __forceinline__ unsigned xb_add(unsigned* p, unsigned v) { return __hip_atomic_fetch_add(p, v, __ATOMIC_RELAXED, __HIP_MEMORY_SCOPE_AGENT); }
__device__ __forceinline__ unsigned xb_xcc_id() { return (unsigned)__builtin_amdgcn_s_getreg((3 << 11) | 20) & 0xFu; }
#define XB_SPIN(cond, bar) do { unsigned _sp = 0; while (cond) { __builtin_amdgcn_s_sleep(1); \
    if ((++_sp & 255u) == 0u) { if (xb_ld(&(bar)[XB_TMO])) break; if (_sp > XB_SPIN_CAP) { atomicAdd(&(bar)[XB_TMO], 1u); break; } } } } while (0)

struct XcdBarrier {
    unsigned* bar; unsigned x;
    volatile LAS unsigned* st;
};

__device__ __forceinline__ XcdBarrier xcd_barrier_post(unsigned* bar, volatile LAS unsigned* st) {
    XcdBarrier b; b.bar = bar; b.x = xb_xcc_id(); b.st = st;
    if (threadIdx.x == 0) (void)xb_add(&bar[XB_XCNT(b.x)], 1u);
    return b;
}
__device__ __forceinline__ void xcd_barrier_complete(unsigned* bar, unsigned x, unsigned& nloc, unsigned& nx) {
    const unsigned G = gridDim.x * gridDim.y * gridDim.z;
    unsigned sum, cnt, mine, sp = 0u;
    for (;;) {
        sum = 0u; cnt = 0u; mine = 0u;
#pragma unroll
        for (unsigned j = 0; j < 16; ++j) { const unsigned c = xb_ld(&bar[XB_XCNT(j)]); sum += c; cnt += (c > 0u) ? 1u : 0u; mine = (j == x) ? c : mine; }
        if (sum == G) break;
        __builtin_amdgcn_s_sleep(1);
        if ((++sp & 255u) == 0u) { if (xb_ld(&bar[XB_TMO])) break; if (sp > XB_SPIN_CAP) { atomicAdd(&bar[XB_TMO], 1u); break; } }
    }
    nloc = mine > 0u ? mine : 1u; nx = cnt > 0u ? cnt : 1u;
}

__device__ __forceinline__ void xcd_barrier(const XcdBarrier& b) {
    asm volatile("s_waitcnt vmcnt(0)" ::: "memory");
    __syncthreads();
    if (threadIdx.x == 0) {
        unsigned* bar = b.bar;
        __builtin_amdgcn_s_waitcnt(0);
        unsigned nloc = b.st[0], nx = b.st[1];
        if (nloc == 0u) { xcd_barrier_complete(bar, b.x, nloc, nx); b.st[0] = nloc; b.st[1] = nx; }
        const unsigned old = xb_add(&bar[XB_XSUB(b.x)], 1u);
        const unsigned gen = old / nloc;
        if (old + 1u == (gen + 1u) * nloc) {
            __builtin_amdgcn_fence(__ATOMIC_RELEASE, "agent");
            asm volatile("s_waitcnt vmcnt(0)" ::: "memory");
            const unsigned og = xb_add(&bar[XB_TOP], 1u);
            const unsigned tg = og / nx;
            if (og + 1u == (tg + 1u) * nx) xb_add(&bar[XB_TOPGEN], 1u);
            else XB_SPIN(xb_ld(&bar[XB_TOPGEN]) == tg, bar);
            __builtin_amdgcn_fence(__ATOMIC_ACQUIRE, "agent");
            xb_add(&bar[XB_XGEN(b.x)], 1u);
            asm volatile("s_waitcnt vmcnt(0)" ::: "memory");
        } else {
            XB_SPIN(xb_ld(&bar[XB_XGEN(b.x)]) == gen, bar);
            __builtin_amdgcn_fence(__ATOMIC_ACQUIRE, "agent");
            asm volatile("s_waitcnt vmcnt(0)" ::: "memory");
        }
    }
    __syncthreads();
}
using pg8::MP; using pg8::MS; using pg8::MALL; using pg8::DM; using pg8::SEQ; using pg8::EVIN; using pg8::ODIN; using pg8::FFD;
typedef unsigned u32x2 __attribute__((ext_vector_type(2)));
typedef short v4i16_t __attribute__((ext_vector_type(4)));
constexpr int NWAVES = 8;
constexpr size_t MiB = 1u << 20;
constexpr size_t WS_CTL = 0, CTL_ZERO_BYTES = 65536;
constexpr size_t WS_WEVIN = 2 * MiB, WS_WEVOUT = 12 * MiB, WS_WODIN = 14 * MiB, WS_WODOUT = 19 * MiB, WS_W1 = 21 * MiB  , WS_W2 = 37 * MiB  , WS_WG = 53 * MiB  ,
                 WS_WP = 57 * MiB  , WS_POOLW = 58 * MiB, WS_WST = 58 * MiB + 256 * 1024, WS_ROPE = 59 * MiB  , WS_SS = 81 * MiB  ;
constexpr size_t WS_PB = 64 * MiB  , WS_R = 84 * MiB  , WS_RB = 150 * MiB  , WS_YAB = 216 * MiB  , WS_PROJ = 249 * MiB  , WS_Z = 282 * MiB  ,
                 WS_F = 447 * MiB  , WS_OG = 579 * MiB  , WS_LSE = 629 * MiB  , WS_END = 632 * MiB;
static_assert(WS_PB + 2 * (size_t)MALL * 256 * 2 <= WS_R && WS_R + (size_t)MALL * DM * 4 <= WS_RB && WS_RB + 2 * (size_t)MALL * DM * 2 <= WS_YAB && WS_Z + (size_t)MALL * EVIN * 2 <= WS_F &&
              WS_F + (size_t)MALL * FFD * 2 <= WS_OG && WS_OG + 3 * (size_t)MALL * 512 * 2 <= WS_LSE && WS_LSE + 3 * (size_t)MALL * 8 * 4 <= WS_END && WS_ROPE + 8196 * 64 * 4 <= WS_PB &&
              WS_SS + 2 * (size_t)MALL * 16 * 4 <= WS_R && WS_PB + 2 * (size_t)MALL * 256 * 2 <= WS_SS, "d_ws map");
constexpr int CW_BAR = 4096;
constexpr int RING_BYTES = 131072, LDSCTL_OFF = RING_BYTES, MISC_OFF = LDSCTL_OFF + 320, LDS_BYTES = 147456;
constexpr int KVS = 144;
constexpr int ATT_K = 0, ATT_V = 272 * KVS, ATT_SC = 2 * 272 * KVS;
constexpr int VNS = 272;

struct Args { const float* in[28]; float* out; unsigned char* ws; int ph_lo, ph_hi; };
struct Frame {
    LAS unsigned char* lds; volatile LAS unsigned* MISC; gu32* ctl;
    int tid, lane, wave, vcu, G;
    float* out; unsigned char* ws;
};
__device__ __forceinline__ float wave_sum(float v) {
#pragma unroll
    for (int o = 1; o < 64; o <<= 1) v += __shfl_xor(v, o);
    return v;
}
__device__ __forceinline__ float wave_max(float v) {
#pragma unroll
    for (int o = 1; o < 64; o <<= 1) v = __builtin_fmaxf(v, __shfl_xor(v, o));
    return v;
}
__device__ __forceinline__ float red_max16(float x) { const unsigned u = __builtin_bit_cast(unsigned, x); const auto r = __builtin_amdgcn_permlane16_swap(u, u, false, false); return __builtin_fmaxf(__builtin_bit_cast(float, (unsigned)r[0]), __builtin_bit_cast(float, (unsigned)r[1])); }
__device__ __forceinline__ float red_max32(float x) { const unsigned u = __builtin_bit_cast(unsigned, x); const auto r = __builtin_amdgcn_permlane32_swap(u, u, false, false); return __builtin_fmaxf(__builtin_bit_cast(float, (unsigned)r[0]), __builtin_bit_cast(float, (unsigned)r[1])); }
__device__ __forceinline__ float red_add16(float x) { const unsigned u = __builtin_bit_cast(unsigned, x); const auto r = __builtin_amdgcn_permlane16_swap(u, u, false, false); return __builtin_bit_cast(float, (unsigned)r[0]) + __builtin_bit_cast(float, (unsigned)r[1]); }
__device__ __forceinline__ float red_add32(float x) { const unsigned u = __builtin_bit_cast(unsigned, x); const auto r = __builtin_amdgcn_permlane32_swap(u, u, false, false); return __builtin_bit_cast(float, (unsigned)r[0]) + __builtin_bit_cast(float, (unsigned)r[1]); }
__device__ __forceinline__ v4u pair16(u32x2 A, u32x2 B) { const auto rx = __builtin_amdgcn_permlane16_swap(A.x, B.x, false, false); const auto ry = __builtin_amdgcn_permlane16_swap(A.y, B.y, false, false);
    v4u o; o.x = rx[0]; o.y = ry[0]; o.z = rx[1]; o.w = ry[1]; return o; }
__device__ __forceinline__ int pair16_off(int fq) { return 4 * fq + ((fq & 1) ? 12 : 0); }
__device__ __forceinline__ unsigned cvtpk(float lo, float hi) { return pg8::cvt_pk_bf16(lo, hi); }
__device__ __forceinline__ float bflo(unsigned w) { return __builtin_bit_cast(float, w << 16); }
__device__ __forceinline__ float bfhi(unsigned w) { return __builtin_bit_cast(float, w & 0xffff0000u); }
__device__ __forceinline__ f32x4 mfma16(bf16x8 a, bf16x8 b, f32x4 c) { return __builtin_amdgcn_mfma_f32_16x16x32_bf16(a, b, c, 0, 0, 0); }
__device__ __forceinline__ v4i16_t trread(LAS const unsigned char* p) { return __builtin_amdgcn_ds_read_tr16_b64_v4i16((LAS v4i16_t*)p); }

constexpr int SG_NST = 5, SG_STAGE = 24576;
template <class Epi> __device__ __forceinline__ void sample_gemm_k(LAS unsigned char* lds, const Epi& E, const bf16* A, const bf16* Bt, int K_, int cb0);
template <class Epi> __device__ __forceinline__ void sample_gemm(LAS unsigned char* lds, const Epi& E, const bf16* A, const bf16* Bt, int N, int K_) {
    if (N == 1024) { sample_gemm_k(lds, E, A, Bt, K_, 0); return; }
    int t_ = threadIdx.x; asm volatile("" : "+v"(t_)); int K = K_; asm volatile("" : "+s"(K));
    const int tid = t_, lane = tid & 63, wave = __builtin_amdgcn_readfirstlane(tid >> 6), fr = lane & 15, fq = lane >> 4;
    const int b = blockIdx.x, G = gridDim.x, nkt = K / 64;
    const int ncb_big = (N == 5120 && G == 256) ? 64 : N / 64;
    const int nit = ncb_big * 4;
    const int v = (G == 256) ? (((b & 7) + 8 * (b >> 5)) * 4 + ((b >> 3) & 3)) : b;
    int R0, C0, R1, C1; pg8::stage_rc(tid * 16, R0, C0); pg8::stage_rc(tid * 16 + 8192, R1, C1);
    const unsigned ldsw = (unsigned)wave * 1024u;
    const int aoff = pg8::lds_byte(16 * wave + fr, 8 * fq);
    int boff[2][2];
#pragma unroll
    for (int bj = 0; bj < 2; ++bj)
#pragma unroll
        for (int n = 0; n < 2; ++n) boff[bj][n] = 16384 + pg8::lds_byte(32 * bj + 16 * n + fr, 8 * fq);
    for (int it = v; it < nit; it += G) {
        const int cb = it >> 2, oct = it & 3, pn = cb >> 2, wc = cb & 3;
        const int row0 = MP + oct * 128;
        const bf16* ga0 = A + (size_t)(row0 + R0) * K + C0; const bf16* ga1 = A + (size_t)(row0 + R1) * K + C1;
        const bf16* gb = Bt + (size_t)(pn * 256 + (Epi::PERM ? wc * 64 + (R0 >> 5) * 32 + pg8::perm32(R0 & 31) : (R0 >> 5) * 128 + wc * 32 + (R0 & 31))) * K + C0;
#define SG_ISSUE(kt) do { const int s_ = (kt) % SG_NST; const size_t ko_ = (size_t)(kt) * 64; \
        __builtin_amdgcn_global_load_lds((const unsigned*)(ga0 + ko_), (LAS unsigned*)(lds + s_ * SG_STAGE + ldsw), 16, 0, 0); \
        __builtin_amdgcn_global_load_lds((const unsigned*)(ga1 + ko_), (LAS unsigned*)(lds + s_ * SG_STAGE + 8192 + ldsw), 16, 0, 0); \
        __builtin_amdgcn_global_load_lds((const unsigned*)(gb + ko_), (LAS unsigned*)(lds + s_ * SG_STAGE + 16384 + ldsw), 16, 0, 0); } while (0)
        for (int kt = 0; kt < SG_NST - 1 && kt < nkt; ++kt) SG_ISSUE(kt);
        f32x4 acc[2][2];
#pragma unroll
        for (int bj = 0; bj < 2; ++bj)
#pragma unroll
            for (int n = 0; n < 2; ++n) acc[bj][n] = (f32x4){0.f, 0.f, 0.f, 0.f};
        for (int kt = 0; kt < nkt; ++kt) {
            const int ahead = (nkt - 1 - kt) < (SG_NST - 2) ? (nkt - 1 - kt) : (SG_NST - 2);
            if (ahead >= 3) asm volatile("s_waitcnt vmcnt(9)" ::: "memory"); else if (ahead == 2) asm volatile("s_waitcnt vmcnt(6)" ::: "memory");
            else if (ahead == 1) asm volatile("s_waitcnt vmcnt(3)" ::: "memory"); else asm volatile("s_waitcnt vmcnt(0)" ::: "memory");
            __builtin_amdgcn_s_barrier(); __builtin_amdgcn_sched_barrier(0); asm volatile("" ::: "memory");
            if (kt + SG_NST - 1 < nkt) SG_ISSUE(kt + SG_NST - 1);
            LAS const unsigned char* st = lds + (kt % SG_NST) * SG_STAGE;
            bf16x8 af[2], bf[2][2][2];
#pragma unroll
            for (int ks = 0; ks < 2; ++ks) { af[ks] = *(LAS const bf16x8*)(st + aoff + ks * 1024);
#pragma unroll
                for (int bj = 0; bj < 2; ++bj)
#pragma unroll
                    for (int n = 0; n < 2; ++n) bf[ks][bj][n] = *(LAS const bf16x8*)(st + boff[bj][n] + ks * 1024); }
            asm volatile("s_waitcnt lgkmcnt(0)" ::: "memory");
#pragma unroll
            for (int ks = 0; ks < 2; ++ks)
#pragma unroll
                for (int bj = 0; bj < 2; ++bj)
#pragma unroll
                    for (int n = 0; n < 2; ++n) acc[bj][n] = mfma16(bf[ks][bj][n], af[ks], acc[bj][n]);
        }
#undef SG_ISSUE
        { const int row_ = row0 + wave * 16 + fr; E.rg(acc, row_, pn, wc, fq, Epi::USE_RS ? pg8::row_rs(E.SS, row_) : 0.f); }
        asm volatile("s_waitcnt vmcnt(0) lgkmcnt(0)" ::: "memory"); __builtin_amdgcn_s_barrier(); asm volatile("" ::: "memory");
    }
    if (ncb_big < N / 64) sample_gemm_k(lds, E, A, Bt, K_, ncb_big);
}
constexpr int SK_NST = 5, SK_STAGE = 24576;
template <class Epi> __device__ __forceinline__ void sample_gemm_k(LAS unsigned char* lds, const Epi& E, const bf16* A, const bf16* Bt, int K_, int cb0) {
    int t_ = threadIdx.x; asm volatile("" : "+v"(t_)); int K = K_; asm volatile("" : "+s"(K));
    const int tid = t_, lane = tid & 63, wave = __builtin_amdgcn_readfirstlane(tid >> 6), fr = lane & 15, fq = lane >> 4, rg = wave & 1, kq = (wave >> 1) & 1, ch = wave >> 2;
    const int b = blockIdx.x, G = gridDim.x, nit = 256, nkc = K / 128;
    const int v = (G == 256) ? (((b & 7) + 8 * (b >> 5)) * 4 + ((b >> 3) & 3)) : b;
    int RA, CA; const int QA = (tid * 16) >> 12; pg8::stage_rc((tid * 16) & 4095, RA, CA);
    int RB_, CB_; pg8::stage_rc(tid * 16, RB_, CB_);
    const unsigned ldsw = (unsigned)wave * 1024u;
    const int aoff = kq * 4096 + pg8::lds_byte(16 * rg + fr, 8 * fq);
    int boff[2];
#pragma unroll
    for (int n = 0; n < 2; ++n) boff[n] = 8192 + kq * 8192 + pg8::lds_byte(32 * ch + 16 * n + fr, 8 * fq);
    for (int it = v; it < nit; it += G) {
        const int cb = cb0 + (it >> 4), rgrp = it & 15, pn = cb >> 2, wc = cb & 3;
        const int row0 = MP + rgrp * 32;
        const bf16* ga = A + (size_t)(row0 + RA) * K + QA * 64 + CA;
        const bf16* gb = Bt + (size_t)(pn * 256 + (Epi::PERM ? wc * 64 + (RB_ >> 5) * 32 + pg8::perm32(RB_ & 31) : (RB_ >> 5) * 128 + wc * 32 + (RB_ & 31))) * K + CB_;
#define SK_ISSUE(kc) do { const int s_ = (kc) % SK_NST; const size_t ko_ = (size_t)(kc) * 128; \
        __builtin_amdgcn_global_load_lds((const unsigned*)(ga + ko_), (LAS unsigned*)(lds + s_ * SK_STAGE + ldsw), 16, 0, 0); \
        __builtin_amdgcn_global_load_lds((const unsigned*)(gb + ko_), (LAS unsigned*)(lds + s_ * SK_STAGE + 8192 + ldsw), 16, 0, 0); \
        __builtin_amdgcn_global_load_lds((const unsigned*)(gb + ko_ + 64), (LAS unsigned*)(lds + s_ * SK_STAGE + 16384 + ldsw), 16, 0, 0); } while (0)
        for (int kc = 0; kc < SK_NST - 1 && kc < nkc; ++kc) SK_ISSUE(kc);
        f32x4 acc[2];
#pragma unroll
        for (int n = 0; n < 2; ++n) acc[n] = (f32x4){0.f, 0.f, 0.f, 0.f};
        for (int kc = 0; kc < nkc; ++kc) {
            const int ahead = (nkc - 1 - kc) < (SK_NST - 2) ? (nkc - 1 - kc) : (SK_NST - 2);
            if (ahead >= 3) asm volatile("s_waitcnt vmcnt(9)" ::: "memory"); else if (ahead == 2) asm volatile("s_waitcnt vmcnt(6)" ::: "memory");
            else if (ahead == 1) asm volatile("s_waitcnt vmcnt(3)" ::: "memory"); else asm volatile("s_waitcnt vmcnt(0)" ::: "memory");
            __builtin_amdgcn_s_barrier(); __builtin_amdgcn_sched_barrier(0); asm volatile("" ::: "memory");
            if (kc + SK_NST - 1 < nkc) SK_ISSUE(kc + SK_NST - 1);
            LAS const unsigned char* st = lds + (kc % SK_NST) * SK_STAGE;
            bf16x8 af[2], bf[2][2];
#pragma unroll
            for (int ks = 0; ks < 2; ++ks) { af[ks] = *(LAS const bf16x8*)(st + aoff + ks * 1024);
#pragma unroll
                for (int n = 0; n < 2; ++n) bf[ks][n] = *(LAS const bf16x8*)(st + boff[n] + ks * 1024); }
            asm volatile("s_waitcnt lgkmcnt(0)" ::: "memory");
#pragma unroll
            for (int ks = 0; ks < 2; ++ks)
#pragma unroll
                for (int n = 0; n < 2; ++n) acc[n] = mfma16(bf[ks][n], af[ks], acc[n]);
        }
#undef SK_ISSUE
        LAS float* red = (LAS float*)(lds + (nkc % SK_NST) * SK_STAGE);
        if (kq | ch) { const int slot = ch * 2 + kq - 1;
#pragma unroll
            for (int n = 0; n < 2; ++n) *(LAS f32x4*)(red + (((rg * 3 + slot) * 64 + lane) * 8 + n * 4)) = acc[n]; }
        asm volatile("s_waitcnt lgkmcnt(0)" ::: "memory"); __builtin_amdgcn_s_barrier(); asm volatile("" ::: "memory");
        if (!(kq | ch)) { f32x4 a[2][2];
#pragma unroll
            for (int n = 0; n < 2; ++n) { a[0][n] = acc[n] + *(LAS const f32x4*)(red + (((rg * 3 + 0) * 64 + lane) * 8 + n * 4));
                a[1][n] = *(LAS const f32x4*)(red + (((rg * 3 + 1) * 64 + lane) * 8 + n * 4)) + *(LAS const f32x4*)(red + (((rg * 3 + 2) * 64 + lane) * 8 + n * 4)); }
            { const int row_ = row0 + rg * 16 + fr; E.rg(a, row_, pn, wc, fq, Epi::USE_RS ? pg8::row_rs(E.SS, row_) : 0.f); } }
        asm volatile("s_waitcnt vmcnt(0) lgkmcnt(0)" ::: "memory"); __builtin_amdgcn_s_barrier(); asm volatile("" ::: "memory");
    }
}
__device__ __forceinline__ void relaunder(Frame& F) { int t = threadIdx.x; asm volatile("" : "+v"(t)); F.tid = t; F.lane = t & 63; F.wave = __builtin_amdgcn_readfirstlane(t >> 6); }
__device__ __forceinline__ void p0_transpose_item(const float* W, int K, int N, bf16* WT, const float* gain, int mode, LAS float* scr, int item, int lane) {
    const int nblk = N / 32, kb = item / nblk, nb = item % nblk, k0 = 64 * kb, n0 = 32 * nb, n4 = lane & 7, kr = lane >> 3;
    int srcc = n0 + 4 * n4;
    if (mode == 1 && n0 >= 512 && ((n0 - 512) % 1536) < 1024) srcc = (n0 & ~63) + 16 * ((n0 >> 5) & 1) + ((4 * n4) & 15) + 32 * ((4 * n4) >> 4);
    f32x4 v[8];
#pragma unroll
    for (int i = 0; i < 8; ++i) v[i] = __builtin_nontemporal_load((const GAS f32x4*)(W + (size_t)(k0 + kr + 8 * i) * N + srcc));
#pragma unroll
    for (int i = 0; i < 8; ++i) { const int kk = kr + 8 * i; const float gsc = gain ? gain[k0 + kk] : 1.0f;
#pragma unroll
        for (int j = 0; j < 4; ++j) scr[kk * 33 + 4 * n4 + j] = v[i][j] * gsc; }
    LDS_WAIT(); asm volatile("" ::: "memory");
    const int c = lane & 7;
#pragma unroll
    for (int j = 0; j < 4; ++j) { const int n = (lane >> 3) + 8 * j; const LAS float* s = scr + (8 * c) * 33 + n;
        v4u o; o.x = cvtpk(s[0 * 33], s[1 * 33]); o.y = cvtpk(s[2 * 33], s[3 * 33]); o.z = cvtpk(s[4 * 33], s[5 * 33]); o.w = cvtpk(s[6 * 33], s[7 * 33]);
        if (mode == 2) __builtin_nontemporal_store(o, (GAS v4u*)(WT + (size_t)(n0 + n) * K + k0 + 8 * c)); else *(GAS v4u*)(WT + (size_t)(n0 + n) * K + k0 + 8 * c) = o; }
    LDS_WAIT(); asm volatile("" ::: "memory");
}
__device__ __forceinline__ void p0_prologue(Frame& F, const Args& A) {
    LAS float* scr = (LAS float*)(F.lds + F.wave * 16384);
    const int gw = F.vcu * NWAVES + F.wave, NGW = F.G * NWAVES;
    unsigned char* ws = F.ws;
    constexpr int I_EVIN = 16 * 160, I_SQ = 16 * 32, I_ODIN = 16 * 80, I_W1 = 16 * 128, I_W2 = 64 * 32, I_WP = 4 * 32;
    constexpr int NITEMS = I_EVIN + 2 * I_SQ + I_ODIN + 2 * I_W1 + 2 * I_W2 + 2 * I_SQ + 2 * I_WP;
    for (int it = gw; it < NITEMS; it += NGW) {
        int r = it;
        if (r < I_EVIN) { p0_transpose_item(A.in[9], 1024, EVIN, (bf16*)(ws + WS_WEVIN), A.in[20], 0, scr, r, F.lane); continue; } r -= I_EVIN;
        if (r < I_SQ) { p0_transpose_item(A.in[12], 1024, 1024, (bf16*)(ws + WS_WEVOUT), nullptr, 2, scr, r, F.lane); continue; } r -= I_SQ;
        if (r < I_ODIN) { p0_transpose_item(A.in[13], 1024, ODIN, (bf16*)(ws + WS_WODIN), A.in[20] + 1024, 2, scr, r, F.lane); continue; } r -= I_ODIN;
        if (r < I_SQ) { p0_transpose_item(A.in[19], 1024, 1024, (bf16*)(ws + WS_WODOUT), nullptr, 2, scr, r, F.lane); continue; } r -= I_SQ;
        if (r < 2 * I_W1) { const int L = r / I_W1; p0_transpose_item(A.in[23] + (size_t)L * 1024 * FFD, 1024, FFD, (bf16*)(ws + WS_W1) + (size_t)L * 1024 * FFD, A.in[21] + L * 1024, 2, scr, r % I_W1, F.lane); continue; } r -= 2 * I_W1;
        if (r < 2 * I_W2) { const int L = r / I_W2; p0_transpose_item(A.in[24] + (size_t)L * 1024 * FFD, FFD, 1024, (bf16*)(ws + WS_W2) + (size_t)L * 1024 * FFD, nullptr, 2, scr, r % I_W2, F.lane); continue; } r -= 2 * I_W2;
        if (r < 2 * I_SQ) { const int L = r / I_SQ; p0_transpose_item(A.in[26] + (size_t)L * 1024 * 1024, 1024, 1024, (bf16*)(ws + WS_WG) + (size_t)L * 1024 * 1024, A.in[22] + L * 1024, 2, scr, r % I_SQ, F.lane); continue; } r -= 2 * I_SQ;
        { const int L = r / I_WP; p0_transpose_item(A.in[25] + (size_t)L * 256 * 1024, 256, 1024, (bf16*)(ws + WS_WP) + (size_t)L * 256 * 1024, nullptr, 2, scr, r % I_WP, F.lane); }
    }
    {
        bf16* RB0 = (bf16*)(ws + WS_RB); float* SS0 = (float*)(ws + WS_SS);
        for (int m0 = gw; m0 < MALL; m0 += 2 * NGW) {
            f32x4 v[2][4];
#pragma unroll
            for (int r = 0; r < 2; ++r) { const int m = m0 + r * NGW; if (m < MALL) { const float* xrow = m < MP ? A.in[0] + (size_t)m * DM : A.in[1] + (size_t)(m - MP) * DM;
                const GAS f32x4* xr = (const GAS f32x4*)xrow + F.lane;
#pragma unroll
                for (int j = 0; j < 4; ++j) v[r][j] = __builtin_nontemporal_load(xr + 64 * j); } }
#pragma unroll
            for (int r = 0; r < 2; ++r) { const int m = m0 + r * NGW; if (m < MALL) { float s = 0.f;
#pragma unroll
                for (int j = 0; j < 4; ++j) s += (v[r][j][0] * v[r][j][0] + v[r][j][1] * v[r][j][1]) + (v[r][j][2] * v[r][j][2] + v[r][j][3] * v[r][j][3]);
                s = wave_sum(s);
                GAS u32x2* o8 = (GAS u32x2*)(RB0 + (size_t)m * DM) + F.lane;
#pragma unroll
                for (int j = 0; j < 4; ++j) { u32x2 w; w.x = cvtpk(v[r][j][0], v[r][j][1]); w.y = cvtpk(v[r][j][2], v[r][j][3]); o8[64 * j] = w; }
                if (F.lane < 16) SS0[(size_t)m * 16 + F.lane] = F.lane == 0 ? s : 0.f; } }
        }
    }
    const int gt = gw * 64 + F.lane, NT = NGW * 64;
    { bf16* PB = (bf16*)(ws + WS_PB);
      for (int i0 = gt; i0 < 2 * MALL * 64; i0 += 4 * NT) { f32x4 v[4];
#pragma unroll
          for (int u = 0; u < 4; ++u) { const int i = i0 + u * NT; if (i < 2 * MALL * 64) { const int L = i / (MALL * 64), rem = i % (MALL * 64), row = rem >> 6, c4 = rem & 63;
              const float* src = row < MP ? A.in[7] + ((size_t)L * MP + row) * 256 + c4 * 4 : A.in[8] + ((size_t)L * MS + (row - MP)) * 256 + c4 * 4; v[u] = __builtin_nontemporal_load((const GAS f32x4*)src); } }
#pragma unroll
          for (int u = 0; u < 4; ++u) { const int i = i0 + u * NT; if (i < 2 * MALL * 64) { const int L = i / (MALL * 64), rem = i % (MALL * 64), row = rem >> 6, c4 = rem & 63;
              u32x2 w; w.x = cvtpk(v[u][0], v[u][1]); w.y = cvtpk(v[u][2], v[u][3]); *(GAS u32x2*)(PB + ((size_t)L * MALL + row) * 256 + c4 * 4) = w; } } } }
    { float* tab = (float*)(ws + WS_ROPE);
      for (int i = gt; i < 8196 * 32; i += NT) { const int pos = i >> 5, k = i & 31;
          const float inv = (float)exp2(-(double)k * (13.287712379549449 / 32.0));
          const float ang = (float)pos * inv;
          const double rev = (double)ang * 0.15915494309189535; const float fr = (float)(rev - rint(rev));
          tab[2 * i] = __builtin_amdgcn_cosf(fr); tab[2 * i + 1] = __builtin_amdgcn_sinf(fr); } }
    { bf16* PW = (bf16*)(ws + WS_POOLW); bf16* WT = (bf16*)(ws + WS_WST);
      for (int i = gt; i < 4 * 128 * 128; i += NT) { const int g = i >> 14, d = (i >> 7) & 127, c = i & 127;
          PW[i] = (bf16)(cvtpk(A.in[10][(g * 128 + c) * 128 + d] * A.in[11][g * 128 + d], 0.f) & 0xffffu);
          const int t = d, s = c; WT[i] = (bf16)(cvtpk(s <= t ? A.in[16][i] : 0.f, 0.f) & 0xffffu); } }
    { for (int i = gt; i < 128 * 11 * 128; i += NT) { const int n = i / (11 * 128), rem = i % (11 * 128), j = rem >> 7, c4 = rem & 127;
          *(GAS f32x4*)(F.out + pg8::O_POOLS + ((size_t)(n * 15 + j) * 512 + c4 * 4)) = *(const GAS f32x4*)(A.in[5] + ((size_t)(n * 15 + j + 4) * 512 + c4 * 4)); } }
}

template <int W> __device__ __forceinline__ void pool_unit(Frame& F, const Args& A, int gi, int slab) {
    const int w = 2 << gi;
    int lane_ = F.lane; asm volatile("" : "+v"(lane_));
    const int lane = lane_, fq = lane >> 4, a = lane & 15;
    const bf16* Z = (const bf16*)(F.ws + WS_Z); const bf16* PW = (const bf16*)(F.ws + WS_POOLW); const float* SP = A.in[5]; bf16* YAB = (bf16*)(F.ws + WS_YAB);
    const int row = slab * 16 + a; const bool samp = slab >= MP / 16; const int ms = row - MP; const int t = samp ? (ms & 3) : (row & (SEQ - 1)); const int nsq = ms >> 2;
    const float rc = 1.0f / (float)(samp ? w : (w < t + 1 ? w : t + 1));
    bf16x8 pf[4];
#pragma unroll
    for (int ks = 0; ks < 4; ++ks) { const int c = gi * 128 + 32 * ks + 8 * fq; float acc[8], x0[8];
        if (!samp) {
            v4u zz[W];
            const int jmax = t < w - 1 ? t : w - 1;
#pragma unroll
            for (int j = 0; j < W; ++j) { const int jj = j < jmax ? j : jmax; zz[j] = *(const GAS v4u*)(Z + (size_t)(row - jj) * EVIN + c); }
#pragma unroll
            for (int k = 0; k < 4; ++k) { x0[2 * k] = bflo(zz[0][k]); x0[2 * k + 1] = bfhi(zz[0][k]); acc[2 * k] = x0[2 * k]; acc[2 * k + 1] = x0[2 * k + 1]; }
#pragma unroll
            for (int j = 1; j < W; ++j) { const float wgt = j <= jmax ? 1.0f : 0.0f;
#pragma unroll
                for (int k = 0; k < 4; ++k) { acc[2 * k] += wgt * bflo(zz[j][k]); acc[2 * k + 1] += wgt * bfhi(zz[j][k]); } }
        } else {
            { const v4u z0 = *(const GAS v4u*)(Z + (size_t)row * EVIN + c);
#pragma unroll
              for (int k = 0; k < 4; ++k) { x0[2 * k] = bflo(z0[k]); x0[2 * k + 1] = bfhi(z0[k]); acc[2 * k] = x0[2 * k]; acc[2 * k + 1] = x0[2 * k + 1]; } }
            for (int j = 1; j < w; ++j) {
                if (j <= t) { const v4u z1 = *(const GAS v4u*)(Z + (size_t)(row - j) * EVIN + c);
#pragma unroll
                    for (int k = 0; k < 4; ++k) { acc[2 * k] += bflo(z1[k]); acc[2 * k + 1] += bfhi(z1[k]); } }
                else if (samp) { const float* sp = SP + ((size_t)(nsq * 15 + 15 + t - j)) * 512 + c; const f32x4 s0 = *(const GAS f32x4*)sp, s1 = *(const GAS f32x4*)(sp + 4);
#pragma unroll
                    for (int k = 0; k < 4; ++k) { acc[k] += s0[k]; acc[4 + k] += s1[k]; } } }
        }
        v4u pw; pw.x = cvtpk(acc[0] * rc - x0[0], acc[1] * rc - x0[1]); pw.y = cvtpk(acc[2] * rc - x0[2], acc[3] * rc - x0[3]);
        pw.z = cvtpk(acc[4] * rc - x0[4], acc[5] * rc - x0[5]); pw.w = cvtpk(acc[6] * rc - x0[6], acc[7] * rc - x0[7]);
        pf[ks] = __builtin_bit_cast(bf16x8, pw); }
#pragma unroll
    for (int nb = 0; nb < 8; ++nb) { f32x4 d = (f32x4){0.f, 0.f, 0.f, 0.f}; asm volatile("" : "+v"(d));
#pragma unroll
        for (int ks = 0; ks < 4; ++ks) { const bf16x8 wf = *(const GAS bf16x8*)(PW + ((size_t)(gi * 128 + 16 * nb + a)) * 128 + 32 * ks + 8 * fq); d = mfma16(wf, pf[ks], d); }
        u32x2 o; o.x = cvtpk(d[0], d[1]); o.y = cvtpk(d[2], d[3]);
        *(GAS u32x2*)(YAB + (size_t)row * DM + gi * 128 + 16 * nb + 4 * fq) = o; }
}
struct KvRegs { v4u k[4], v[4]; bf16x8 qa, qb; };
__device__ __forceinline__ void attn_prompt_load(Frame& F, int u, int tid, KvRegs& R) {
    const int rb = u & 63, h = (u >> 6) & 7, ng = u >> 9, g = ng % 3, n = ng / 3;
    const int dsh = 2 * g, nbk = 64 >> dsh, r = rb >> (6 - dsh), b = rb & (nbk - 1);
    const size_t rowbase = (size_t)n * SEQ; const bf16* Z = (const bf16*)(F.ws + WS_Z);
    const int colK = 512 + g * 1536 + h * 64 + 512, colV = colK + 512;
#pragma unroll
    for (int i = 0; i < 4; ++i) { const int c = tid + 512 * i, key = c >> 3, ch = c & 7; const int kb = (b - 1) * 128 + key;
        R.k[i] = (v4u){0u, 0u, 0u, 0u}; R.v[i] = R.k[i];
        if (kb >= 0) { const bf16* p = Z + (rowbase + ((size_t)kb << dsh) + r) * EVIN; R.k[i] = *(const GAS v4u*)(p + colK + ch * 8); R.v[i] = *(const GAS v4u*)(p + colV + ch * 8); } }
    { const int lane = tid & 63, w = tid >> 6, fq = lane >> 4, a = lane & 15; const size_t qrow = rowbase + ((size_t)(b * 128 + 16 * w + a) << dsh) + r; const bf16* qp = Z + qrow * EVIN + (colK - 512) + 8 * fq;
      R.qa = *(const GAS bf16x8*)qp; R.qb = *(const GAS bf16x8*)(qp + 32); }
}
__device__ __forceinline__ void attn_prompt_unit(Frame& F, const Args& A, int u, int unext, KvRegs& R) {
    const int rb = u & 63, h = (u >> 6) & 7, ng = u >> 9, g = ng % 3, n = ng / 3;
    const int dsh = 2 * g, nbk = 64 >> dsh, r = rb >> (6 - dsh), b = rb & (nbk - 1);
    const size_t rowbase = (size_t)n * SEQ;
    const bf16* Z = (const bf16*)(F.ws + WS_Z);
    const int colQ = 512 + g * 1536 + h * 64;
    LAS unsigned char* lds = F.lds;
    int tid_ = F.tid; asm volatile("" : "+v"(tid_));
    const int tid = tid_, lane = tid & 63, w = F.wave, fq = lane >> 4, a = lane & 15;
#pragma unroll
    for (int i = 0; i < 4; ++i) { const int c = tid + 512 * i, key = c >> 3, ch = c & 7;
        *(LAS v4u*)(lds + ATT_K + key * KVS + ch * 16) = R.k[i]; *(LAS v4u*)(lds + ATT_V + key * KVS + ch * 16) = R.v[i]; }
    const bf16x8 qa = R.qa, qb = R.qb;
    if (unext >= 0) attn_prompt_load(F, unext, tid, R);
    const int qi = 16 * w + a; const size_t qrow = rowbase + ((size_t)(b * 128 + qi) << dsh) + r;
    asm volatile("s_waitcnt lgkmcnt(0)" ::: "memory"); __builtin_amdgcn_s_barrier(); asm volatile("" ::: "memory");
    f32x4 S[5][2];
    const int krow = 8 * (a >> 2) + (a & 3);
    __builtin_amdgcn_s_setprio(1);
#pragma unroll
    for (int s = 0; s < 5; ++s) { LAS const unsigned char* kp = lds + ATT_K + (16 * w + 32 * s + krow) * KVS + fq * 16;
        const bf16x8 k0a = *(LAS const bf16x8*)kp, k0b = *(LAS const bf16x8*)(kp + 64), k1a = *(LAS const bf16x8*)(kp + 4 * KVS), k1b = *(LAS const bf16x8*)(kp + 4 * KVS + 64);
        const f32x4 z4 = (f32x4){0.f, 0.f, 0.f, 0.f};
        S[s][0] = mfma16(k0a, qa, z4); S[s][0] = mfma16(k0b, qb, S[s][0]); S[s][1] = mfma16(k1a, qa, z4); S[s][1] = mfma16(k1b, qb, S[s][1]); }
    __builtin_amdgcn_s_setprio(0);
    float mx = -INFINITY;
    if (b > 0) {
#pragma unroll
        for (int tt = 0; tt < 2; ++tt)
#pragma unroll
            for (int j = 0; j < 4; ++j) { const int o = 8 * fq + 4 * tt + j;
                S[0][tt][j] = o >= a ? S[0][tt][j] : -INFINITY; S[4][tt][j] = o <= a ? S[4][tt][j] : -INFINITY; }
#pragma unroll
        for (int s = 0; s < 5; ++s)
#pragma unroll
            for (int tt = 0; tt < 2; ++tt)
#pragma unroll
                for (int j = 0; j < 4; ++j) mx = __builtin_fmaxf(mx, S[s][tt][j]);
    } else {
#pragma unroll
        for (int s = 0; s < 5; ++s)
#pragma unroll
            for (int tt = 0; tt < 2; ++tt)
#pragma unroll
                for (int j = 0; j < 4; ++j) { const int kk = 16 * w + 32 * s + 8 * fq + 4 * tt + j; const bool ok = (kk >= qi) && (kk <= qi + 128) && (kk >= 128);
                    const float v = ok ? S[s][tt][j] : -INFINITY; S[s][tt][j] = v; mx = __builtin_fmaxf(mx, v); }
    }
    mx = red_max16(mx); mx = red_max32(mx);
    float l = 0.f;
#pragma unroll
    for (int s = 0; s < 5; ++s)
#pragma unroll
        for (int tt = 0; tt < 2; ++tt)
#pragma unroll
            for (int j = 0; j < 4; ++j) { const float p = __builtin_amdgcn_exp2f(S[s][tt][j] - mx); S[s][tt][j] = p; l += p; }
    l = red_add16(l); l = red_add32(l);
    f32x4 O[4];
#pragma unroll
    for (int db = 0; db < 4; ++db) O[db] = (f32x4){0.f, 0.f, 0.f, 0.f};
    const int q4 = a >> 2, p4 = a & 3;
    __builtin_amdgcn_s_setprio(1);
#pragma unroll
    for (int s = 0; s < 5; ++s) {
        v4u pw; pw.x = cvtpk(S[s][0][0], S[s][0][1]); pw.y = cvtpk(S[s][0][2], S[s][0][3]); pw.z = cvtpk(S[s][1][0], S[s][1][1]); pw.w = cvtpk(S[s][1][2], S[s][1][3]);
        const bf16x8 pf = __builtin_bit_cast(bf16x8, pw);
        LAS const unsigned char* vp = lds + ATT_V + (16 * w + 32 * s + 8 * fq + q4) * KVS + p4 * 8;
#pragma unroll
        for (int db = 0; db < 4; ++db) { const v4i16_t t0 = trread(vp + db * 32), t1 = trread(vp + 4 * KVS + db * 32);
            const bf16x8 vf = (bf16x8){t0[0], t0[1], t0[2], t0[3], t1[0], t1[1], t1[2], t1[3]};
            O[db] = mfma16(vf, pf, O[db]); } }
    __builtin_amdgcn_s_setprio(0);
    const float inv = 1.0f / l;
    bf16* og = (bf16*)(F.ws + WS_OG) + ((size_t)g * MALL + qrow) * 512 + h * 64 + pair16_off(fq);
#pragma unroll
    for (int db = 0; db < 4; db += 2) { u32x2 oa, ob; oa.x = cvtpk(O[db][0] * inv, O[db][1] * inv); oa.y = cvtpk(O[db][2] * inv, O[db][3] * inv);
        ob.x = cvtpk(O[db + 1][0] * inv, O[db + 1][1] * inv); ob.y = cvtpk(O[db + 1][2] * inv, O[db + 1][3] * inv); *(GAS v4u*)(og + 16 * db) = pair16(oa, ob); }
    if (fq == 0) ((float*)(F.ws + WS_LSE))[((size_t)g * MALL + qrow) * 8 + h] = (mx + __builtin_amdgcn_logf(l)) * 0.6931471805599453f;
    asm volatile("s_waitcnt lgkmcnt(0)" ::: "memory"); __builtin_amdgcn_s_barrier(); asm volatile("" ::: "memory");
}
__device__ __forceinline__ float red16(float x) {
    x += __builtin_bit_cast(float, __builtin_amdgcn_update_dpp(0, __builtin_bit_cast(int, x), 0xB1, 0xF, 0xF, false));
    x += __builtin_bit_cast(float, __builtin_amdgcn_update_dpp(0, __builtin_bit_cast(int, x), 0x4E, 0xF, 0xF, false));
    x += __builtin_bit_cast(float, __builtin_amdgcn_update_dpp(0, __builtin_bit_cast(int, x), 0x141, 0xF, 0xF, false));
    x += __builtin_bit_cast(float, __builtin_amdgcn_update_dpp(0, __builtin_bit_cast(int, x), 0x140, 0xF, 0xF, false));
    return x;
}
template <int NQ, int J> __device__ __forceinline__ void sattn_batch(const f32x4 (&q)[NQ], const f32x4 (&kx)[J], const f32x4 (&vx)[J], int m0, int mstep, int tq, bool isnew,
                                                                   float (&mrun)[NQ], float (&lrun)[NQ], f32x4 (&o)[NQ]) {
#pragma unroll
    for (int t = 0; t < NQ; ++t) { const int tt = NQ == 4 ? t : tq; float sv[J]; float bm = -INFINITY;
#pragma unroll
        for (int j = 0; j < J; ++j) { const float d = red16((q[t][0] * kx[j][0] + q[t][1] * kx[j][1]) + (q[t][2] * kx[j][2] + q[t][3] * kx[j][3])); const int m = m0 + j * mstep;
            const bool ok = isnew ? (NQ == 4 ? m <= tt : m == tt) : (NQ == 4 ? m >= tt : true);
            sv[j] = ok ? d : -INFINITY; bm = __builtin_fmaxf(bm, sv[j]); }
        bm = __builtin_fmaxf(bm, __shfl_xor(bm, 16)); bm = __builtin_fmaxf(bm, __shfl_xor(bm, 32));
        const float mnew = __builtin_fmaxf(mrun[t], bm); const float scl = __builtin_amdgcn_exp2f(mrun[t] - mnew); mrun[t] = mnew;
        float ls = 0.f; f32x4 ov = o[t] * scl;
#pragma unroll
        for (int j = 0; j < J; ++j) { const float pj = __builtin_amdgcn_exp2f(sv[j] - mnew); ls += pj; ov += vx[j] * pj; }
        lrun[t] = lrun[t] * scl + ls; o[t] = ov; }
}
template <int NQ> __device__ __forceinline__ void attn_sample_item(Frame& F, const Args& A, int n, int g, int tq, int h) {
    int lane_ = F.lane; asm volatile("" : "+v"(lane_));
    const int lane = lane_, ks = lane >> 4, dc = lane & 15;
    const int Lb = 128 << (2 * g), stride = 1 << (2 * g), first = NQ == 4 ? 0 : tq;
    const float* cache = A.in[2 + g] + (size_t)n * Lb * 1024 + (size_t)(first + ks * stride) * 1024 + h * 64 + dc * 4;
    const size_t itstep = (size_t)4 * stride * 1024;
    const float* newkv = F.out + (g == 0 ? pg8::O_KVS0 : (g == 1 ? pg8::O_KVS1 : pg8::O_KVS2)) + (size_t)(n * 4 + ks) * 1024 + h * 64 + dc * 4;
    const bf16* Z = (const bf16*)(F.ws + WS_Z);
    f32x4 q[NQ];
#pragma unroll
    for (int t = 0; t < NQ; ++t) { const int tt = NQ == 4 ? t : tq; const u32x2 wq = *(const GAS u32x2*)(Z + (size_t)(MP + n * 4 + tt) * EVIN + 512 + g * 1536 + h * 64 + dc * 4);
        q[t] = (f32x4){bflo(wq.x), bfhi(wq.x), bflo(wq.y), bfhi(wq.y)}; }
    float mrun[NQ], lrun[NQ]; f32x4 o[NQ];
#pragma unroll
    for (int t = 0; t < NQ; ++t) { mrun[t] = -INFINITY; lrun[t] = 0.f; o[t] = (f32x4){0.f, 0.f, 0.f, 0.f}; }
    constexpr int J = NQ == 4 ? 4 : 8;
    f32x4 kA[J], vA[J], kB[J], vB[J];
#define SA_LOAD(KX, VX, b) do { _Pragma("unroll") for (int j = 0; j < J; ++j) { const float* p_ = cache + (size_t)((b) * J + j) * itstep; \
        KX[j] = __builtin_nontemporal_load((const GAS f32x4*)p_); VX[j] = __builtin_nontemporal_load((const GAS f32x4*)(p_ + 512)); } } while (0)
    SA_LOAD(kA, vA, 0);
    { f32x4 kn[1], vn[1]; kn[0] = *(const GAS f32x4*)newkv; vn[0] = *(const GAS f32x4*)(newkv + 512);
      sattn_batch<NQ, 1>(q, kn, vn, ks, 0, tq, true, mrun, lrun, o); }
#pragma unroll 1
    for (int bb = 0; bb < 16 / J; ++bb) {
        SA_LOAD(kB, vB, 2 * bb + 1); sattn_batch<NQ, J>(q, kA, vA, 8 * J * bb + ks, 4, tq, false, mrun, lrun, o);
        if (bb < 16 / J - 1) SA_LOAD(kA, vA, 2 * bb + 2);
        sattn_batch<NQ, J>(q, kB, vB, 8 * J * bb + 4 * J + ks, 4, tq, false, mrun, lrun, o);
    }
#undef SA_LOAD
#pragma unroll
    for (int t = 0; t < NQ; ++t) { const int tt = NQ == 4 ? t : tq; f32x4 ov = o[t]; float l = lrun[t];
        l += __shfl_xor(l, 16); l += __shfl_xor(l, 32);
#pragma unroll
        for (int j = 0; j < 4; ++j) { ov[j] += __shfl_xor(ov[j], 16); ov[j] += __shfl_xor(ov[j], 32); }
        const float inv = 1.0f / l; const size_t row = (size_t)MP + n * 4 + tt;
        if (ks == 0) { u32x2 ow; ow.x = cvtpk(ov[0] * inv, ov[1] * inv); ow.y = cvtpk(ov[2] * inv, ov[3] * inv); *(GAS u32x2*)((bf16*)(F.ws + WS_OG) + ((size_t)g * MALL + row) * 512 + h * 64 + dc * 4) = ow; }
        if (lane == 0) ((float*)(F.ws + WS_LSE))[((size_t)g * MALL + row) * 8 + h] = (mrun[t] + __builtin_amdgcn_logf(l)) * 0.6931471805599453f; }
}
__device__ __forceinline__ void p2_attention(Frame& F, const Args& A) {
    for (int i = F.tid; i < 2 * 16 * KVS / 4; i += 512) { const int which = i / (16 * KVS / 4), o = i % (16 * KVS / 4); *(LAS unsigned*)(F.lds + (which ? ATT_V : ATT_K) + 256 * KVS + o * 4) = 0u; }
    __syncthreads();
    const int first_prompt = F.vcu & 1;
    for (int pass = 0; pass < 2; ++pass) {
        if ((pass ^ first_prompt) == 0) {
            if (F.wave < 4) {
                for (int it = F.vcu; it < 1152; it += F.G) { const int n = it / 9, kind = it % 9;
#pragma unroll 1
                    for (int hh = 0; hh < 2; ++hh) { const int h = 2 * F.wave + hh;
                        if (kind == 0) attn_sample_item<4>(F, A, n, 0, 0, h); else attn_sample_item<1>(F, A, n, kind < 5 ? 1 : 2, (kind - 1) & 3, h); } }
            } else {
                for (int pu = F.vcu * 4 + (F.wave - 4); pu < (MP / 16 + 32) * 4; pu += F.G * 4) if ((pu >> 2) >= MP / 16) pool_unit<16>(F, A, pu & 3, pu >> 2);
            }
        } else {
            { KvRegs R; attn_prompt_load(F, F.vcu, F.tid, R);
              for (int u = F.vcu; u < 3072; u += F.G) attn_prompt_unit(F, A, u, u + F.G < 3072 ? u + F.G : -1, R); }
        }
        __syncthreads();
    }
}

template <int PART> __device__ __forceinline__ void p3_combine_pool(Frame& F, const Args& A) {
    const int gw = F.vcu * NWAVES + F.wave, NGW = F.G * NWAVES, lane = F.lane;
    bf16* YAB = (bf16*)(F.ws + WS_YAB); const bf16* OG = (const bf16*)(F.ws + WS_OG); const float* LSE = (const float*)(F.ws + WS_LSE);
    if (PART & 1)
    for (int row0 = gw; row0 < MALL; row0 += 2 * NGW) { const int h = lane >> 3;
        float ls[2][3]; v4u ov[2][3];
#pragma unroll
        for (int r = 0; r < 2; ++r) { const int row = row0 + r * NGW < MALL ? row0 + r * NGW : row0;
#pragma unroll
            for (int g = 0; g < 3; ++g) { ls[r][g] = LSE[((size_t)g * MALL + row) * 8 + h]; ov[r][g] = *(const GAS v4u*)(OG + ((size_t)g * MALL + row) * 512 + lane * 8); } }
#pragma unroll
        for (int r = 0; r < 2; ++r) { const int row = row0 + r * NGW; if (row < MALL) {
            const float mx = __builtin_fmaxf(__builtin_fmaxf(ls[r][0], ls[r][1]), ls[r][2]);
            float wg[3]; float den = 0.f;
#pragma unroll
            for (int g = 0; g < 3; ++g) { wg[g] = __expf(ls[r][g] - mx); den += wg[g]; }
            const float inv = 1.0f / den; float y[8];
#pragma unroll
            for (int k = 0; k < 8; ++k) y[k] = 0.f;
#pragma unroll
            for (int g = 0; g < 3; ++g) { const float ww = wg[g] * inv;
#pragma unroll
                for (int k = 0; k < 4; ++k) { y[2 * k] += ww * bflo(ov[r][g][k]); y[2 * k + 1] += ww * bfhi(ov[r][g][k]); } }
            v4u o; o.x = cvtpk(y[0], y[1]); o.y = cvtpk(y[2], y[3]); o.z = cvtpk(y[4], y[5]); o.w = cvtpk(y[6], y[7]);
            *(GAS v4u*)(YAB + (size_t)row * DM + 512 + lane * 8) = o; } } }
    if (PART & 2) {
        constexpr int TS = 272, TW = 31 * TS + 16  , PWO = 8 * 8448, PWS = 272;
        const bf16* Z = (const bf16*)(F.ws + WS_Z); const bf16* PW = (const bf16*)(F.ws + WS_POOLW);
        const int b = blockIdx.x, gi = b & 3, blk = b >> 2, w = 2 << gi, fq = lane >> 4, a = lane & 15;
        LAS unsigned char* lds = F.lds; LAS unsigned char* tile = lds + F.wave * TW;
        for (int i = F.tid; i < 2048; i += 512) { const int d = i >> 4, ch = i & 15; *(LAS v4u*)(lds + PWO + d * PWS + ch * 16) = *(const GAS v4u*)(PW + ((size_t)(gi * 128 + d)) * 128 + ch * 8); }
        __syncthreads();
        for (int sl = blk * NWAVES + F.wave; sl < MP / 16; sl += (F.G >> 2) * NWAVES) {
            const int row0 = sl * 16, t0 = row0 & (SEQ - 1);
            v4u ld[8];
#pragma unroll
            for (int i = 0; i < 8; ++i) { const int ri = 4 * i + fq; int dt = t0 - 15 + ri; dt = dt < 0 ? 0 : dt; const int ric = ri < 31 ? ri : 30;
                ld[i] = *(const GAS v4u*)(Z + (size_t)(row0 - t0 + (ri < 31 ? dt : t0 + 15)) * EVIN + gi * 128 + a * 8); (void)ric; }
#pragma unroll
            for (int i = 0; i < 8; ++i) { const int ri = 4 * i + fq; if (ri < 31) *(LAS v4u*)(tile + ri * TS + a * 16) = ld[i]; }
            LDS_WAIT(); asm volatile("" ::: "memory");
            const int t = t0 + a; const int jmax = t < w - 1 ? t : w - 1; const float rc = 1.0f / (float)(jmax + 1);
            bf16x8 pf[4];
#pragma unroll
            for (int ks = 0; ks < 4; ++ks) { v4u zz[16];
#pragma unroll
                for (int j = 0; j < 16; ++j) { const int jj = j < jmax ? j : jmax; zz[j] = *(LAS const v4u*)(tile + (15 + a - jj) * TS + (32 * ks + 8 * fq) * 2); }
                float acc[8], x0[8];
#pragma unroll
                for (int k = 0; k < 4; ++k) { x0[2 * k] = bflo(zz[0][k]); x0[2 * k + 1] = bfhi(zz[0][k]); acc[2 * k] = x0[2 * k]; acc[2 * k + 1] = x0[2 * k + 1]; }
#pragma unroll
                for (int j = 1; j < 16; ++j) { const float wgt = j <= jmax ? 1.0f : 0.0f;
#pragma unroll
                    for (int k = 0; k < 4; ++k) { acc[2 * k] += wgt * bflo(zz[j][k]); acc[2 * k + 1] += wgt * bfhi(zz[j][k]); } }
                v4u pw; pw.x = cvtpk(acc[0] * rc - x0[0], acc[1] * rc - x0[1]); pw.y = cvtpk(acc[2] * rc - x0[2], acc[3] * rc - x0[3]);
                pw.z = cvtpk(acc[4] * rc - x0[4], acc[5] * rc - x0[5]); pw.w = cvtpk(acc[6] * rc - x0[6], acc[7] * rc - x0[7]);
                pf[ks] = __builtin_bit_cast(bf16x8, pw); }
            const size_t row = (size_t)row0 + a;
#pragma unroll
            for (int nb = 0; nb < 8; nb += 2) { f32x4 d0 = (f32x4){0.f, 0.f, 0.f, 0.f}, d1 = d0;
#pragma unroll
                for (int ks = 0; ks < 4; ++ks) { const bf16x8 w0 = *(LAS const bf16x8*)(lds + PWO + (16 * nb + a) * PWS + (32 * ks + 8 * fq) * 2), w1 = *(LAS const bf16x8*)(lds + PWO + (16 * nb + 16 + a) * PWS + (32 * ks + 8 * fq) * 2);
                    d0 = mfma16(w0, pf[ks], d0); d1 = mfma16(w1, pf[ks], d1); }
                u32x2 oa, ob; oa.x = cvtpk(d0[0], d0[1]); oa.y = cvtpk(d0[2], d0[3]); ob.x = cvtpk(d1[0], d1[1]); ob.y = cvtpk(d1[2], d1[3]);
                *(GAS v4u*)(YAB + row * DM + gi * 128 + 16 * nb + pair16_off(fq)) = pair16(oa, ob); }
            LDS_WAIT(); asm volatile("" ::: "memory");
        }
        __syncthreads();
    }
}

__device__ __forceinline__ void p9_oddmix(Frame& F, const Args& A) {
    const int gw = F.vcu * NWAVES + F.wave, NGW = F.G * NWAVES, lane = F.lane, tid = F.tid, wv = F.wave;
    const bf16* Z = (const bf16*)(F.ws + WS_Z); bf16* YAB = (bf16*)(F.ws + WS_YAB);
    const float* lng = A.in[14]; const float* lnb = A.in[15]; const float* bs = A.in[17]; const float* cw = A.in[18];
    for (int blk8 = gw; blk8 < MP / 8; blk8 += NGW) { const int r0 = blk8 * 8, t0 = r0 & (SEQ - 1), c = lane * 8;
        v4u gi[10], xi[10], go[8];
#pragma unroll
        for (int i = 0; i < 10; ++i) { const int rr = (t0 == 0 && i < 2) ? r0 : r0 - 2 + i; const bf16* zr = Z + (size_t)rr * ODIN; gi[i] = *(const GAS v4u*)(zr + 1536 + c); xi[i] = *(const GAS v4u*)(zr + 2048 + c); }
#pragma unroll
        for (int i = 0; i < 8; ++i) go[i] = *(const GAS v4u*)(Z + (size_t)(r0 + i) * ODIN + 1024 + c);
        float cwv[3][8];
#pragma unroll
        for (int j = 0; j < 3; ++j)
#pragma unroll
            for (int k = 0; k < 8; ++k) cwv[j][k] = cw[j * 512 + c + k];
        float hd[10][8]; const float z01 = t0 == 0 ? 0.f : 1.f;
#pragma unroll
        for (int i = 0; i < 10; ++i) { const float m = i < 2 ? z01 : 1.f;
#pragma unroll
            for (int k = 0; k < 4; ++k) { hd[i][2 * k] = m * bflo(gi[i][k]) * bflo(xi[i][k]); hd[i][2 * k + 1] = m * bfhi(gi[i][k]) * bfhi(xi[i][k]); } }
#pragma unroll
        for (int i = 0; i < 8; ++i) { float y[8];
#pragma unroll
            for (int k = 0; k < 8; ++k) { const float cv = cwv[0][k] * hd[i][k] + cwv[1][k] * hd[i + 1][k] + cwv[2][k] * hd[i + 2][k]; y[k] = ((k & 1) ? bfhi(go[i][k >> 1]) : bflo(go[i][k >> 1])) * cv; }
            v4u o; o.x = cvtpk(y[0], y[1]); o.y = cvtpk(y[2], y[3]); o.z = cvtpk(y[4], y[5]); o.w = cvtpk(y[6], y[7]);
            *(GAS v4u*)(YAB + (size_t)(r0 + i) * DM + 512 + c) = o; }
        if (t0 == SEQ - 8) { float* co = F.out + pg8::O_CONVP + ((size_t)((r0 >> 13) * 2)) * 512 + c;
#pragma unroll
            for (int j = 0; j < 2; ++j) { *(GAS f32x4*)(co + j * 512) = (f32x4){hd[8 + j][0], hd[8 + j][1], hd[8 + j][2], hd[8 + j][3]}; *(GAS f32x4*)(co + j * 512 + 4) = (f32x4){hd[8 + j][4], hd[8 + j][5], hd[8 + j][6], hd[8 + j][7]}; } } }
    for (int row = MP + gw; row < MALL; row += NGW) { const bool samp = row >= MP; const int ms = row - MP; const int t = samp ? (ms & 3) : (row & (SEQ - 1)); const int nb = samp ? (ms >> 2) : (row >> 13);
        const int c = lane * 8; float hd[3][8];
#pragma unroll
        for (int j = 0; j < 3; ++j) { const int dt = 2 - j;
            if (dt <= t) { const bf16* zr = Z + (size_t)(row - dt) * ODIN; const v4u gi = *(const GAS v4u*)(zr + 1536 + c), xi = *(const GAS v4u*)(zr + 2048 + c); const unsigned* pg = (const unsigned*)&gi; const unsigned* px = (const unsigned*)&xi;
#pragma unroll
                for (int k = 0; k < 4; ++k) { hd[j][2 * k] = bflo(pg[k]) * bflo(px[k]); hd[j][2 * k + 1] = bfhi(pg[k]) * bfhi(px[k]); } }
            else if (samp) { const float* sp = A.in[6] + ((size_t)(nb * 2 + (t + 2 - dt))) * 512 + c; const f32x4 s0 = *(const GAS f32x4*)sp, s1 = *(const GAS f32x4*)(sp + 4);
#pragma unroll
                for (int k = 0; k < 4; ++k) { hd[j][k] = s0[k]; hd[j][4 + k] = s1[k]; } }
            else {
#pragma unroll
                for (int k = 0; k < 8; ++k) hd[j][k] = 0.f; } }
        const v4u go = *(const GAS v4u*)(Z + (size_t)row * ODIN + 1024 + c); const unsigned* pgo = (const unsigned*)&go;
        float y[8];
#pragma unroll
        for (int k = 0; k < 8; ++k) { const float cv = cw[c + k] * hd[0][k] + cw[512 + c + k] * hd[1][k] + cw[1024 + c + k] * hd[2][k]; y[k] = ((k & 1) ? bfhi(pgo[k >> 1]) : bflo(pgo[k >> 1])) * cv; }
        v4u o; o.x = cvtpk(y[0], y[1]); o.y = cvtpk(y[2], y[3]); o.z = cvtpk(y[4], y[5]); o.w = cvtpk(y[6], y[7]);
        *(GAS v4u*)(YAB + (size_t)row * DM + 512 + c) = o;
        float* co = nullptr;
        if (samp) { if (t >= 2) co = F.out + pg8::O_CONVS + ((size_t)(nb * 2 + t - 2)) * 512 + c; } else if (t >= SEQ - 2) co = F.out + pg8::O_CONVP + ((size_t)(nb * 2 + t - (SEQ - 2))) * 512 + c;
        if (co) { *(GAS f32x4*)co = (f32x4){hd[2][0], hd[2][1], hd[2][2], hd[2][3]}; *(GAS f32x4*)(co + 4) = (f32x4){hd[2][4], hd[2][5], hd[2][6], hd[2][7]}; } }
    for (int n = gw; n < 128; n += NGW) { const int c = lane * 8, g = lane >> 4; float vn[4][8];
#pragma unroll
        for (int s = 0; s < 4; ++s) { const v4u vv = *(const GAS v4u*)(Z + (size_t)(MP + n * 4 + s) * ODIN + 512 + c); const unsigned* pv = (const unsigned*)&vv; float x[8]; float sm = 0.f;
#pragma unroll
            for (int k = 0; k < 4; ++k) { x[2 * k] = bflo(pv[k]); x[2 * k + 1] = bfhi(pv[k]); sm += x[2 * k] + x[2 * k + 1]; }
            sm += __shfl_xor(sm, 1); sm += __shfl_xor(sm, 2); sm += __shfl_xor(sm, 4); sm += __shfl_xor(sm, 8);
            const float mu = sm * (1.0f / 128.0f); float q = 0.f;
#pragma unroll
            for (int k = 0; k < 8; ++k) { x[k] -= mu; q += x[k] * x[k]; }
            q += __shfl_xor(q, 1); q += __shfl_xor(q, 2); q += __shfl_xor(q, 4); q += __shfl_xor(q, 8);
            const float rstd = __builtin_amdgcn_rsqf(q * (1.0f / 128.0f) + 1e-6f);
#pragma unroll
            for (int k = 0; k < 8; ++k) vn[s][k] = x[k] * rstd * lng[c + k] + lnb[c + k];
            float* cvo = F.out + pg8::O_CVS + ((size_t)(n * 4 + s)) * 512 + c;
            *(GAS f32x4*)cvo = (f32x4){vn[s][0], vn[s][1], vn[s][2], vn[s][3]}; *(GAS f32x4*)(cvo + 4) = (f32x4){vn[s][4], vn[s][5], vn[s][6], vn[s][7]}; }
#pragma unroll
        for (int t = 0; t < 4; ++t) { float sp[8];
#pragma unroll
            for (int k = 0; k < 8; ++k) sp[k] = bs[g * 128 + t];
#pragma unroll
            for (int s = 0; s <= t; ++s) { const float wts = A.in[16][(g * 128 + t) * 128 + s];
#pragma unroll
                for (int k = 0; k < 8; ++k) sp[k] += wts * vn[s][k]; }
            const v4u uu = *(const GAS v4u*)(Z + (size_t)(MP + n * 4 + t) * ODIN + c); const unsigned* pu = (const unsigned*)&uu;
            v4u o; o.x = cvtpk(bflo(pu[0]) * sp[0], bfhi(pu[0]) * sp[1]); o.y = cvtpk(bflo(pu[1]) * sp[2], bfhi(pu[1]) * sp[3]); o.z = cvtpk(bflo(pu[2]) * sp[4], bfhi(pu[2]) * sp[5]); o.w = cvtpk(bflo(pu[3]) * sp[6], bfhi(pu[3]) * sp[7]);
            *(GAS v4u*)(YAB + (size_t)(MP + n * 4 + t) * DM + c) = o; } }
    const bf16* WT = (const bf16*)(F.ws + WS_WST);
    LAS unsigned char* lds = F.lds; const int fq = lane >> 4, a = lane & 15, q4 = a >> 2, p4 = a & 3;
    for (int un = F.vcu; un < 512; un += F.G) { const int g = un & 3, ck = un >> 2; const int row0 = ck * 128;
        { const int rn = tid >> 2, c0 = (tid & 3) * 32; const bf16* zr = Z + (size_t)(row0 + rn) * ODIN + 512 + g * 128 + c0; float x[32]; float sm = 0.f;
#pragma unroll
          for (int k4 = 0; k4 < 4; ++k4) { const v4u vv = *(const GAS v4u*)(zr + 8 * k4); const unsigned* pv = (const unsigned*)&vv;
#pragma unroll
              for (int k = 0; k < 4; ++k) { x[8 * k4 + 2 * k] = bflo(pv[k]); x[8 * k4 + 2 * k + 1] = bfhi(pv[k]); sm += x[8 * k4 + 2 * k] + x[8 * k4 + 2 * k + 1]; } }
          sm += __shfl_xor(sm, 1); sm += __shfl_xor(sm, 2); const float mu = sm * (1.0f / 128.0f); float q = 0.f;
#pragma unroll
          for (int k = 0; k < 32; ++k) { x[k] -= mu; q += x[k] * x[k]; }
          q += __shfl_xor(q, 1); q += __shfl_xor(q, 2); const float rstd = __builtin_amdgcn_rsqf(q * (1.0f / 128.0f) + 1e-6f);
          const float* gp = lng + g * 128 + c0; const float* bp = lnb + g * 128 + c0;
#pragma unroll
          for (int k4 = 0; k4 < 4; ++k4) { v4u o; unsigned* po = (unsigned*)&o;
#pragma unroll
              for (int k = 0; k < 4; ++k) po[k] = cvtpk(x[8 * k4 + 2 * k] * rstd * gp[8 * k4 + 2 * k] + bp[8 * k4 + 2 * k], x[8 * k4 + 2 * k + 1] * rstd * gp[8 * k4 + 2 * k + 1] + bp[8 * k4 + 2 * k + 1]);
              *(LAS v4u*)(lds + rn * VNS + (c0 + 8 * k4) * 2) = o; } }
        __syncthreads();
        const int t = 16 * wv + a; const int nks = (wv >> 1) + 1;
        f32x4 D[8];
#pragma unroll
        for (int cb = 0; cb < 8; ++cb) D[cb] = (f32x4){0.f, 0.f, 0.f, 0.f};
        for (int ks = 0; ks < nks; ++ks) { const bf16x8 wf = *(const GAS bf16x8*)(WT + ((size_t)(g * 128 + t)) * 128 + 32 * ks + 8 * fq);
            LAS const unsigned char* vp = lds + (32 * ks + 8 * fq + q4) * VNS + p4 * 8;
#pragma unroll
            for (int cb = 0; cb < 8; ++cb) { const v4i16_t t0 = trread(vp + cb * 32), t1 = trread(vp + 4 * VNS + cb * 32);
                const bf16x8 vf = (bf16x8){t0[0], t0[1], t0[2], t0[3], t1[0], t1[1], t1[2], t1[3]};
                D[cb] = mfma16(vf, wf, D[cb]); } }
        const float bt = bs[g * 128 + t]; const size_t row = (size_t)row0 + t;
#pragma unroll
        for (int cb = 0; cb < 8; cb += 2) { const int c = g * 128 + 16 * cb + pair16_off(fq);
            float lo[4], hi[4];
#pragma unroll
            for (int j = 0; j < 4; ++j) { const auto r = __builtin_amdgcn_permlane16_swap(__builtin_bit_cast(unsigned, D[cb][j] + bt), __builtin_bit_cast(unsigned, D[cb + 1][j] + bt), false, false);
                lo[j] = __builtin_bit_cast(float, (unsigned)r[0]); hi[j] = __builtin_bit_cast(float, (unsigned)r[1]); }
            const v4u uu = *(const GAS v4u*)(Z + row * ODIN + c);
            v4u o; o.x = cvtpk(bflo(uu.x) * lo[0], bfhi(uu.x) * lo[1]); o.y = cvtpk(bflo(uu.y) * lo[2], bfhi(uu.y) * lo[3]); o.z = cvtpk(bflo(uu.z) * hi[0], bfhi(uu.z) * hi[1]); o.w = cvtpk(bflo(uu.w) * hi[2], bfhi(uu.w) * hi[3]);
            *(GAS v4u*)(YAB + row * DM + c) = o; }
        __syncthreads(); }
}

__device__ __forceinline__ void p_final(Frame& F, const Args& A, const float* SS) {
    const int gw = F.vcu * NWAVES + F.wave, NGW = F.G * NWAVES;
    const bf16* RB = (const bf16*)(F.ws + WS_RB); const float* gf = A.in[27];
    const GAS f32x4* gg = (const GAS f32x4*)gf + F.lane; f32x4 g4[4];
#pragma unroll
    for (int j = 0; j < 4; ++j) g4[j] = gg[64 * j];
    for (int m0 = gw; m0 < MALL; m0 += 2 * NGW) { u32x2 w[2][4]; float rs[2];
#pragma unroll
        for (int r = 0; r < 2; ++r) { const int m = m0 + r * NGW < MALL ? m0 + r * NGW : m0; rs[r] = pg8::row_rs(SS, m); const GAS u32x2* xr = (const GAS u32x2*)(RB + (size_t)m * DM) + F.lane;
#pragma unroll
            for (int j = 0; j < 4; ++j) w[r][j] = __builtin_nontemporal_load(xr + 64 * j); }
#pragma unroll
        for (int r = 0; r < 2; ++r) { const int m = m0 + r * NGW; if (m < MALL) { GAS f32x4* o = (GAS f32x4*)(F.out + (size_t)m * DM) + F.lane;
#pragma unroll
            for (int j = 0; j < 4; ++j) __builtin_nontemporal_store((f32x4){bflo(w[r][j].x) * g4[j][0], bfhi(w[r][j].x) * g4[j][1], bflo(w[r][j].y) * g4[j][2], bfhi(w[r][j].y) * g4[j][3]} * rs[r], o + 64 * j); } } }
}

constexpr int N_PHASES = 15;
__global__ void __launch_bounds__(NWAVES * 64, 2) mk_fwd(Args args) {
    extern __shared__ __attribute__((aligned(16))) unsigned char lds[];
    Frame F;
    F.lds = (LAS unsigned char*)lds; F.MISC = (volatile LAS unsigned*)(F.lds + MISC_OFF);
    F.tid = threadIdx.x; F.lane = F.tid & 63; F.wave = __builtin_amdgcn_readfirstlane(F.tid >> 6);
    F.G = gridDim.x; { const int bx = blockIdx.x; F.vcu = (F.G % 8 == 0) ? (bx % 8) * (F.G / 8) + bx / 8 : bx; }
    F.out = args.out; F.ws = args.ws; F.ctl = (gu32*)(args.ws + WS_CTL);
    for (int u = F.tid; u < (LDS_BYTES - LDSCTL_OFF) / 4; u += NWAVES * 64) ((LAS unsigned*)(F.lds + LDSCTL_OFF))[u] = 0u;
    __syncthreads();
    const int lo = args.ph_lo, hi = args.ph_hi;
    XcdBarrier bar; bar.bar = (unsigned*)(F.ctl + CW_BAR); bar.x = 0; bar.st = nullptr;
    if (hi - lo > 1) bar = xcd_barrier_post((unsigned*)(F.ctl + CW_BAR), F.MISC + 8);
#define IN(k) (lo <= (k) && (k) < hi)
#define SEAM(k) do { if (IN(k) && IN((k) + 1)) xcd_barrier(bar); } while (0)
#define RSTAB ((LAS float*)(F.lds + LDSCTL_OFF + 1024))
#define SITE_PTRS unsigned char* ws = args.ws; asm volatile("" : "+s"(ws)); bf16* RBb = (bf16*)(ws + WS_RB); float* SSb = (float*)(ws + WS_SS); (void)RBb; (void)SSb;
    constexpr size_t RBN = (size_t)MALL * DM, SSN = (size_t)MALL * 16;
    const int cid = (int)blockIdx.x;
    const int stag = (cid >> 3) & 1;

    if (IN(0)) { SITE_PTRS relaunder(F); p0_prologue(F, args); } SEAM(0);

            if (IN(1)) { SITE_PTRS
                pg8::Gemm g{RBb, (const bf16*)(ws + WS_WEVIN), MP, EVIN, DM}; pg8::StaticOrder S; S.init(MP, EVIN, F.G, cid);
                pg8::EpiEvIn E{(bf16*)(ws + WS_Z), SSb, (const float*)(ws + WS_ROPE), F.out, RSTAB};
                _Pragma("unroll 1") for (int st_ = 0; st_ < 2; ++st_) { if ((st_ ^ stag) == 0) sample_gemm(F.lds, E, g.A, g.Bt, g.N, g.K);
                else pg8::gemm_phase<pg8::EpiEvIn, pg8::StaticOrder, true, true>(F.lds, g, S, E); }
            } SEAM(1);
            if (IN(2)) { SITE_PTRS relaunder(F); p2_attention(F, args); relaunder(F); p3_combine_pool<2>(F, args);
                if (F.G == 256) {
                    pg8::Gemm g2{(const bf16*)(ws + WS_PB), (const bf16*)(ws + WS_WP), MP, DM, 256}; pg8::StaticOrder S2; S2.init(MP, DM, 128, F.vcu >= 128 ? F.vcu - 128 : 256);
                    pg8::EpiPlain E2{(bf16*)(ws + WS_PROJ), DM, nullptr, nullptr};
                    pg8::gemm_phase<pg8::EpiPlain, pg8::StaticOrder, true, true>(F.lds, g2, S2, E2); }
            } SEAM(2);
            if (IN(3)) { SITE_PTRS relaunder(F); p3_combine_pool<1>(F, args); } SEAM(3);
        if (IN(4)) { SITE_PTRS
            pg8::Gemm g{(const bf16*)(ws + WS_YAB), (const bf16*)(ws + WS_WEVOUT), MP, DM, DM}; pg8::StaticOrder S; S.init(MP, DM, F.G, cid);
            pg8::EpiResid<true> E{RBb, nullptr, RBb + (RBN), SSb + (SSN), nullptr, nullptr};
            _Pragma("unroll 1") for (int st_ = 0; st_ < 2; ++st_) { if ((st_ ^ stag) == 0) sample_gemm(F.lds, E, g.A, g.Bt, g.N, g.K);
            else pg8::gemm_phase<pg8::EpiResid<true>, pg8::StaticOrder, true, true>(F.lds, g, S, E); }
        } SEAM(4);
        if (IN(4 + 1)) { SITE_PTRS
            { pg8::Gemm g{RBb + (RBN), (const bf16*)(ws + WS_W1) + (size_t)0 * 1024 * FFD, MP, FFD, DM}; pg8::StaticOrder S; S.init(MP, FFD, F.G, cid);
              pg8::EpiScaled<0> E{(bf16*)(ws + WS_F), FFD, SSb + (SSN), RSTAB};
              _Pragma("unroll 1") for (int st_ = 0; st_ < 2; ++st_) { if ((st_ ^ stag) == 0) sample_gemm(F.lds, E, g.A, g.Bt, g.N, g.K);
              else pg8::gemm_phase<pg8::EpiScaled<0>, pg8::StaticOrder, true, true>(F.lds, g, S, E); } }
        }
        if (IN(4 + 1)) { SITE_PTRS
            { pg8::Gemm g{(const bf16*)(ws + WS_PB) + (size_t)0 * MALL * 256, (const bf16*)(ws + WS_WP) + (size_t)0 * 256 * 1024, MP, DM, 256}; pg8::StaticOrder S; S.init(MP, DM, F.G, cid);
              pg8::EpiPlain E{(bf16*)(ws + WS_PROJ), DM, nullptr, nullptr};
              sample_gemm(F.lds, E, g.A, g.Bt, g.N, g.K);
              if (F.G != 256) pg8::gemm_phase<pg8::EpiPlain, pg8::StaticOrder, true, true>(F.lds, g, S, E); }
        } SEAM(4 + 1);
        if (IN(4 + 2)) { SITE_PTRS
            pg8::Gemm g{(const bf16*)(ws + WS_F), (const bf16*)(ws + WS_W2) + (size_t)0 * 1024 * FFD, MP, DM, FFD}; pg8::StaticOrder S; S.init(MP, DM, F.G, cid);
            pg8::EpiResid<true> E{RBb + RBN, nullptr, RBb + (0), SSb + (0), nullptr, nullptr};
            _Pragma("unroll 1") for (int st_ = 0; st_ < 2; ++st_) { if ((st_ ^ stag) == 0) sample_gemm(F.lds, E, g.A, g.Bt, g.N, g.K);
            else pg8::gemm_phase<pg8::EpiResid<true>, pg8::StaticOrder, true, true>(F.lds, g, S, E); }
        } SEAM(4 + 2);
        if (IN(4 + 3)) { SITE_PTRS
            pg8::Gemm g{RBb + (0), (const bf16*)(ws + WS_WG) + (size_t)0 * 1024 * 1024, MP, DM, DM}; pg8::StaticOrder S; S.init(MP, DM, F.G, cid);
            pg8::EpiPle E{SSb + (0), (const bf16*)(ws + WS_PROJ), RBb + (0), RBb + (RBN), SSb + (SSN), RSTAB};
            _Pragma("unroll 1") for (int st_ = 0; st_ < 2; ++st_) { if ((st_ ^ stag) == 0) sample_gemm(F.lds, E, g.A, g.Bt, g.N, g.K);
            else pg8::gemm_phase<pg8::EpiPle, pg8::StaticOrder, true, true>(F.lds, g, S, E); }
        } SEAM(4 + 3);
            if (IN(8)) { SITE_PTRS
                pg8::Gemm g{RBb + RBN, (const bf16*)(ws + WS_WODIN), MP, ODIN, DM}; pg8::StaticOrder S; S.init(MP, ODIN, F.G, cid);
                pg8::EpiScaled<1> E{(bf16*)(ws + WS_Z), ODIN, SSb + SSN, RSTAB};
                _Pragma("unroll 1") for (int st_ = 0; st_ < 2; ++st_) { if ((st_ ^ stag) == 0) sample_gemm(F.lds, E, g.A, g.Bt, g.N, g.K);
                else pg8::gemm_phase<pg8::EpiScaled<1>, pg8::StaticOrder, true, true>(F.lds, g, S, E); }
                if (F.G == 256) {
                    pg8::Gemm g2{(const bf16*)(ws + WS_PB) + (size_t)1 * MALL * 256, (const bf16*)(ws + WS_WP) + (size_t)1 * 256 * 1024, MP, DM, 256}; pg8::StaticOrder S2; S2.init(MP, DM, 128, cid >= 128 ? cid - 128 : 256);
                    pg8::EpiPlain E2{(bf16*)(ws + WS_PROJ), DM, nullptr, nullptr};
                    pg8::gemm_phase<pg8::EpiPlain, pg8::StaticOrder, true, true>(F.lds, g2, S2, E2); }
            } SEAM(8);
            if (IN(9)) { SITE_PTRS relaunder(F); p9_oddmix(F, args); } SEAM(9);
        if (IN(10)) { SITE_PTRS
            pg8::Gemm g{(const bf16*)(ws + WS_YAB), (const bf16*)(ws + WS_WODOUT), MP, DM, DM}; pg8::StaticOrder S; S.init(MP, DM, F.G, cid);
            pg8::EpiResid<true> E{RBb + RBN, nullptr, RBb + (0), SSb + (0), nullptr, nullptr};
            _Pragma("unroll 1") for (int st_ = 0; st_ < 2; ++st_) { if ((st_ ^ stag) == 0) sample_gemm(F.lds, E, g.A, g.Bt, g.N, g.K);
            else pg8::gemm_phase<pg8::EpiResid<true>, pg8::StaticOrder, true, true>(F.lds, g, S, E); }
        } SEAM(10);
        if (IN(10 + 1)) { SITE_PTRS
            { pg8::Gemm g{RBb + (0), (const bf16*)(ws + WS_W1) + (size_t)1 * 1024 * FFD, MP, FFD, DM}; pg8::StaticOrder S; S.init(MP, FFD, F.G, cid);
              pg8::EpiScaled<0> E{(bf16*)(ws + WS_F), FFD, SSb + (0), RSTAB};
              _Pragma("unroll 1") for (int st_ = 0; st_ < 2; ++st_) { if ((st_ ^ stag) == 0) sample_gemm(F.lds, E, g.A, g.Bt, g.N, g.K);
              else pg8::gemm_phase<pg8::EpiScaled<0>, pg8::StaticOrder, true, true>(F.lds, g, S, E); } }
        }
        if (IN(10 + 1)) { SITE_PTRS
            { pg8::Gemm g{(const bf16*)(ws + WS_PB) + (size_t)1 * MALL * 256, (const bf16*)(ws + WS_WP) + (size_t)1 * 256 * 1024, MP, DM, 256}; pg8::StaticOrder S; S.init(MP, DM, F.G, cid);
              pg8::EpiPlain E{(bf16*)(ws + WS_PROJ), DM, nullptr, nullptr};
              sample_gemm(F.lds, E, g.A, g.Bt, g.N, g.K);
              if (F.G != 256) pg8::gemm_phase<pg8::EpiPlain, pg8::StaticOrder, true, true>(F.lds, g, S, E); }
        } SEAM(10 + 1);
        if (IN(10 + 2)) { SITE_PTRS
            pg8::Gemm g{(const bf16*)(ws + WS_F), (const bf16*)(ws + WS_W2) + (size_t)1 * 1024 * FFD, MP, DM, FFD}; pg8::StaticOrder S; S.init(MP, DM, F.G, cid);
            pg8::EpiResid<true> E{RBb, nullptr, RBb + (RBN), SSb + (SSN), nullptr, nullptr};
            _Pragma("unroll 1") for (int st_ = 0; st_ < 2; ++st_) { if ((st_ ^ stag) == 0) sample_gemm(F.lds, E, g.A, g.Bt, g.N, g.K);
            else pg8::gemm_phase<pg8::EpiResid<true>, pg8::StaticOrder, true, true>(F.lds, g, S, E); }
        } SEAM(10 + 2);
        if (IN(10 + 3)) { SITE_PTRS
            pg8::Gemm g{RBb + (RBN), (const bf16*)(ws + WS_WG) + (size_t)1 * 1024 * 1024, MP, DM, DM}; pg8::StaticOrder S; S.init(MP, DM, F.G, cid);
            pg8::EpiPle E{SSb + (SSN), (const bf16*)(ws + WS_PROJ), RBb + (RBN), RBb + (0), SSb + (0), RSTAB};
            _Pragma("unroll 1") for (int st_ = 0; st_ < 2; ++st_) { if ((st_ ^ stag) == 0) sample_gemm(F.lds, E, g.A, g.Bt, g.N, g.K);
            else pg8::gemm_phase<pg8::EpiPle, pg8::StaticOrder, true, true>(F.lds, g, S, E); }
        } SEAM(10 + 3);
    if (IN(14)) { SITE_PTRS relaunder(F); p_final(F, args, SSb); }
#undef IN
#undef SEAM
}

extern "C" void kernel_launch(void* const* d_in, const int* in_sizes, int n_in, void* d_out, int out_size, void* d_ws, size_t ws_size, hipStream_t stream) {
    static int grid = 0;
    if (grid == 0) {
        if (n_in != 28 || out_size != (int)pg8::O_END || ws_size < WS_END) { fprintf(stderr, "kernel_launch: unexpected shapes n_in %d out %d ws %zu\n", n_in, out_size, ws_size); grid = -1; return; }
        int dev = 0, cus = 0, per_cu = 0;
        if (hipGetDevice(&dev) != hipSuccess || hipDeviceGetAttribute(&cus, hipDeviceAttributeMultiprocessorCount, dev) != hipSuccess) { grid = -1; return; }
        if (hipFuncSetAttribute((const void*)mk_fwd, hipFuncAttributeMaxDynamicSharedMemorySize, LDS_BYTES) != hipSuccess) { fprintf(stderr, "kernel_launch: hipFuncSetAttribute failed\n"); grid = -1; return; }
        if (hipOccupancyMaxActiveBlocksPerMultiprocessor(&per_cu, (const void*)mk_fwd, NWAVES * 64, LDS_BYTES) != hipSuccess || per_cu < 1) fprintf(stderr, "kernel_launch: occupancy query says %d\n", per_cu);
        (void)hipGetLastError();
        grid = cus;
    }
    if (grid < 0) return;
    (void)in_sizes;
    if (hipMemsetAsync((char*)d_ws + WS_CTL, 0, CTL_ZERO_BYTES, stream) != hipSuccess) return;
    Args a{};
    for (int i = 0; i < 28; ++i) a.in[i] = (const float*)d_in[i];
    a.out = (float*)d_out; a.ws = (unsigned char*)d_ws;
    a.ph_lo = 0; a.ph_hi = N_PHASES;
    hipLaunchKernelGGL(mk_fwd, dim3(grid), dim3(NWAVES * 64), LDS_BYTES, stream, a);
}
```

```cpp
#include <hip/hip_runtime.h>
#include <cstdio>
#include <cstdint>
#include <cmath>
namespace pg8 {
#define PG8_LAS __attribute__((address_space(3)))
#define PG8_GAS __attribute__((address_space(1)))
typedef unsigned short bf16_t;
typedef short bf16x8 __attribute__((ext_vector_type(8)));
typedef float f32x4 __attribute__((ext_vector_type(4)));
typedef unsigned u32x4 __attribute__((ext_vector_type(4)));
constexpr int BM = 256, BK = 64, HALF = 128, HTB = HALF * BK * 2  , STAGE_BYTES = 8 * HTB, NXCD = 8, WGM = 8;

__host__ __device__ __forceinline__ int lds_byte(int r, int c) { const int st = (r >> 4) * 2 + (c >> 5), rr = r & 15, cc = c & 31, ob = rr * 64 + cc * 2; return st * 1024 + (ob ^ (((ob >> 9) & 1) << 5)); }
__host__ __device__ __forceinline__ void stage_rc(int b, int& R, int& C) { const int st = b / 1024, sb = b % 1024, swz = sb ^ (((sb >> 9) & 1) << 5); R = (st >> 1) * 16 + swz / 64; C = (st & 1) * 32 + (swz % 64) / 2; }
__host__ __device__ __forceinline__ int perm32(int rho) { const int n = rho >> 4, i = rho & 15; return 8 * (i >> 2) + 4 * n + (i & 3); }

struct Unit { int pm, pn; };
struct Gemm { const bf16_t* A; const bf16_t* Bt; int M, N, K; };

struct StaticOrder {
    int nM, nN, nwg, G, c;
    __host__ __device__ void init(int M, int N, int G_, int c_) { nM = M / BM; nN = N / BM; nwg = nM * nN; G = G_; c = c_; }
    __host__ __device__ bool next(int i, Unit& u) const {
        const long L = (long)i * G + c; if (L >= nwg) return false;
        int wgid = (int)L; { const int q = nwg / NXCD, r = nwg % NXCD, xcd = wgid % NXCD, off = wgid / NXCD; wgid = (xcd < r ? xcd * (q + 1) : r * (q + 1) + (xcd - r) * q) + off; }
        const int nig = WGM * nN, gid = wgid / nig, fm = gid * WGM, gsz = (nM - fm) < WGM ? (nM - fm) : WGM;
        u.pm = fm + ((wgid % nig) % gsz); u.pn = (wgid % nig) / gsz; return true;
    }
    __device__ __forceinline__ void a_ready(const Unit&) const {}
    __device__ __forceinline__ void done(const Unit&) const {}
};

typedef float f32x2c __attribute__((ext_vector_type(2))); typedef __bf16 bf16x2c __attribute__((ext_vector_type(2)));
__device__ __forceinline__ unsigned cvt_pk_bf16(float lo, float hi) { const f32x2c v = {lo, hi}; return __builtin_bit_cast(unsigned, __builtin_convertvector(v, bf16x2c)); }
typedef float f32x2 __attribute__((ext_vector_type(2)));
typedef unsigned u32x2 __attribute__((ext_vector_type(2)));
constexpr int DM = 1024, SEQ = 8192, MP = 2 * SEQ, MS = 512, MALL = MP + MS;
constexpr int EVIN = 5120, ODIN = 2560, FFD = 4096;
constexpr float C2 = 0.125f * 1.4426950408889634f;
constexpr size_t O_YP = 0, O_YS = O_YP + (size_t)MP * DM, O_KVP0 = O_YS + (size_t)MS * DM, O_KVP1 = O_KVP0 + 2 * 128 * 1024, O_KVP2 = O_KVP1 + 2 * 512 * 1024,
                 O_KVS0 = O_KVP2 + 2 * 2048 * 1024, O_KVS1 = O_KVS0 + (size_t)MS * 1024, O_KVS2 = O_KVS1 + (size_t)MS * 1024, O_POOLP = O_KVS2 + (size_t)MS * 1024,
                 O_POOLS = O_POOLP + 2 * 15 * 512, O_CONVP = O_POOLS + 128 * 15 * 512, O_CONVS = O_CONVP + 2 * 2 * 512, O_CVS = O_CONVS + 128 * 2 * 512, O_END = O_CVS + (size_t)MS * 512;
static_assert(O_END == 25773056, "output size");

__device__ __forceinline__ float row_rs(const float* SS, int row) {
    const PG8_GAS f32x4* p = (const PG8_GAS f32x4*)(SS + (size_t)row * 16);
    const f32x4 a = p[0], b = p[1], c = p[2], d = p[3];
    const float s = (((a[0] + a[1]) + (a[2] + a[3])) + ((b[0] + b[1]) + (b[2] + b[3]))) + (((c[0] + c[1]) + (c[2] + c[3])) + ((d[0] + d[1]) + (d[2] + d[3])));
    return __builtin_amdgcn_rsqf(s * (1.0f / 1024.0f) + 1e-6f);
}
__device__ __forceinline__ u32x4 pack8(const f32x4 v0, const f32x4 v1) { u32x4 w; w.x = cvt_pk_bf16(v0[0], v0[1]); w.y = cvt_pk_bf16(v0[2], v0[3]); w.z = cvt_pk_bf16(v1[0], v1[1]); w.w = cvt_pk_bf16(v1[2], v1[3]); return w; }
__device__ __forceinline__ u32x2 pack4(const f32x4 v) { u32x2 w; w.x = cvt_pk_bf16(v[0], v[1]); w.y = cvt_pk_bf16(v[2], v[3]); return w; }
__device__ __forceinline__ float bf_lo(unsigned w) { return __builtin_bit_cast(float, w << 16); }
__device__ __forceinline__ float bf_hi(unsigned w) { return __builtin_bit_cast(float, w & 0xffff0000u); }

__device__ __forceinline__ void st16(void* base, size_t off, const u32x4 v) { *(PG8_GAS u32x4*)((PG8_GAS char*)base + off) = v; }
__device__ __forceinline__ void st8(void* base, size_t off, const u32x2 v) { *(PG8_GAS u32x2*)((PG8_GAS char*)base + off) = v; }
__device__ __forceinline__ void stf8(float* p, const f32x4 v0, const f32x4 v1) { *(PG8_GAS f32x4*)p = v0; *(PG8_GAS f32x4*)(p + 4) = v1; }
#define PG8_EPI_CALL \
    __device__ __forceinline__ void operator()(const f32x4 (&acc)[2][2][4][2], const Unit& u, int wr_, int wc_, int fr_, int fq_, bool fresh) const { \
        int wr = wr_, wc = wc_, fr = fr_, fq = fq_; asm volatile("" : "+s"(wr), "+s"(wc), "+v"(fr), "+v"(fq));     \
        float rsv[2][4]; \
        if constexpr (USE_RS) { PG8_LAS float* tab = rstab + (wr * 4 + wc) * 128; const int ln = fq * 16 + fr; \
            if (fresh) { _Pragma("unroll") for (int ai = 0; ai < 2; ++ai) tab[ai * 64 + ln] = row_rs(SS, u.pm * BM + ai * HALF + wr * 64 + ln);     \
                asm volatile("s_waitcnt lgkmcnt(0)" ::: "memory"); } \
            _Pragma("unroll") for (int ai = 0; ai < 2; ++ai) _Pragma("unroll") for (int m = 0; m < 4; ++m) rsv[ai][m] = tab[ai * 64 + m * 16 + fr]; \
        } else { _Pragma("unroll") for (int ai = 0; ai < 2; ++ai) _Pragma("unroll") for (int m = 0; m < 4; ++m) rsv[ai][m] = 0.f; } \
        _Pragma("unroll") for (int ai = 0; ai < 2; ++ai) _Pragma("unroll") for (int m = 0; m < 4; ++m) { \
            const f32x4 a[2][2] = {{acc[ai][0][m][0], acc[ai][0][m][1]}, {acc[ai][1][m][0], acc[ai][1][m][1]}}; \
            rg(a, u.pm * BM + ai * HALF + wr * 64 + m * 16 + fr, u.pn, wc, fq, rsv[ai][m]); } }

struct EpiEvIn {
    static constexpr bool PERM = true, AFTER_DRAIN = false, USE_RS = true;
    bf16_t* Z; const float* SS; const float* rope; float* out; PG8_LAS float* rstab;
    __device__ __forceinline__ void rg(const f32x4 (&a)[2][2], int row, int pn, int wc, int fq, float rs) const {
        const int part = pn < 2 ? 0 : (pn - 2) % 6, g = pn < 2 ? 0 : (pn - 2) / 6;
        const int kind = pn < 2 ? 3 : (part >> 1);
        const int hoff = (part & 1) * 4;
        const int keep = 128 << (2 * g);
        float* kvp = out + (g == 0 ? O_KVP0 : (g == 1 ? O_KVP1 : O_KVP2));
        float* kvs = out + (g == 0 ? O_KVS0 : (g == 1 ? O_KVS1 : O_KVS2));
        const bool samp = row >= MP; const int ms = row - MP;
        const int t = samp ? (ms & 3) : (row & (SEQ - 1));
        const int nb = samp ? (ms >> 2) : (row >> 13);
        const size_t zro = ((size_t)row * EVIN + pn * BM) * 2;
        const int cb = wc * 64 + 8 * fq;
        if (kind == 3) {
#pragma unroll
            for (int bj = 0; bj < 2; ++bj) { const f32x4 v0 = a[bj][0] * rs, v1 = a[bj][1] * rs; const int ct = cb + 32 * bj;
                st16(Z, zro + ct * 2, pack8(v0, v1));
                const int ch = pn * BM + ct;
                if (samp) stf8(out + O_POOLS + (size_t)(nb * 15 + 11 + t) * 512 + ch, v0, v1);
                else if (t >= SEQ - 15) stf8(out + O_POOLP + (size_t)(nb * 15 + (t - (SEQ - 15))) * 512 + ch, v0, v1); }
        } else if (kind == 2) {
#pragma unroll
            for (int bj = 0; bj < 2; ++bj) { const f32x4 v0 = a[bj][0] * rs, v1 = a[bj][1] * rs; const int ct = cb + 32 * bj;
                st16(Z, zro + ct * 2, pack8(v0, v1));
                const int hd = hoff * 64 + ct;
                if (samp) stf8(kvs + ((size_t)ms * 2 + 1) * 512 + hd, v0, v1);
                else if (t >= SEQ - keep) stf8(kvp + ((size_t)(nb * keep + (t - (SEQ - keep))) * 2 + 1) * 512 + hd, v0, v1); }
        } else {
            const int pos = samp ? 2048 + t : t;
            const PG8_GAS f32x4* tp = (const PG8_GAS f32x4*)(rope + ((size_t)pos * 32 + 8 * fq) * 2);
            const float sc = (kind == 0) ? C2 * rs : rs;
            f32x4 o1[2], o2[2];
#pragma unroll
            for (int n = 0; n < 2; ++n) { const f32x4 cs0 = tp[2 * n], cs1 = tp[2 * n + 1];
                const f32x4 x1 = a[0][n] * sc, x2 = a[1][n] * sc;
                o1[n][0] = x1[0] * cs0[0] - x2[0] * cs0[1]; o2[n][0] = x2[0] * cs0[0] + x1[0] * cs0[1];
                o1[n][1] = x1[1] * cs0[2] - x2[1] * cs0[3]; o2[n][1] = x2[1] * cs0[2] + x1[1] * cs0[3];
                o1[n][2] = x1[2] * cs1[0] - x2[2] * cs1[1]; o2[n][2] = x2[2] * cs1[0] + x1[2] * cs1[1];
                o1[n][3] = x1[3] * cs1[2] - x2[3] * cs1[3]; o2[n][3] = x2[3] * cs1[2] + x1[3] * cs1[3]; }
            st16(Z, zro + cb * 2, pack8(o1[0], o1[1])); st16(Z, zro + (cb + 32) * 2, pack8(o2[0], o2[1]));
            if (kind == 1) {
                const int hd = (hoff + wc) * 64 + 8 * fq;
                float* p = nullptr;
                if (samp) p = kvs + ((size_t)ms * 2) * 512 + hd; else if (t >= SEQ - keep) p = kvp + ((size_t)(nb * keep + (t - (SEQ - keep))) * 2) * 512 + hd;
                if (p) { stf8(p, o1[0], o1[1]); stf8(p + 32, o2[0], o2[1]); }
            }
        }
    }
    PG8_EPI_CALL
};
struct EpiPlain {
    static constexpr bool PERM = true, AFTER_DRAIN = false, USE_RS = false;
    bf16_t* O; int ldc; const float* SS; PG8_LAS float* rstab;
    __device__ __forceinline__ void rg(const f32x4 (&a)[2][2], int row, int pn, int wc, int fq, float rs) const {
        const size_t rowo = ((size_t)row * ldc + pn * BM + wc * 64 + 8 * fq) * 2;
#pragma unroll
        for (int bj = 0; bj < 2; ++bj) st16(O, rowo + bj * 32 * 2, pack8(a[bj][0], a[bj][1]));
    }
    PG8_EPI_CALL
};
template <int MODE> struct EpiScaled {
    static constexpr bool PERM = true, AFTER_DRAIN = false, USE_RS = true;
    bf16_t* O; int ldc; const float* SS; PG8_LAS float* rstab;
    __device__ __forceinline__ void rg(const f32x4 (&a)[2][2], int row, int pn, int wc, int fq, float rs) const {
        const bool act = (MODE == 0) || (pn < 4);
        const size_t rowo = ((size_t)row * ldc + pn * BM + wc * 64 + 8 * fq) * 2;
#pragma unroll
        for (int bj = 0; bj < 2; ++bj) { f32x4 v[2] = {a[bj][0] * rs, a[bj][1] * rs};
            if (MODE == 0) {
#pragma unroll
                for (int n = 0; n < 2; ++n)
#pragma unroll
                    for (int j = 0; j < 4; ++j) { const float x = __builtin_fmaxf(v[n][j], 0.f); v[n][j] = x * x; }
            } else if (act) {
#pragma unroll
                for (int n = 0; n < 2; ++n)
#pragma unroll
                    for (int j = 0; j < 4; ++j) { const float x = v[n][j]; const float uu = x * (0.7978845608028654f + 0.035677408136300125f * x * x);
                        v[n][j] = x * __builtin_amdgcn_rcpf(1.0f + __builtin_amdgcn_exp2f(-2.8853900817779268f * uu)); }
            }
            st16(O, rowo + bj * 32 * 2, pack8(v[0], v[1])); }
    }
    PG8_EPI_CALL
};
template <bool BASE_BF16> struct EpiResid {
    static constexpr bool PERM = true, AFTER_DRAIN = false, USE_RS = false;
    const void* baseP; const void* baseS; bf16_t* RB; float* SSo; const float* SS; PG8_LAS float* rstab;
    __device__ __forceinline__ void rg(const f32x4 (&a)[2][2], int row, int pn, int wc, int fq, float rs) const {
        const int col0 = pn * BM + wc * 64 + 8 * fq;
        float sq = 0.f;
#pragma unroll
        for (int bj = 0; bj < 2; ++bj) { f32x4 v0, v1;
            if (BASE_BF16) { const u32x4 b = *(const PG8_GAS u32x4*)((const bf16_t*)baseP + (size_t)row * DM + col0 + bj * 32);
                v0 = (f32x4){bf_lo(b.x), bf_hi(b.x), bf_lo(b.y), bf_hi(b.y)} + a[bj][0]; v1 = (f32x4){bf_lo(b.z), bf_hi(b.z), bf_lo(b.w), bf_hi(b.w)} + a[bj][1]; }
            else { const float* bp = (row < MP ? (const float*)baseP + (size_t)row * DM : (const float*)baseS + (size_t)(row - MP) * DM) + col0 + bj * 32;
                v0 = *(const PG8_GAS f32x4*)bp + a[bj][0]; v1 = *(const PG8_GAS f32x4*)(bp + 4) + a[bj][1]; }
            st16(RB, ((size_t)row * DM + col0 + bj * 32) * 2, pack8(v0, v1));
            sq += ((v0[0] * v0[0] + v0[1] * v0[1]) + (v0[2] * v0[2] + v0[3] * v0[3])) + ((v1[0] * v1[0] + v1[1] * v1[1]) + (v1[2] * v1[2] + v1[3] * v1[3])); }
        sq += __shfl_xor(sq, 16); sq += __shfl_xor(sq, 32);
        if (fq == 0) *(PG8_GAS float*)(SSo + (size_t)row * 16 + pn * 4 + wc) = sq;
    }
    PG8_EPI_CALL
};
struct EpiPle {
    static constexpr bool PERM = true, AFTER_DRAIN = false, USE_RS = true;
    const float* SS; const bf16_t* PROJ; const bf16_t* RBi; bf16_t* RB; float* SSo; PG8_LAS float* rstab;
    __device__ __forceinline__ void rg(const f32x4 (&a)[2][2], int row, int pn, int wc, int fq, float rs) const {
        const int col0 = pn * BM + wc * 64 + 8 * fq;
        rs *= -1.4426950408889634f;
        float sq = 0.f;
#pragma unroll
        for (int bj = 0; bj < 2; ++bj) { const size_t off = (size_t)row * DM + col0 + bj * 32;
            const u32x4 pj = *(const PG8_GAS u32x4*)(PROJ + off), b = *(const PG8_GAS u32x4*)(RBi + off);
            const f32x4 a0 = a[bj][0] * rs, a1 = a[bj][1] * rs;
            f32x4 g0, g1;
#pragma unroll
            for (int j = 0; j < 4; ++j) { g0[j] = __builtin_amdgcn_rcpf(1.0f + __builtin_amdgcn_exp2f(a0[j])); g1[j] = __builtin_amdgcn_rcpf(1.0f + __builtin_amdgcn_exp2f(a1[j])); }
            f32x4 v0, v1;
            v0[0] = bf_lo(b.x) + g0[0] * bf_lo(pj.x); v0[1] = bf_hi(b.x) + g0[1] * bf_hi(pj.x); v0[2] = bf_lo(b.y) + g0[2] * bf_lo(pj.y); v0[3] = bf_hi(b.y) + g0[3] * bf_hi(pj.y);
            v1[0] = bf_lo(b.z) + g1[0] * bf_lo(pj.z); v1[1] = bf_hi(b.z) + g1[1] * bf_hi(pj.z); v1[2] = bf_lo(b.w) + g1[2] * bf_lo(pj.w); v1[3] = bf_hi(b.w) + g1[3] * bf_hi(pj.w);
            st16(RB, off * 2, pack8(v0, v1));
            sq += ((v0[0] * v0[0] + v0[1] * v0[1]) + (v0[2] * v0[2] + v0[3] * v0[3])) + ((v1[0] * v1[0] + v1[1] * v1[1]) + (v1[2] * v1[2] + v1[3] * v1[3])); }
        sq += __shfl_xor(sq, 16); sq += __shfl_xor(sq, 32);
        if (fq == 0) *(PG8_GAS float*)(SSo + (size_t)row * 16 + pn * 4 + wc) = sq;
    }
    PG8_EPI_CALL
};
template <class Epi, class Sched, bool ALIGN_EPI = false, bool SP2 = false>
__device__ __forceinline__ void gemm_phase(PG8_LAS unsigned char* lds, const Gemm g, const Sched& S, const Epi& E) {
    int tid_ = threadIdx.x; asm volatile("" : "+v"(tid_));
    const int tid = tid_, wid = __builtin_amdgcn_readfirstlane(tid >> 6), lane = tid & 63, wr = wid >> 2, wc = wid & 3, fr = lane & 15, fq = lane >> 4;
    int K_ = g.K; asm volatile("" : "+s"(K_));
    const int K = K_, nt = K / BK;
    unsigned voffA[2], voffB[2];
#pragma unroll
    for (int i = 0; i < 2; ++i) { int R, C; stage_rc(tid * 16 + i * 8192, R, C); const int Rb = Epi::PERM ? (64 * (R >> 5) + perm32(R & 31)) : R;
        voffA[i] = (unsigned)(R * K + C) * 2u; voffB[i] = (unsigned)(Rb * K + C) * 2u; }
    const size_t kstep = (size_t)(BK * 2);
    const size_t hstep = (size_t)HALF * K * 2;
    const size_t tstep = 2 * hstep;
    const size_t bstep = Epi::PERM ? (size_t)32 * K * 2 : hstep;
    const unsigned ldsw = (unsigned)wid * 1024u;
    const int aoff = lds_byte(wr * 64 + fr, fq * 8), boff = lds_byte(wc * 32 + fr, fq * 8);
#define PG8_SA(b, h) (((b) * 2 + (h)) * HTB)
#define PG8_SB(b, h) ((4 + (b) * 2 + (h)) * HTB)
#define PG8_STAGE(bufoff, gbase, voff) do { _Pragma("unroll") for (int _i = 0; _i < 2; ++_i) \
        __builtin_amdgcn_global_load_lds((const unsigned*)((const char*)(gbase) + (voff)[_i]), (PG8_LAS unsigned*)(lds + (bufoff) + ldsw + _i * 8192), 16, 0, 0); } while (0)
#define PG8_LDA(dst, b, h) do { _Pragma("unroll") for (int m = 0; m < 4; ++m) _Pragma("unroll") for (int k = 0; k < 2; ++k) dst[m][k] = *(const PG8_LAS bf16x8*)(lds + PG8_SA(b, h) + aoff + m * 2048 + k * 1024); } while (0)
#define PG8_LDB(dst, b, h) do { _Pragma("unroll") for (int n = 0; n < 2; ++n) _Pragma("unroll") for (int k = 0; k < 2; ++k) dst[n][k] = *(const PG8_LAS bf16x8*)(lds + PG8_SB(b, h) + boff + n * 2048 + k * 1024); } while (0)
#define PG8_MMA(ai, bj, At, Bt) do { __builtin_amdgcn_s_setprio(1); _Pragma("unroll") for (int m = 0; m < 4; ++m) _Pragma("unroll") for (int n = 0; n < 2; ++n) _Pragma("unroll") for (int k = 0; k < 2; ++k) \
        acc[ai][bj][m][n] = __builtin_amdgcn_mfma_f32_16x16x32_bf16(Bt[n][k], At[m][k], acc[ai][bj][m][n], 0, 0, 0); __builtin_amdgcn_s_setprio(0); } while (0)
#define PG8_WAIT_V(n) asm volatile("s_waitcnt vmcnt(" #n ")" ::: "memory")
#define PG8_WAIT_L(n) asm volatile("s_waitcnt lgkmcnt(" #n ")" ::: "memory")
#define PG8_BAR __builtin_amdgcn_s_barrier()
#define PG8_SCHED __builtin_amdgcn_sched_barrier(0)
    Unit cur, nxt; int ui = 0, rs_pm = -1;
    if (!S.next(0, cur)) return;
    f32x4 acc[2][2][4][2];
#pragma unroll
    for (int a = 0; a < 2; ++a)
#pragma unroll
        for (int b = 0; b < 2; ++b)
#pragma unroll
            for (int m = 0; m < 4; ++m)
#pragma unroll
                for (int n = 0; n < 2; ++n) acc[a][b][m][n] = (f32x4){0.f, 0.f, 0.f, 0.f};
    bf16x8 At[4][2], B0[2][2], B1[2][2];
    const char* cA = (const char*)g.A + (size_t)cur.pm * tstep; const char* cB = (const char*)g.Bt + (size_t)cur.pn * tstep;
    S.a_ready(cur);
    if constexpr (SP2) {
        PG8_STAGE(PG8_SB(0, 0), cB, voffB); PG8_STAGE(PG8_SB(0, 1), cB + bstep, voffB); PG8_STAGE(PG8_SA(0, 0), cA, voffA); PG8_STAGE(PG8_SA(0, 1), cA + hstep, voffA);
        if (wr == 1) PG8_BAR;
        PG8_WAIT_V(2); PG8_BAR;
        PG8_STAGE(PG8_SB(1, 0), cB + kstep, voffB); PG8_STAGE(PG8_SA(1, 0), cA + kstep, voffA); PG8_STAGE(PG8_SB(1, 1), cB + bstep + kstep, voffB);
        PG8_WAIT_V(6); PG8_BAR;
    } else {
        PG8_STAGE(PG8_SB(0, 0), cB, voffB); PG8_STAGE(PG8_SA(0, 0), cA, voffA); PG8_STAGE(PG8_SB(0, 1), cB + bstep, voffB); PG8_STAGE(PG8_SA(0, 1), cA + hstep, voffA);
        if (wr == 1) PG8_BAR;
        PG8_WAIT_V(4); PG8_BAR;
        PG8_STAGE(PG8_SB(1, 0), cB + kstep, voffB); PG8_STAGE(PG8_SA(1, 0), cA + kstep, voffA); PG8_STAGE(PG8_SB(1, 1), cB + bstep + kstep, voffB);
        PG8_WAIT_V(6); PG8_BAR;
    }
    for (;;) {
        const bool has_next = S.next(ui + 1, nxt);
        const char* nA = has_next ? (const char*)g.A + (size_t)nxt.pm * tstep : cA; const char* nB = has_next ? (const char*)g.Bt + (size_t)nxt.pn * tstep : cB;
        for (int t = 0; t < nt; t += 2) {
            const bool last = (t == nt - 2);
            const char* a1 = cA + (size_t)(t + 1) * kstep;
            const char* a2 = last ? nA : cA + (size_t)(t + 2) * kstep; const char* b2 = last ? nB : cB + (size_t)(t + 2) * kstep;
            const char* a3 = a2 + kstep; const char* b3 = b2 + kstep;
            if (last && has_next) S.a_ready(nxt);
            if constexpr (SP2) {
            PG8_LDB(B0, 0, 0); PG8_LDB(B1, 0, 1); PG8_SCHED; PG8_LDA(At, 0, 0); PG8_STAGE(PG8_SA(1, 1), a1 + hstep, voffA);
            PG8_WAIT_V(8); PG8_WAIT_L(0); PG8_BAR; PG8_MMA(0, 0, At, B0); PG8_MMA(0, 1, At, B1); PG8_BAR; PG8_SCHED;
            PG8_LDA(At, 0, 1); PG8_STAGE(PG8_SB(0, 0), b2, voffB); PG8_STAGE(PG8_SB(0, 1), b2 + bstep, voffB); PG8_STAGE(PG8_SA(0, 0), a2, voffA);
            PG8_WAIT_V(8); PG8_WAIT_L(0); PG8_BAR; PG8_MMA(1, 0, At, B0); PG8_MMA(1, 1, At, B1); PG8_BAR; PG8_SCHED;
            PG8_LDB(B0, 1, 0); PG8_LDB(B1, 1, 1); PG8_SCHED; PG8_LDA(At, 1, 0); PG8_STAGE(PG8_SA(0, 1), a2 + hstep, voffA);
            PG8_WAIT_V(8); PG8_WAIT_L(0); PG8_BAR; PG8_MMA(0, 0, At, B0); PG8_MMA(0, 1, At, B1); PG8_BAR; PG8_SCHED;
            PG8_LDA(At, 1, 1); PG8_STAGE(PG8_SB(1, 0), b3, voffB); PG8_STAGE(PG8_SB(1, 1), b3 + bstep, voffB); PG8_STAGE(PG8_SA(1, 0), a3, voffA);
            PG8_WAIT_V(8); PG8_WAIT_L(0); PG8_BAR; PG8_MMA(1, 0, At, B0); PG8_MMA(1, 1, At, B1); PG8_BAR; PG8_SCHED;
            } else {
            PG8_LDB(B0, 0, 0); PG8_SCHED; PG8_LDA(At, 0, 0); PG8_STAGE(PG8_SA(1, 1), a1 + hstep, voffA);
            PG8_WAIT_L(8); PG8_BAR; PG8_WAIT_L(0); PG8_MMA(0, 0, At, B0); PG8_BAR; PG8_SCHED;
            PG8_LDB(B1, 0, 1); PG8_STAGE(PG8_SB(0, 0), b2, voffB);
            PG8_BAR; PG8_WAIT_L(0); PG8_MMA(0, 1, At, B1); PG8_BAR;
            PG8_LDA(At, 0, 1); PG8_STAGE(PG8_SA(0, 0), a2, voffA);
            PG8_BAR; PG8_WAIT_L(0); PG8_MMA(1, 0, At, B0); PG8_BAR; PG8_SCHED;
            PG8_STAGE(PG8_SB(0, 1), b2 + bstep, voffB);
            PG8_WAIT_V(6); PG8_BAR; PG8_MMA(1, 1, At, B1); PG8_BAR;
            PG8_LDB(B0, 1, 0); PG8_SCHED; PG8_LDA(At, 1, 0); PG8_STAGE(PG8_SA(0, 1), a2 + hstep, voffA);
            PG8_WAIT_L(8); PG8_BAR; PG8_WAIT_L(0); PG8_MMA(0, 0, At, B0); PG8_BAR; PG8_SCHED;
            PG8_LDB(B1, 1, 1); PG8_STAGE(PG8_SB(1, 0), b3, voffB);
            PG8_BAR; PG8_WAIT_L(0); PG8_MMA(0, 1, At, B1); PG8_BAR;
            PG8_LDA(At, 1, 1); PG8_STAGE(PG8_SA(1, 0), a3, voffA);
            PG8_BAR; PG8_WAIT_L(0); PG8_MMA(1, 0, At, B0); PG8_BAR; PG8_SCHED;
            PG8_STAGE(PG8_SB(1, 1), b3 + bstep, voffB);
            PG8_WAIT_V(6); PG8_BAR; PG8_MMA(1, 1, At, B1); PG8_BAR;
            }
        }
        if constexpr (ALIGN_EPI) { if (wr == 0) PG8_BAR; }
        if constexpr (!Epi::AFTER_DRAIN) { E(acc, cur, wr, wc, fr, fq, cur.pm != rs_pm); rs_pm = cur.pm; S.done(cur); }
        if (!has_next) break;
#pragma unroll
        for (int a = 0; a < 2; ++a)
#pragma unroll
            for (int b = 0; b < 2; ++b)
#pragma unroll
                for (int m = 0; m < 4; ++m)
#pragma unroll
                    for (int n = 0; n < 2; ++n) acc[a][b][m][n] = (f32x4){0.f, 0.f, 0.f, 0.f};
        cur = nxt; cA = nA; cB = nB; ++ui;
        if constexpr (ALIGN_EPI) { if (wr == 1) PG8_BAR; }
    }
    PG8_WAIT_V(0);
    if constexpr (!ALIGN_EPI) { if (wr == 0) PG8_BAR; }
    PG8_BAR;
    if constexpr (Epi::AFTER_DRAIN) { E.fused(acc, cur, wr, wc, fr, fq, lds, wid, lane); S.done(cur); }
#undef PG8_SA
#undef PG8_SB
#undef PG8_STAGE
#undef PG8_LDA
#undef PG8_LDB
#undef PG8_MMA
#undef PG8_WAIT_V
#undef PG8_WAIT_L
#undef PG8_BAR
#undef PG8_SCHED
}
}
#define GAS __attribute__((address_space(1)))
#define LAS __attribute__((address_space(3)))
typedef unsigned short bf16;
typedef unsigned v4u __attribute__((ext_vector_type(4)));
typedef float f32x4 __attribute__((ext_vector_type(4)));
typedef short bf16x8 __attribute__((ext_vector_type(8)));
typedef GAS unsigned gu32;
typedef GAS unsigned long long gu64;
#define RLX_AGENT __ATOMIC_RELAXED, __HIP_MEMORY_SCOPE_AGENT
#define LDS_WAIT() asm volatile("s_waitcnt lgkmcnt(0)" ::: "memory")
#define VM_WAIT() asm volatile("s_waitcnt vmcnt(0)" ::: "memory")
__device__ __forceinline__ unsigned long long rt() { return __builtin_amdgcn_s_memrealtime(); }
__device__ __forceinline__ unsigned f2bf(float f) { unsigned u = __builtin_bit_cast(unsigned, f); return (u + 0x7fffu + ((u >> 16) & 1u)) >> 16; }
__device__ __forceinline__ unsigned pk2(float lo, float hi) { return f2bf(lo) | (f2bf(hi) << 16); }
#define XB_TMO      128
#define XB_XCNT(j)  (256  + 64 * (j))
#define XB_XSUB(j)  (1280 + 64 * (j))
#define XB_XGEN(j)  (2304 + 64 * (j))
#define XB_TOP      3328
#define XB_TOPGEN   3392
#define XCD_BAR_WORDS 3456
#define XB_SPIN_CAP (1u << 18)

__device__ __forceinline__ unsigned xb_ld(unsigned* p)              { return __hip_atomic_load(p, __ATOMIC_RELAXED, __HIP_MEMORY_SCOPE_AGENT); }
__device__ __forceinline__ unsigned xb_add(unsigned* p, unsigned v) { return __hip_atomic_fetch_add(p, v, __ATOMIC_RELAXED, __HIP_MEMORY_SCOPE_AGENT); }
__device__ __forceinline__ unsigned xb_xcc_id() { return (unsigned)__builtin_amdgcn_s_getreg((3 << 11) | 20) & 0xFu; }
#define XB_SPIN(cond, bar) do { unsigned _sp = 0; while (cond) { __builtin_amdgcn_s_sleep(1); \
    if ((++_sp & 255u) == 0u) { if (xb_ld(&(bar)[XB_TMO])) break; if (_sp > XB_SPIN_CAP) { atomicAdd(&(bar)[XB_TMO], 1u); break; } } } } while (0)

struct XcdBarrier {
    unsigned* bar; unsigned x;
    volatile LAS unsigned* st;
};

__device__ __forceinline__ XcdBarrier xcd_barrier_post(unsigned* bar, volatile LAS unsigned* st) {
    XcdBarrier b; b.bar = bar; b.x = xb_xcc_id(); b.st = st;
    if (threadIdx.x == 0) (void)xb_add(&bar[XB_XCNT(b.x)], 1u);
    return b;
}
__device__ __forceinline__ void xcd_barrier_complete(unsigned* bar, unsigned x, unsigned& nloc, unsigned& nx) {
    const unsigned G = gridDim.x * gridDim.y * gridDim.z;
    unsigned sum, cnt, mine, sp = 0u;
    for (;;) {
        sum = 0u; cnt = 0u; mine = 0u;
#pragma unroll
        for (unsigned j = 0; j < 16; ++j) { const unsigned c = xb_ld(&bar[XB_XCNT(j)]); sum += c; cnt += (c > 0u) ? 1u : 0u; mine = (j == x) ? c : mine; }
        if (sum == G) break;
        __builtin_amdgcn_s_sleep(1);
        if ((++sp & 255u) == 0u) { if (xb_ld(&bar[XB_TMO])) break; if (sp > XB_SPIN_CAP) { atomicAdd(&bar[XB_TMO], 1u); break; } }
    }
    nloc = mine > 0u ? mine : 1u; nx = cnt > 0u ? cnt : 1u;
}

__device__ __forceinline__ void xcd_barrier(const XcdBarrier& b) {
    asm volatile("s_waitcnt vmcnt(0)" ::: "memory");
    __syncthreads();
    if (threadIdx.x == 0) {
        unsigned* bar = b.bar;
        __builtin_amdgcn_s_waitcnt(0);
        unsigned nloc = b.st[0], nx = b.st[1];
        if (nloc == 0u) { xcd_barrier_complete(bar, b.x, nloc, nx); b.st[0] = nloc; b.st[1] = nx; }
        const unsigned old = xb_add(&bar[XB_XSUB(b.x)], 1u);
        const unsigned gen = old / nloc;
        if (old + 1u == (gen + 1u) * nloc) {
            __builtin_amdgcn_fence(__ATOMIC_RELEASE, "agent");
            asm volatile("s_waitcnt vmcnt(0)" ::: "memory");
            const unsigned og = xb_add(&bar[XB_TOP], 1u);
            const unsigned tg = og / nx;
            if (og + 1u == (tg + 1u) * nx) xb_add(&bar[XB_TOPGEN], 1u);
            else XB_SPIN(xb_ld(&bar[XB_TOPGEN]) == tg, bar);
            __builtin_amdgcn_fence(__ATOMIC_ACQUIRE, "agent");
            xb_add(&bar[XB_XGEN(b.x)], 1u);
            asm volatile("s_waitcnt vmcnt(0)" ::: "memory");
        } else {
            XB_SPIN(xb_ld(&bar[XB_XGEN(b.x)]) == gen, bar);
            __builtin_amdgcn_fence(__ATOMIC_ACQUIRE, "agent");
            asm volatile("s_waitcnt vmcnt(0)" ::: "memory");
        }
    }
    __syncthreads();
}
using pg8::MP; using pg8::MS; using pg8::MALL; using pg8::DM; using pg8::SEQ; using pg8::EVIN; using pg8::ODIN; using pg8::FFD;
typedef unsigned u32x2 __attribute__((ext_vector_type(2)));
typedef short v4i16_t __attribute__((ext_vector_type(4)));
constexpr int NWAVES = 8;
constexpr size_t MiB = 1u << 20;
constexpr size_t WS_CTL = 0, CTL_ZERO_BYTES = 65536;
constexpr size_t WS_WEVIN = 2 * MiB, WS_WEVOUT = 12 * MiB, WS_WODIN = 14 * MiB, WS_WODOUT = 19 * MiB, WS_W1 = 21 * MiB  , WS_W2 = 37 * MiB  , WS_WG = 53 * MiB  ,
                 WS_WP = 57 * MiB  , WS_POOLW = 58 * MiB, WS_WST = 58 * MiB + 256 * 1024, WS_ROPE = 59 * MiB  , WS_SS = 81 * MiB  ;
constexpr size_t WS_PB = 64 * MiB  , WS_R = 84 * MiB  , WS_RB = 150 * MiB  , WS_YAB = 216 * MiB  , WS_PROJ = 249 * MiB  , WS_Z = 282 * MiB  ,
                 WS_F = 447 * MiB  , WS_OG = 579 * MiB  , WS_LSE = 629 * MiB  , WS_END = 632 * MiB;
static_assert(WS_PB + 2 * (size_t)MALL * 256 * 2 <= WS_R && WS_R + (size_t)MALL * DM * 4 <= WS_RB && WS_RB + 2 * (size_t)MALL * DM * 2 <= WS_YAB && WS_Z + (size_t)MALL * EVIN * 2 <= WS_F &&
              WS_F + (size_t)MALL * FFD * 2 <= WS_OG && WS_OG + 3 * (size_t)MALL * 512 * 2 <= WS_LSE && WS_LSE + 3 * (size_t)MALL * 8 * 4 <= WS_END && WS_ROPE + 8196 * 64 * 4 <= WS_PB &&
              WS_SS + 2 * (size_t)MALL * 16 * 4 <= WS_R && WS_PB + 2 * (size_t)MALL * 256 * 2 <= WS_SS, "d_ws map");
constexpr int CW_BAR = 4096;
constexpr int RING_BYTES = 131072, LDSCTL_OFF = RING_BYTES, MISC_OFF = LDSCTL_OFF + 320, LDS_BYTES = 147456;
constexpr int KVS = 144;
constexpr int ATT_K = 0, ATT_V = 272 * KVS, ATT_SC = 2 * 272 * KVS;
constexpr int VNS = 272;

struct Args { const float* in[28]; float* out; unsigned char* ws; int ph_lo, ph_hi; };
struct Frame {
    LAS unsigned char* lds; volatile LAS unsigned* MISC; gu32* ctl;
    int tid, lane, wave, vcu, G;
    float* out; unsigned char* ws;
};
__device__ __forceinline__ float wave_sum(float v) {
#pragma unroll
    for (int o = 1; o < 64; o <<= 1) v += __shfl_xor(v, o);
    return v;
}
__device__ __forceinline__ float wave_max(float v) {
#pragma unroll
    for (int o = 1; o < 64; o <<= 1) v = __builtin_fmaxf(v, __shfl_xor(v, o));
    return v;
}
__device__ __forceinline__ float red_max16(float x) { const unsigned u = __builtin_bit_cast(unsigned, x); const auto r = __builtin_amdgcn_permlane16_swap(u, u, false, false); return __builtin_fmaxf(__builtin_bit_cast(float, (unsigned)r[0]), __builtin_bit_cast(float, (unsigned)r[1])); }
__device__ __forceinline__ float red_max32(float x) { const unsigned u = __builtin_bit_cast(unsigned, x); const auto r = __builtin_amdgcn_permlane32_swap(u, u, false, false); return __builtin_fmaxf(__builtin_bit_cast(float, (unsigned)r[0]), __builtin_bit_cast(float, (unsigned)r[1])); }
__device__ __forceinline__ float red_add16(float x) { const unsigned u = __builtin_bit_cast(unsigned, x); const auto r = __builtin_amdgcn_permlane16_swap(u, u, false, false); return __builtin_bit_cast(float, (unsigned)r[0]) + __builtin_bit_cast(float, (unsigned)r[1]); }
__device__ __forceinline__ float red_add32(float x) { const unsigned u = __builtin_bit_cast(unsigned, x); const auto r = __builtin_amdgcn_permlane32_swap(u, u, false, false); return __builtin_bit_cast(float, (unsigned)r[0]) + __builtin_bit_cast(float, (unsigned)r[1]); }
__device__ __forceinline__ v4u pair16(u32x2 A, u32x2 B) { const auto rx = __builtin_amdgcn_permlane16_swap(A.x, B.x, false, false); const auto ry = __builtin_amdgcn_permlane16_swap(A.y, B.y, false, false);
    v4u o; o.x = rx[0]; o.y = ry[0]; o.z = rx[1]; o.w = ry[1]; return o; }
__device__ __forceinline__ int pair16_off(int fq) { return 4 * fq + ((fq & 1) ? 12 : 0); }
__device__ __forceinline__ unsigned cvtpk(float lo, float hi) { return pg8::cvt_pk_bf16(lo, hi); }
__device__ __forceinline__ float bflo(unsigned w) { return __builtin_bit_cast(float, w << 16); }
__device__ __forceinline__ float bfhi(unsigned w) { return __builtin_bit_cast(float, w & 0xffff0000u); }
__device__ __forceinline__ f32x4 mfma16(bf16x8 a, bf16x8 b, f32x4 c) { return __builtin_amdgcn_mfma_f32_16x16x32_bf16(a, b, c, 0, 0, 0); }
__device__ __forceinline__ v4i16_t trread(LAS const unsigned char* p) { return __builtin_amdgcn_ds_read_tr16_b64_v4i16((LAS v4i16_t*)p); }

constexpr int SG_NST = 5, SG_STAGE = 24576;
template <class Epi> __device__ __forceinline__ void sample_gemm_k(LAS unsigned char* lds, const Epi& E, const bf16* A, const bf16* Bt, int K_, int cb0);
template <class Epi> __device__ __forceinline__ void sample_gemm(LAS unsigned char* lds, const Epi& E, const bf16* A, const bf16* Bt, int N, int K_) {
    if (N == 1024) { sample_gemm_k(lds, E, A, Bt, K_, 0); return; }
    int t_ = threadIdx.x; asm volatile("" : "+v"(t_)); int K = K_; asm volatile("" : "+s"(K));
    const int tid = t_, lane = tid & 63, wave = __builtin_amdgcn_readfirstlane(tid >> 6), fr = lane & 15, fq = lane >> 4;
    const int b = blockIdx.x, G = gridDim.x, nkt = K / 64;
    const int ncb_big = (N == 5120 && G == 256) ? 64 : N / 64;
    const int nit = ncb_big * 4;
    const int v = (G == 256) ? (((b & 7) + 8 * (b >> 5)) * 4 + ((b >> 3) & 3)) : b;
    int R0, C0, R1, C1; pg8::stage_rc(tid * 16, R0, C0); pg8::stage_rc(tid * 16 + 8192, R1, C1);
    const unsigned ldsw = (unsigned)wave * 1024u;
    const int aoff = pg8::lds_byte(16 * wave + fr, 8 * fq);
    int boff[2][2];
#pragma unroll
    for (int bj = 0; bj < 2; ++bj)
#pragma unroll
        for (int n = 0; n < 2; ++n) boff[bj][n] = 16384 + pg8::lds_byte(32 * bj + 16 * n + fr, 8 * fq);
    for (int it = v; it < nit; it += G) {
        const int cb = it >> 2, oct = it & 3, pn = cb >> 2, wc = cb & 3;
        const int row0 = MP + oct * 128;
        const bf16* ga0 = A + (size_t)(row0 + R0) * K + C0; const bf16* ga1 = A + (size_t)(row0 + R1) * K + C1;
        const bf16* gb = Bt + (size_t)(pn * 256 + (Epi::PERM ? wc * 64 + (R0 >> 5) * 32 + pg8::perm32(R0 & 31) : (R0 >> 5) * 128 + wc * 32 + (R0 & 31))) * K + C0;
#define SG_ISSUE(kt) do { const int s_ = (kt) % SG_NST; const size_t ko_ = (size_t)(kt) * 64; \
        __builtin_amdgcn_global_load_lds((const unsigned*)(ga0 + ko_), (LAS unsigned*)(lds + s_ * SG_STAGE + ldsw), 16, 0, 0); \
        __builtin_amdgcn_global_load_lds((const unsigned*)(ga1 + ko_), (LAS unsigned*)(lds + s_ * SG_STAGE + 8192 + ldsw), 16, 0, 0); \
        __builtin_amdgcn_global_load_lds((const unsigned*)(gb + ko_), (LAS unsigned*)(lds + s_ * SG_STAGE + 16384 + ldsw), 16, 0, 0); } while (0)
        for (int kt = 0; kt < SG_NST - 1 && kt < nkt; ++kt) SG_ISSUE(kt);
        f32x4 acc[2][2];
#pragma unroll
        for (int bj = 0; bj < 2; ++bj)
#pragma unroll
            for (int n = 0; n < 2; ++n) acc[bj][n] = (f32x4){0.f, 0.f, 0.f, 0.f};
        for (int kt = 0; kt < nkt; ++kt) {
            const int ahead = (nkt - 1 - kt) < (SG_NST - 2) ? (nkt - 1 - kt) : (SG_NST - 2);
            if (ahead >= 3) asm volatile("s_waitcnt vmcnt(9)" ::: "memory"); else if (ahead == 2) asm volatile("s_waitcnt vmcnt(6)" ::: "memory");
            else if (ahead == 1) asm volatile("s_waitcnt vmcnt(3)" ::: "memory"); else asm volatile("s_waitcnt vmcnt(0)" ::: "memory");
            __builtin_amdgcn_s_barrier(); __builtin_amdgcn_sched_barrier(0); asm volatile("" ::: "memory");
            if (kt + SG_NST - 1 < nkt) SG_ISSUE(kt + SG_NST - 1);
            LAS const unsigned char* st = lds + (kt % SG_NST) * SG_STAGE;
            bf16x8 af[2], bf[2][2][2];
#pragma unroll
            for (int ks = 0; ks < 2; ++ks) { af[ks] = *(LAS const bf16x8*)(st + aoff + ks * 1024);
#pragma unroll
                for (int bj = 0; bj < 2; ++bj)
#pragma unroll
                    for (int n = 0; n < 2; ++n) bf[ks][bj][n] = *(LAS const bf16x8*)(st + boff[bj][n] + ks * 1024); }
            asm volatile("s_waitcnt lgkmcnt(0)" ::: "memory");
#pragma unroll
            for (int ks = 0; ks < 2; ++ks)
#pragma unroll
                for (int bj = 0; bj < 2; ++bj)
#pragma unroll
                    for (int n = 0; n < 2; ++n) acc[bj][n] = mfma16(bf[ks][bj][n], af[ks], acc[bj][n]);
        }
#undef SG_ISSUE
        { const int row_ = row0 + wave * 16 + fr; E.rg(acc, row_, pn, wc, fq, Epi::USE_RS ? pg8::row_rs(E.SS, row_) : 0.f); }
        asm volatile("s_waitcnt vmcnt(0) lgkmcnt(0)" ::: "memory"); __builtin_amdgcn_s_barrier(); asm volatile("" ::: "memory");
    }
    if (ncb_big < N / 64) sample_gemm_k(lds, E, A, Bt, K_, ncb_big);
}
constexpr int SK_NST = 5, SK_STAGE = 24576;
template <class Epi> __device__ __forceinline__ void sample_gemm_k(LAS unsigned char* lds, const Epi& E, const bf16* A, const bf16* Bt, int K_, int cb0) {
    int t_ = threadIdx.x; asm volatile("" : "+v"(t_)); int K = K_; asm volatile("" : "+s"(K));
    const int tid = t_, lane = tid & 63, wave = __builtin_amdgcn_readfirstlane(tid >> 6), fr = lane & 15, fq = lane >> 4, rg = wave & 1, kq = (wave >> 1) & 1, ch = wave >> 2;
    const int b = blockIdx.x, G = gridDim.x, nit = 256, nkc = K / 128;
    const int v = (G == 256) ? (((b & 7) + 8 * (b >> 5)) * 4 + ((b >> 3) & 3)) : b;
    int RA, CA; const int QA = (tid * 16) >> 12; pg8::stage_rc((tid * 16) & 4095, RA, CA);
    int RB_, CB_; pg8::stage_rc(tid * 16, RB_, CB_);
    const unsigned ldsw = (unsigned)wave * 1024u;
    const int aoff = kq * 4096 + pg8::lds_byte(16 * rg + fr, 8 * fq);
    int boff[2];
#pragma unroll
    for (int n = 0; n < 2; ++n) boff[n] = 8192 + kq * 8192 + pg8::lds_byte(32 * ch + 16 * n + fr, 8 * fq);
    for (int it = v; it < nit; it += G) {
        const int cb = cb0 + (it >> 4), rgrp = it & 15, pn = cb >> 2, wc = cb & 3;
        const int row0 = MP + rgrp * 32;
        const bf16* ga = A + (size_t)(row0 + RA) * K + QA * 64 + CA;
        const bf16* gb = Bt + (size_t)(pn * 256 + (Epi::PERM ? wc * 64 + (RB_ >> 5) * 32 + pg8::perm32(RB_ & 31) : (RB_ >> 5) * 128 + wc * 32 + (RB_ & 31))) * K + CB_;
#define SK_ISSUE(kc) do { const int s_ = (kc) % SK_NST; const size_t ko_ = (size_t)(kc) * 128; \
        __builtin_amdgcn_global_load_lds((const unsigned*)(ga + ko_), (LAS unsigned*)(lds + s_ * SK_STAGE + ldsw), 16, 0, 0); \
        __builtin_amdgcn_global_load_lds((const unsigned*)(gb + ko_), (LAS unsigned*)(lds + s_ * SK_STAGE + 8192 + ldsw), 16, 0, 0); \
        __builtin_amdgcn_global_load_lds((const unsigned*)(gb + ko_ + 64), (LAS unsigned*)(lds + s_ * SK_STAGE + 16384 + ldsw), 16, 0, 0); } while (0)
        for (int kc = 0; kc < SK_NST - 1 && kc < nkc; ++kc) SK_ISSUE(kc);
        f32x4 acc[2];
#pragma unroll
        for (int n = 0; n < 2; ++n) acc[n] = (f32x4){0.f, 0.f, 0.f, 0.f};
        for (int kc = 0; kc < nkc; ++kc) {
            const int ahead = (nkc - 1 - kc) < (SK_NST - 2) ? (nkc - 1 - kc) : (SK_NST - 2);
            if (ahead >= 3) asm volatile("s_waitcnt vmcnt(9)" ::: "memory"); else if (ahead == 2) asm volatile("s_waitcnt vmcnt(6)" ::: "memory");
            else if (ahead == 1) asm volatile("s_waitcnt vmcnt(3)" ::: "memory"); else asm volatile("s_waitcnt vmcnt(0)" ::: "memory");
            __builtin_amdgcn_s_barrier(); __builtin_amdgcn_sched_barrier(0); asm volatile("" ::: "memory");
            if (kc + SK_NST - 1 < nkc) SK_ISSUE(kc + SK_NST - 1);
            LAS const unsigned char* st = lds + (kc % SK_NST) * SK_STAGE;
            bf16x8 af[2], bf[2][2];
#pragma unroll
            for (int ks = 0; ks < 2; ++ks) { af[ks] = *(LAS const bf16x8*)(st + aoff + ks * 1024);
#pragma unroll
                for (int n = 0; n < 2; ++n) bf[ks][n] = *(LAS const bf16x8*)(st + boff[n] + ks * 1024); }
            asm volatile("s_waitcnt lgkmcnt(0)" ::: "memory");
#pragma unroll
            for (int ks = 0; ks < 2; ++ks)
#pragma unroll
                for (int n = 0; n < 2; ++n) acc[n] = mfma16(bf[ks][n], af[ks], acc[n]);
        }
#undef SK_ISSUE
        LAS float* red = (LAS float*)(lds + (nkc % SK_NST) * SK_STAGE);
        if (kq | ch) { const int slot = ch * 2 + kq - 1;
#pragma unroll
            for (int n = 0; n < 2; ++n) *(LAS f32x4*)(red + (((rg * 3 + slot) * 64 + lane) * 8 + n * 4)) = acc[n]; }
        asm volatile("s_waitcnt lgkmcnt(0)" ::: "memory"); __builtin_amdgcn_s_barrier(); asm volatile("" ::: "memory");
        if (!(kq | ch)) { f32x4 a[2][2];
#pragma unroll
            for (int n = 0; n < 2; ++n) { a[0][n] = acc[n] + *(LAS const f32x4*)(red + (((rg * 3 + 0) * 64 + lane) * 8 + n * 4));
                a[1][n] = *(LAS const f32x4*)(red + (((rg * 3 + 1) * 64 + lane) * 8 + n * 4)) + *(LAS const f32x4*)(red + (((rg * 3 + 2) * 64 + lane) * 8 + n * 4)); }
            { const int row_ = row0 + rg * 16 + fr; E.rg(a, row_, pn, wc, fq, Epi::USE_RS ? pg8::row_rs(E.SS, row_) : 0.f); } }
        asm volatile("s_waitcnt vmcnt(0) lgkmcnt(0)" ::: "memory"); __builtin_amdgcn_s_barrier(); asm volatile("" ::: "memory");
    }
}
__device__ __forceinline__ void relaunder(Frame& F) { int t = threadIdx.x; asm volatile("" : "+v"(t)); F.tid = t; F.lane = t & 63; F.wave = __builtin_amdgcn_readfirstlane(t >> 6); }
__device__ __forceinline__ void p0_transpose_item(const float* W, int K, int N, bf16* WT, const float* gain, int mode, LAS float* scr, int item, int lane) {
    const int nblk = N / 32, kb = item / nblk, nb = item % nblk, k0 = 64 * kb, n0 = 32 * nb, n4 = lane & 7, kr = lane >> 3;
    int srcc = n0 + 4 * n4;
    if (mode == 1 && n0 >= 512 && ((n0 - 512) % 1536) < 1024) srcc = (n0 & ~63) + 16 * ((n0 >> 5) & 1) + ((4 * n4) & 15) + 32 * ((4 * n4) >> 4);
    f32x4 v[8];
#pragma unroll
    for (int i = 0; i < 8; ++i) v[i] = __builtin_nontemporal_load((const GAS f32x4*)(W + (size_t)(k0 + kr + 8 * i) * N + srcc));
#pragma unroll
    for (int i = 0; i < 8; ++i) { const int kk = kr + 8 * i; const float gsc = gain ? gain[k0 + kk] : 1.0f;
#pragma unroll
        for (int j = 0; j < 4; ++j) scr[kk * 33 + 4 * n4 + j] = v[i][j] * gsc; }
    LDS_WAIT(); asm volatile("" ::: "memory");
    const int c = lane & 7;
#pragma unroll
    for (int j = 0; j < 4; ++j) { const int n = (lane >> 3) + 8 * j; const LAS float* s = scr + (8 * c) * 33 + n;
        v4u o; o.x = cvtpk(s[0 * 33], s[1 * 33]); o.y = cvtpk(s[2 * 33], s[3 * 33]); o.z = cvtpk(s[4 * 33], s[5 * 33]); o.w = cvtpk(s[6 * 33], s[7 * 33]);
        if (mode == 2) __builtin_nontemporal_store(o, (GAS v4u*)(WT + (size_t)(n0 + n) * K + k0 + 8 * c)); else *(GAS v4u*)(WT + (size_t)(n0 + n) * K + k0 + 8 * c) = o; }
    LDS_WAIT(); asm volatile("" ::: "memory");
}
__device__ __forceinline__ void p0_prologue(Frame& F, const Args& A) {
    LAS float* scr = (LAS float*)(F.lds + F.wave * 16384);
    const int gw = F.vcu * NWAVES + F.wave, NGW = F.G * NWAVES;
    unsigned char* ws = F.ws;
    constexpr int I_EVIN = 16 * 160, I_SQ = 16 * 32, I_ODIN = 16 * 80, I_W1 = 16 * 128, I_W2 = 64 * 32, I_WP = 4 * 32;
    constexpr int NITEMS = I_EVIN + 2 * I_SQ + I_ODIN + 2 * I_W1 + 2 * I_W2 + 2 * I_SQ + 2 * I_WP;
    for (int it = gw; it < NITEMS; it += NGW) {
        int r = it;
        if (r < I_EVIN) { p0_transpose_item(A.in[9], 1024, EVIN, (bf16*)(ws + WS_WEVIN), A.in[20], 0, scr, r, F.lane); continue; } r -= I_EVIN;
        if (r < I_SQ) { p0_transpose_item(A.in[12], 1024, 1024, (bf16*)(ws + WS_WEVOUT), nullptr, 2, scr, r, F.lane); continue; } r -= I_SQ;
        if (r < I_ODIN) { p0_transpose_item(A.in[13], 1024, ODIN, (bf16*)(ws + WS_WODIN), A.in[20] + 1024, 2, scr, r, F.lane); continue; } r -= I_ODIN;
        if (r < I_SQ) { p0_transpose_item(A.in[19], 1024, 1024, (bf16*)(ws + WS_WODOUT), nullptr, 2, scr, r, F.lane); continue; } r -= I_SQ;
        if (r < 2 * I_W1) { const int L = r / I_W1; p0_transpose_item(A.in[23] + (size_t)L * 1024 * FFD, 1024, FFD, (bf16*)(ws + WS_W1) + (size_t)L * 1024 * FFD, A.in[21] + L * 1024, 2, scr, r % I_W1, F.lane); continue; } r -= 2 * I_W1;
        if (r < 2 * I_W2) { const int L = r / I_W2; p0_transpose_item(A.in[24] + (size_t)L * 1024 * FFD, FFD, 1024, (bf16*)(ws + WS_W2) + (size_t)L * 1024 * FFD, nullptr, 2, scr, r % I_W2, F.lane); continue; } r -= 2 * I_W2;
        if (r < 2 * I_SQ) { const int L = r / I_SQ; p0_transpose_item(A.in[26] + (size_t)L * 1024 * 1024, 1024, 1024, (bf16*)(ws + WS_WG) + (size_t)L * 1024 * 1024, A.in[22] + L * 1024, 2, scr, r % I_SQ, F.lane); continue; } r -= 2 * I_SQ;
        { const int L = r / I_WP; p0_transpose_item(A.in[25] + (size_t)L * 256 * 1024, 256, 1024, (bf16*)(ws + WS_WP) + (size_t)L * 256 * 1024, nullptr, 2, scr, r % I_WP, F.lane); }
    }
    {
        bf16* RB0 = (bf16*)(ws + WS_RB); float* SS0 = (float*)(ws + WS_SS);
        for (int m0 = gw; m0 < MALL; m0 += 2 * NGW) {
            f32x4 v[2][4];
#pragma unroll
            for (int r = 0; r < 2; ++r) { const int m = m0 + r * NGW; if (m < MALL) { const float* xrow = m < MP ? A.in[0] + (size_t)m * DM : A.in[1] + (size_t)(m - MP) * DM;
                const GAS f32x4* xr = (const GAS f32x4*)xrow + F.lane;
#pragma unroll
                for (int j = 0; j < 4; ++j) v[r][j] = __builtin_nontemporal_load(xr + 64 * j); } }
#pragma unroll
            for (int r = 0; r < 2; ++r) { const int m = m0 + r * NGW; if (m < MALL) { float s = 0.f;
#pragma unroll
                for (int j = 0; j < 4; ++j) s += (v[r][j][0] * v[r][j][0] + v[r][j][1] * v[r][j][1]) + (v[r][j][2] * v[r][j][2] + v[r][j][3] * v[r][j][3]);
                s = wave_sum(s);
                GAS u32x2* o8 = (GAS u32x2*)(RB0 + (size_t)m * DM) + F.lane;
#pragma unroll
                for (int j = 0; j < 4; ++j) { u32x2 w; w.x = cvtpk(v[r][j][0], v[r][j][1]); w.y = cvtpk(v[r][j][2], v[r][j][3]); o8[64 * j] = w; }
                if (F.lane < 16) SS0[(size_t)m * 16 + F.lane] = F.lane == 0 ? s : 0.f; } }
        }
    }
    const int gt = gw * 64 + F.lane, NT = NGW * 64;
    { bf16* PB = (bf16*)(ws + WS_PB);
      for (int i0 = gt; i0 < 2 * MALL * 64; i0 += 4 * NT) { f32x4 v[4];
#pragma unroll
          for (int u = 0; u < 4; ++u) { const int i = i0 + u * NT; if (i < 2 * MALL * 64) { const int L = i / (MALL * 64), rem = i % (MALL * 64), row = rem >> 6, c4 = rem & 63;
              const float* src = row < MP ? A.in[7] + ((size_t)L * MP + row) * 256 + c4 * 4 : A.in[8] + ((size_t)L * MS + (row - MP)) * 256 + c4 * 4; v[u] = __builtin_nontemporal_load((const GAS f32x4*)src); } }
#pragma unroll
          for (int u = 0; u < 4; ++u) { const int i = i0 + u * NT; if (i < 2 * MALL * 64) { const int L = i / (MALL * 64), rem = i % (MALL * 64), row = rem >> 6, c4 = rem & 63;
              u32x2 w; w.x = cvtpk(v[u][0], v[u][1]); w.y = cvtpk(v[u][2], v[u][3]); *(GAS u32x2*)(PB + ((size_t)L * MALL + row) * 256 + c4 * 4) = w; } } } }
    { float* tab = (float*)(ws + WS_ROPE);
      for (int i = gt; i < 8196 * 32; i += NT) { const int pos = i >> 5, k = i & 31;
          const float inv = (float)exp2(-(double)k * (13.287712379549449 / 32.0));
          const float ang = (float)pos * inv;
          const double rev = (double)ang * 0.15915494309189535; const float fr = (float)(rev - rint(rev));
          tab[2 * i] = __builtin_amdgcn_cosf(fr); tab[2 * i + 1] = __builtin_amdgcn_sinf(fr); } }
    { bf16* PW = (bf16*)(ws + WS_POOLW); bf16* WT = (bf16*)(ws + WS_WST);
      for (int i = gt; i < 4 * 128 * 128; i += NT) { const int g = i >> 14, d = (i >> 7) & 127, c = i & 127;
          PW[i] = (bf16)(cvtpk(A.in[10][(g * 128 + c) * 128 + d] * A.in[11][g * 128 + d], 0.f) & 0xffffu);
          const int t = d, s = c; WT[i] = (bf16)(cvtpk(s <= t ? A.in[16][i] : 0.f, 0.f) & 0xffffu); } }
    { for (int i = gt; i < 128 * 11 * 128; i += NT) { const int n = i / (11 * 128), rem = i % (11 * 128), j = rem >> 7, c4 = rem & 127;
          *(GAS f32x4*)(F.out + pg8::O_POOLS + ((size_t)(n * 15 + j) * 512 + c4 * 4)) = *(const GAS f32x4*)(A.in[5] + ((size_t)(n * 15 + j + 4) * 512 + c4 * 4)); } }
}

template <int W> __device__ __forceinline__ void pool_unit(Frame& F, const Args& A, int gi, int slab) {
    const int w = 2 << gi;
    int lane_ = F.lane; asm volatile("" : "+v"(lane_));
    const int lane = lane_, fq = lane >> 4, a = lane & 15;
    const bf16* Z = (const bf16*)(F.ws + WS_Z); const bf16* PW = (const bf16*)(F.ws + WS_POOLW); const float* SP = A.in[5]; bf16* YAB = (bf16*)(F.ws + WS_YAB);
    const int row = slab * 16 + a; const bool samp = slab >= MP / 16; const int ms = row - MP; const int t = samp ? (ms & 3) : (row & (SEQ - 1)); const int nsq = ms >> 2;
    const float rc = 1.0f / (float)(samp ? w : (w < t + 1 ? w : t + 1));
    bf16x8 pf[4];
#pragma unroll
    for (int ks = 0; ks < 4; ++ks) { const int c = gi * 128 + 32 * ks + 8 * fq; float acc[8], x0[8];
        if (!samp) {
            v4u zz[W];
            const int jmax = t < w - 1 ? t : w - 1;
#pragma unroll
            for (int j = 0; j < W; ++j) { const int jj = j < jmax ? j : jmax; zz[j] = *(const GAS v4u*)(Z + (size_t)(row - jj) * EVIN + c); }
#pragma unroll
            for (int k = 0; k < 4; ++k) { x0[2 * k] = bflo(zz[0][k]); x0[2 * k + 1] = bfhi(zz[0][k]); acc[2 * k] = x0[2 * k]; acc[2 * k + 1] = x0[2 * k + 1]; }
#pragma unroll
            for (int j = 1; j < W; ++j) { const float wgt = j <= jmax ? 1.0f : 0.0f;
#pragma unroll
                for (int k = 0; k < 4; ++k) { acc[2 * k] += wgt * bflo(zz[j][k]); acc[2 * k + 1] += wgt * bfhi(zz[j][k]); } }
        } else {
            { const v4u z0 = *(const GAS v4u*)(Z + (size_t)row * EVIN + c);
#pragma unroll
              for (int k = 0; k < 4; ++k) { x0[2 * k] = bflo(z0[k]); x0[2 * k + 1] = bfhi(z0[k]); acc[2 * k] = x0[2 * k]; acc[2 * k + 1] = x0[2 * k + 1]; } }
            for (int j = 1; j < w; ++j) {
                if (j <= t) { const v4u z1 = *(const GAS v4u*)(Z + (size_t)(row - j) * EVIN + c);
#pragma unroll
                    for (int k = 0; k < 4; ++k) { acc[2 * k] += bflo(z1[k]); acc[2 * k + 1] += bfhi(z1[k]); } }
                else if (samp) { const float* sp = SP + ((size_t)(nsq * 15 + 15 + t - j)) * 512 + c; const f32x4 s0 = *(const GAS f32x4*)sp, s1 = *(const GAS f32x4*)(sp + 4);
#pragma unroll
                    for (int k = 0; k < 4; ++k) { acc[k] += s0[k]; acc[4 + k] += s1[k]; } } }
        }
        v4u pw; pw.x = cvtpk(acc[0] * rc - x0[0], acc[1] * rc - x0[1]); pw.y = cvtpk(acc[2] * rc - x0[2], acc[3] * rc - x0[3]);
        pw.z = cvtpk(acc[4] * rc - x0[4], acc[5] * rc - x0[5]); pw.w = cvtpk(acc[6] * rc - x0[6], acc[7] * rc - x0[7]);
        pf[ks] = __builtin_bit_cast(bf16x8, pw); }
#pragma unroll
    for (int nb = 0; nb < 8; ++nb) { f32x4 d = (f32x4){0.f, 0.f, 0.f, 0.f}; asm volatile("" : "+v"(d));
#pragma unroll
        for (int ks = 0; ks < 4; ++ks) { const bf16x8 wf = *(const GAS bf16x8*)(PW + ((size_t)(gi * 128 + 16 * nb + a)) * 128 + 32 * ks + 8 * fq); d = mfma16(wf, pf[ks], d); }
        u32x2 o; o.x = cvtpk(d[0], d[1]); o.y = cvtpk(d[2], d[3]);
        *(GAS u32x2*)(YAB + (size_t)row * DM + gi * 128 + 16 * nb + 4 * fq) = o; }
}
struct KvRegs { v4u k[4], v[4]; bf16x8 qa, qb; };
__device__ __forceinline__ void attn_prompt_load(Frame& F, int u, int tid, KvRegs& R) {
    const int rb = u & 63, h = (u >> 6) & 7, ng = u >> 9, g = ng % 3, n = ng / 3;
    const int dsh = 2 * g, nbk = 64 >> dsh, r = rb >> (6 - dsh), b = rb & (nbk - 1);
    const size_t rowbase = (size_t)n * SEQ; const bf16* Z = (const bf16*)(F.ws + WS_Z);
    const int colK = 512 + g * 1536 + h * 64 + 512, colV = colK + 512;
#pragma unroll
    for (int i = 0; i < 4; ++i) { const int c = tid + 512 * i, key = c >> 3, ch = c & 7; const int kb = (b - 1) * 128 + key;
        R.k[i] = (v4u){0u, 0u, 0u, 0u}; R.v[i] = R.k[i];
        if (kb >= 0) { const bf16* p = Z + (rowbase + ((size_t)kb << dsh) + r) * EVIN; R.k[i] = *(const GAS v4u*)(p + colK + ch * 8); R.v[i] = *(const GAS v4u*)(p + colV + ch * 8); } }
    { const int lane = tid & 63, w = tid >> 6, fq = lane >> 4, a = lane & 15; const size_t qrow = rowbase + ((size_t)(b * 128 + 16 * w + a) << dsh) + r; const bf16* qp = Z + qrow * EVIN + (colK - 512) + 8 * fq;
      R.qa = *(const GAS bf16x8*)qp; R.qb = *(const GAS bf16x8*)(qp + 32); }
}
__device__ __forceinline__ void attn_prompt_unit(Frame& F, const Args& A, int u, int unext, KvRegs& R) {
    const int rb = u & 63, h = (u >> 6) & 7, ng = u >> 9, g = ng % 3, n = ng / 3;
    const int dsh = 2 * g, nbk = 64 >> dsh, r = rb >> (6 - dsh), b = rb & (nbk - 1);
    const size_t rowbase = (size_t)n * SEQ;
    const bf16* Z = (const bf16*)(F.ws + WS_Z);
    const int colQ = 512 + g * 1536 + h * 64;
    LAS unsigned char* lds = F.lds;
    int tid_ = F.tid; asm volatile("" : "+v"(tid_));
    const int tid = tid_, lane = tid & 63, w = F.wave, fq = lane >> 4, a = lane & 15;
#pragma unroll
    for (int i = 0; i < 4; ++i) { const int c = tid + 512 * i, key = c >> 3, ch = c & 7;
        *(LAS v4u*)(lds + ATT_K + key * KVS + ch * 16) = R.k[i]; *(LAS v4u*)(lds + ATT_V + key * KVS + ch * 16) = R.v[i]; }
    const bf16x8 qa = R.qa, qb = R.qb;
    if (unext >= 0) attn_prompt_load(F, unext, tid, R);
    const int qi = 16 * w + a; const size_t qrow = rowbase + ((size_t)(b * 128 + qi) << dsh) + r;
    asm volatile("s_waitcnt lgkmcnt(0)" ::: "memory"); __builtin_amdgcn_s_barrier(); asm volatile("" ::: "memory");
    f32x4 S[5][2];
    const int krow = 8 * (a >> 2) + (a & 3);
#pragma unroll
    for (int s = 0; s < 5; ++s) { LAS const unsigned char* kp = lds + ATT_K + (16 * w + 32 * s + krow) * KVS + fq * 16;
        const bf16x8 k0a = *(LAS const bf16x8*)kp, k0b = *(LAS const bf16x8*)(kp + 64), k1a = *(LAS const bf16x8*)(kp + 4 * KVS), k1b = *(LAS const bf16x8*)(kp + 4 * KVS + 64);
        const f32x4 z4 = (f32x4){0.f, 0.f, 0.f, 0.f};
        S[s][0] = mfma16(k0a, qa, z4); S[s][0] = mfma16(k0b, qb, S[s][0]); S[s][1] = mfma16(k1a, qa, z4); S[s][1] = mfma16(k1b, qb, S[s][1]); }
    float mx = -INFINITY;
    if (b > 0) {
#pragma unroll
        for (int tt = 0; tt < 2; ++tt)
#pragma unroll
            for (int j = 0; j < 4; ++j) { const int o = 8 * fq + 4 * tt + j;
                S[0][tt][j] = o >= a ? S[0][tt][j] : -INFINITY; S[4][tt][j] = o <= a ? S[4][tt][j] : -INFINITY; }
#pragma unroll
        for (int s = 0; s < 5; ++s)
#pragma unroll
            for (int tt = 0; tt < 2; ++tt)
#pragma unroll
                for (int j = 0; j < 4; ++j) mx = __builtin_fmaxf(mx, S[s][tt][j]);
    } else {
#pragma unroll
        for (int s = 0; s < 5; ++s)
#pragma unroll
            for (int tt = 0; tt < 2; ++tt)
#pragma unroll
                for (int j = 0; j < 4; ++j) { const int kk = 16 * w + 32 * s + 8 * fq + 4 * tt + j; const bool ok = (kk >= qi) && (kk <= qi + 128) && (kk >= 128);
                    const float v = ok ? S[s][tt][j] : -INFINITY; S[s][tt][j] = v; mx = __builtin_fmaxf(mx, v); }
    }
    mx = red_max16(mx); mx = red_max32(mx);
    float l = 0.f;
#pragma unroll
    for (int s = 0; s < 5; ++s)
#pragma unroll
        for (int tt = 0; tt < 2; ++tt)
#pragma unroll
            for (int j = 0; j < 4; ++j) { const float p = __builtin_amdgcn_exp2f(S[s][tt][j] - mx); S[s][tt][j] = p; l += p; }
    l = red_add16(l); l = red_add32(l);
    f32x4 O[4];
#pragma unroll
    for (int db = 0; db < 4; ++db) O[db] = (f32x4){0.f, 0.f, 0.f, 0.f};
    const int q4 = a >> 2, p4 = a & 3;
#pragma unroll
    for (int s = 0; s < 5; ++s) {
        v4u pw; pw.x = cvtpk(S[s][0][0], S[s][0][1]); pw.y = cvtpk(S[s][0][2], S[s][0][3]); pw.z = cvtpk(S[s][1][0], S[s][1][1]); pw.w = cvtpk(S[s][1][2], S[s][1][3]);
        const bf16x8 pf = __builtin_bit_cast(bf16x8, pw);
        LAS const unsigned char* vp = lds + ATT_V + (16 * w + 32 * s + 8 * fq + q4) * KVS + p4 * 8;
#pragma unroll
        for (int db = 0; db < 4; ++db) { const v4i16_t t0 = trread(vp + db * 32), t1 = trread(vp + 4 * KVS + db * 32);
            const bf16x8 vf = (bf16x8){t0[0], t0[1], t0[2], t0[3], t1[0], t1[1], t1[2], t1[3]};
            O[db] = mfma16(vf, pf, O[db]); } }
    const float inv = 1.0f / l;
    bf16* og = (bf16*)(F.ws + WS_OG) + ((size_t)g * MALL + qrow) * 512 + h * 64 + pair16_off(fq);
#pragma unroll
    for (int db = 0; db < 4; db += 2) { u32x2 oa, ob; oa.x = cvtpk(O[db][0] * inv, O[db][1] * inv); oa.y = cvtpk(O[db][2] * inv, O[db][3] * inv);
        ob.x = cvtpk(O[db + 1][0] * inv, O[db + 1][1] * inv); ob.y = cvtpk(O[db + 1][2] * inv, O[db + 1][3] * inv); *(GAS v4u*)(og + 16 * db) = pair16(oa, ob); }
    if (fq == 0) ((float*)(F.ws + WS_LSE))[((size_t)g * MALL + qrow) * 8 + h] = (mx + __builtin_amdgcn_logf(l)) * 0.6931471805599453f;
    asm volatile("s_waitcnt lgkmcnt(0)" ::: "memory"); __builtin_amdgcn_s_barrier(); asm volatile("" ::: "memory");
}
__device__ __forceinline__ float red16(float x) {
    x += __builtin_bit_cast(float, __builtin_amdgcn_update_dpp(0, __builtin_bit_cast(int, x), 0xB1, 0xF, 0xF, false));
    x += __builtin_bit_cast(float, __builtin_amdgcn_update_dpp(0, __builtin_bit_cast(int, x), 0x4E, 0xF, 0xF, false));
    x += __builtin_bit_cast(float, __builtin_amdgcn_update_dpp(0, __builtin_bit_cast(int, x), 0x141, 0xF, 0xF, false));
    x += __builtin_bit_cast(float, __builtin_amdgcn_update_dpp(0, __builtin_bit_cast(int, x), 0x140, 0xF, 0xF, false));
    return x;
}
template <int NQ, int J> __device__ __forceinline__ void sattn_batch(const f32x4 (&q)[NQ], const f32x4 (&kx)[J], const f32x4 (&vx)[J], int m0, int mstep, int tq, bool isnew,
                                                                   float (&mrun)[NQ], float (&lrun)[NQ], f32x4 (&o)[NQ]) {
#pragma unroll
    for (int t = 0; t < NQ; ++t) { const int tt = NQ == 4 ? t : tq; float sv[J]; float bm = -INFINITY;
#pragma unroll
        for (int j = 0; j < J; ++j) { const float d = red16((q[t][0] * kx[j][0] + q[t][1] * kx[j][1]) + (q[t][2] * kx[j][2] + q[t][3] * kx[j][3])); const int m = m0 + j * mstep;
            const bool ok = isnew ? (NQ == 4 ? m <= tt : m == tt) : (NQ == 4 ? m >= tt : true);
            sv[j] = ok ? d : -INFINITY; bm = __builtin_fmaxf(bm, sv[j]); }
        bm = __builtin_fmaxf(bm, __shfl_xor(bm, 16)); bm = __builtin_fmaxf(bm, __shfl_xor(bm, 32));
        const float mnew = __builtin_fmaxf(mrun[t], bm); const float scl = __builtin_amdgcn_exp2f(mrun[t] - mnew); mrun[t] = mnew;
        float ls = 0.f; f32x4 ov = o[t] * scl;
#pragma unroll
        for (int j = 0; j < J; ++j) { const float pj = __builtin_amdgcn_exp2f(sv[j] - mnew); ls += pj; ov += vx[j] * pj; }
        lrun[t] = lrun[t] * scl + ls; o[t] = ov; }
}
template <int NQ> __device__ __forceinline__ void attn_sample_item(Frame& F, const Args& A, int n, int g, int tq, int h) {
    int lane_ = F.lane; asm volatile("" : "+v"(lane_));
    const int lane = lane_, ks = lane >> 4, dc = lane & 15;
    const int Lb = 128 << (2 * g), stride = 1 << (2 * g), first = NQ == 4 ? 0 : tq;
    const float* cache = A.in[2 + g] + (size_t)n * Lb * 1024 + (size_t)(first + ks * stride) * 1024 + h * 64 + dc * 4;
    const size_t itstep = (size_t)4 * stride * 1024;
    const float* newkv = F.out + (g == 0 ? pg8::O_KVS0 : (g == 1 ? pg8::O_KVS1 : pg8::O_KVS2)) + (size_t)(n * 4 + ks) * 1024 + h * 64 + dc * 4;
    const bf16* Z = (const bf16*)(F.ws + WS_Z);
    f32x4 q[NQ];
#pragma unroll
    for (int t = 0; t < NQ; ++t) { const int tt = NQ == 4 ? t : tq; const u32x2 wq = *(const GAS u32x2*)(Z + (size_t)(MP + n * 4 + tt) * EVIN + 512 + g * 1536 + h * 64 + dc * 4);
        q[t] = (f32x4){bflo(wq.x), bfhi(wq.x), bflo(wq.y), bfhi(wq.y)}; }
    float mrun[NQ], lrun[NQ]; f32x4 o[NQ];
#pragma unroll
    for (int t = 0; t < NQ; ++t) { mrun[t] = -INFINITY; lrun[t] = 0.f; o[t] = (f32x4){0.f, 0.f, 0.f, 0.f}; }
    constexpr int J = NQ == 4 ? 4 : 8;
    f32x4 kA[J], vA[J], kB[J], vB[J];
#define SA_LOAD(KX, VX, b) do { _Pragma("unroll") for (int j = 0; j < J; ++j) { const float* p_ = cache + (size_t)((b) * J + j) * itstep; \
        KX[j] = __builtin_nontemporal_load((const GAS f32x4*)p_); VX[j] = __builtin_nontemporal_load((const GAS f32x4*)(p_ + 512)); } } while (0)
    SA_LOAD(kA, vA, 0);
    { f32x4 kn[1], vn[1]; kn[0] = *(const GAS f32x4*)newkv; vn[0] = *(const GAS f32x4*)(newkv + 512);
      sattn_batch<NQ, 1>(q, kn, vn, ks, 0, tq, true, mrun, lrun, o); }
#pragma unroll 1
    for (int bb = 0; bb < 16 / J; ++bb) {
        SA_LOAD(kB, vB, 2 * bb + 1); sattn_batch<NQ, J>(q, kA, vA, 8 * J * bb + ks, 4, tq, false, mrun, lrun, o);
        if (bb < 16 / J - 1) SA_LOAD(kA, vA, 2 * bb + 2);
        sattn_batch<NQ, J>(q, kB, vB, 8 * J * bb + 4 * J + ks, 4, tq, false, mrun, lrun, o);
    }
#undef SA_LOAD
#pragma unroll
    for (int t = 0; t < NQ; ++t) { const int tt = NQ == 4 ? t : tq; f32x4 ov = o[t]; float l = lrun[t];
        l += __shfl_xor(l, 16); l += __shfl_xor(l, 32);
#pragma unroll
        for (int j = 0; j < 4; ++j) { ov[j] += __shfl_xor(ov[j], 16); ov[j] += __shfl_xor(ov[j], 32); }
        const float inv = 1.0f / l; const size_t row = (size_t)MP + n * 4 + tt;
        if (ks == 0) { u32x2 ow; ow.x = cvtpk(ov[0] * inv, ov[1] * inv); ow.y = cvtpk(ov[2] * inv, ov[3] * inv); *(GAS u32x2*)((bf16*)(F.ws + WS_OG) + ((size_t)g * MALL + row) * 512 + h * 64 + dc * 4) = ow; }
        if (lane == 0) ((float*)(F.ws + WS_LSE))[((size_t)g * MALL + row) * 8 + h] = (mrun[t] + __builtin_amdgcn_logf(l)) * 0.6931471805599453f; }
}
__device__ __forceinline__ void p2_attention(Frame& F, const Args& A) {
    for (int i = F.tid; i < 2 * 16 * KVS / 4; i += 512) { const int which = i / (16 * KVS / 4), o = i % (16 * KVS / 4); *(LAS unsigned*)(F.lds + (which ? ATT_V : ATT_K) + 256 * KVS + o * 4) = 0u; }
    __syncthreads();
    const int first_prompt = F.vcu & 1;
    for (int pass = 0; pass < 2; ++pass) {
        if ((pass ^ first_prompt) == 0) {
            if (F.wave < 4) {
                for (int it = F.vcu; it < 1152; it += F.G) { const int n = it / 9, kind = it % 9;
#pragma unroll 1
                    for (int hh = 0; hh < 2; ++hh) { const int h = 2 * F.wave + hh;
                        if (kind == 0) attn_sample_item<4>(F, A, n, 0, 0, h); else attn_sample_item<1>(F, A, n, kind < 5 ? 1 : 2, (kind - 1) & 3, h); } }
            } else {
                for (int pu = F.vcu * 4 + (F.wave - 4); pu < (MP / 16 + 32) * 4; pu += F.G * 4) if ((pu >> 2) >= MP / 16) pool_unit<16>(F, A, pu & 3, pu >> 2);
            }
        } else {
            { KvRegs R; attn_prompt_load(F, F.vcu, F.tid, R);
              for (int u = F.vcu; u < 3072; u += F.G) attn_prompt_unit(F, A, u, u + F.G < 3072 ? u + F.G : -1, R); }
        }
        __syncthreads();
    }
}

template <int PART> __device__ __forceinline__ void p3_combine_pool(Frame& F, const Args& A) {
    const int gw = F.vcu * NWAVES + F.wave, NGW = F.G * NWAVES, lane = F.lane;
    bf16* YAB = (bf16*)(F.ws + WS_YAB); const bf16* OG = (const bf16*)(F.ws + WS_OG); const float* LSE = (const float*)(F.ws + WS_LSE);
    if (PART & 1)
    for (int row0 = gw; row0 < MALL; row0 += 2 * NGW) { const int h = lane >> 3;
        float ls[2][3]; v4u ov[2][3];
#pragma unroll
        for (int r = 0; r < 2; ++r) { const int row = row0 + r * NGW < MALL ? row0 + r * NGW : row0;
#pragma unroll
            for (int g = 0; g < 3; ++g) { ls[r][g] = LSE[((size_t)g * MALL + row) * 8 + h]; ov[r][g] = *(const GAS v4u*)(OG + ((size_t)g * MALL + row) * 512 + lane * 8); } }
#pragma unroll
        for (int r = 0; r < 2; ++r) { const int row = row0 + r * NGW; if (row < MALL) {
            const float mx = __builtin_fmaxf(__builtin_fmaxf(ls[r][0], ls[r][1]), ls[r][2]);
            float wg[3]; float den = 0.f;
#pragma unroll
            for (int g = 0; g < 3; ++g) { wg[g] = __expf(ls[r][g] - mx); den += wg[g]; }
            const float inv = 1.0f / den; float y[8];
#pragma unroll
            for (int k = 0; k < 8; ++k) y[k] = 0.f;
#pragma unroll
            for (int g = 0; g < 3; ++g) { const float ww = wg[g] * inv;
#pragma unroll
                for (int k = 0; k < 4; ++k) { y[2 * k] += ww * bflo(ov[r][g][k]); y[2 * k + 1] += ww * bfhi(ov[r][g][k]); } }
            v4u o; o.x = cvtpk(y[0], y[1]); o.y = cvtpk(y[2], y[3]); o.z = cvtpk(y[4], y[5]); o.w = cvtpk(y[6], y[7]);
            *(GAS v4u*)(YAB + (size_t)row * DM + 512 + lane * 8) = o; } } }
    if (PART & 2) {
        constexpr int TS = 320, TW = 32 * TS  , PWO = 8 * TW, PWS = 272;
        const bf16* Z = (const bf16*)(F.ws + WS_Z); const bf16* PW = (const bf16*)(F.ws + WS_POOLW);
        const int b = blockIdx.x, gi = b & 3, blk = b >> 2, w = 2 << gi, fq = lane >> 4, a = lane & 15, q4 = a >> 2, p4 = a & 3;
        LAS unsigned char* lds = F.lds; LAS unsigned char* tile = lds + F.wave * TW;
        for (int i = F.tid; i < 2048; i += 512) { const int d = i >> 4, ch = i & 15; *(LAS v4u*)(lds + PWO + d * PWS + ch * 16) = *(const GAS v4u*)(PW + ((size_t)(gi * 128 + d)) * 128 + ch * 8); }
        __syncthreads();
        const int slstep = (F.G >> 2) * NWAVES;
        v4u ld[8];
#define POOL_LOAD(sl_) do { const int row0_ = (sl_) * 16, t0_ = row0_ & (SEQ - 1); _Pragma("unroll") for (int i = 0; i < 8; ++i) { const int ri = 4 * i + fq; int dt = t0_ - 15 + ri; dt = dt < 0 ? 0 : dt; \
            ld[i] = *(const GAS v4u*)(Z + (size_t)(row0_ - t0_ + (ri < 31 ? dt : t0_ + 15)) * EVIN + gi * 128 + a * 8); } } while (0)
        { const int sl0 = blk * NWAVES + F.wave; if (sl0 < MP / 16) POOL_LOAD(sl0); }
        for (int sl = blk * NWAVES + F.wave; sl < MP / 16; sl += slstep) {
            const int row0 = sl * 16, t0 = row0 & (SEQ - 1);
#pragma unroll
            for (int i = 0; i < 8; ++i) { const int ri = 4 * i + fq; *(LAS v4u*)(tile + ri * TS + a * 16) = ld[i]; }
            if (sl + slstep < MP / 16) POOL_LOAD(sl + slstep);
            LDS_WAIT(); asm volatile("" ::: "memory");
            const int t = t0 + a; const int jmax = t < w - 1 ? t : w - 1; const float rc = 1.0f / (float)(jmax + 1);
            bf16x8 tf;
            { unsigned tw[4];
#pragma unroll
              for (int e2 = 0; e2 < 4; ++e2) { const int j0 = a + 15 - 8 * fq - 2 * e2, j1 = j0 - 1;
                  const float v0 = (j0 >= 0 && j0 <= jmax) ? (j0 == 0 ? rc - 1.0f : rc) : 0.0f, v1 = (j1 >= 0 && j1 <= jmax) ? (j1 == 0 ? rc - 1.0f : rc) : 0.0f;
                  tw[e2] = cvtpk(v0, v1); }
              v4u tv; tv.x = tw[0]; tv.y = tw[1]; tv.z = tw[2]; tv.w = tw[3]; tf = __builtin_bit_cast(bf16x8, tv); }
            bf16x8 pf[4];
            LAS const unsigned char* tp = tile + (8 * fq + q4) * TS + p4 * 16;
#pragma unroll
            for (int ks = 0; ks < 4; ++ks) {
                const v4i16_t a0 = trread(tp + ks * 64), a1 = trread(tp + 4 * TS + ks * 64), b0 = trread(tp + ks * 64 + 8), b1 = trread(tp + 4 * TS + ks * 64 + 8);
                const bf16x8 fa = (bf16x8){a0[0], a0[1], a0[2], a0[3], a1[0], a1[1], a1[2], a1[3]}, fb = (bf16x8){b0[0], b0[1], b0[2], b0[3], b1[0], b1[1], b1[2], b1[3]};
                const f32x4 z4 = (f32x4){0.f, 0.f, 0.f, 0.f};
                const f32x4 da = mfma16(fa, tf, z4), db = mfma16(fb, tf, z4);
                v4u pw; pw.x = cvtpk(da[0], da[1]); pw.y = cvtpk(da[2], da[3]); pw.z = cvtpk(db[0], db[1]); pw.w = cvtpk(db[2], db[3]);
                pf[ks] = __builtin_bit_cast(bf16x8, pw); }
            const size_t row = (size_t)row0 + a;
#pragma unroll
            for (int nb = 0; nb < 8; nb += 2) { f32x4 d0 = (f32x4){0.f, 0.f, 0.f, 0.f}, d1 = d0;
#pragma unroll
                for (int ks = 0; ks < 4; ++ks) { const bf16x8 w0 = *(LAS const bf16x8*)(lds + PWO + (16 * nb + a) * PWS + (32 * ks + 8 * fq) * 2), w1 = *(LAS const bf16x8*)(lds + PWO + (16 * nb + 16 + a) * PWS + (32 * ks + 8 * fq) * 2);
                    d0 = mfma16(w0, pf[ks], d0); d1 = mfma16(w1, pf[ks], d1); }
                u32x2 oa, ob; oa.x = cvtpk(d0[0], d0[1]); oa.y = cvtpk(d0[2], d0[3]); ob.x = cvtpk(d1[0], d1[1]); ob.y = cvtpk(d1[2], d1[3]);
                *(GAS v4u*)(YAB + row * DM + gi * 128 + 16 * nb + pair16_off(fq)) = pair16(oa, ob); }
            LDS_WAIT(); asm volatile("" ::: "memory");
        }
        __syncthreads();
    }
}

__device__ __forceinline__ void p9_oddmix(Frame& F, const Args& A) {
    const int gw = F.vcu * NWAVES + F.wave, NGW = F.G * NWAVES, lane = F.lane, tid = F.tid, wv = F.wave;
    const bf16* Z = (const bf16*)(F.ws + WS_Z); bf16* YAB = (bf16*)(F.ws + WS_YAB);
    const float* lng = A.in[14]; const float* lnb = A.in[15]; const float* bs = A.in[17]; const float* cw = A.in[18];
    for (int blk8 = gw; blk8 < MP / 8; blk8 += NGW) { const int r0 = blk8 * 8, t0 = r0 & (SEQ - 1), c = lane * 8;
        v4u gi[10], xi[10], go[8];
#pragma unroll
        for (int i = 0; i < 10; ++i) { const int rr = (t0 == 0 && i < 2) ? r0 : r0 - 2 + i; const bf16* zr = Z + (size_t)rr * ODIN; gi[i] = *(const GAS v4u*)(zr + 1536 + c); xi[i] = *(const GAS v4u*)(zr + 2048 + c); }
#pragma unroll
        for (int i = 0; i < 8; ++i) go[i] = *(const GAS v4u*)(Z + (size_t)(r0 + i) * ODIN + 1024 + c);
        float cwv[3][8];
#pragma unroll
        for (int j = 0; j < 3; ++j)
#pragma unroll
            for (int k = 0; k < 8; ++k) cwv[j][k] = cw[j * 512 + c + k];
        float hd[10][8]; const float z01 = t0 == 0 ? 0.f : 1.f;
#pragma unroll
        for (int i = 0; i < 10; ++i) { const float m = i < 2 ? z01 : 1.f;
#pragma unroll
            for (int k = 0; k < 4; ++k) { hd[i][2 * k] = m * bflo(gi[i][k]) * bflo(xi[i][k]); hd[i][2 * k + 1] = m * bfhi(gi[i][k]) * bfhi(xi[i][k]); } }
#pragma unroll
        for (int i = 0; i < 8; ++i) { float y[8];
#pragma unroll
            for (int k = 0; k < 8; ++k) { const float cv = cwv[0][k] * hd[i][k] + cwv[1][k] * hd[i + 1][k] + cwv[2][k] * hd[i + 2][k]; y[k] = ((k & 1) ? bfhi(go[i][k >> 1]) : bflo(go[i][k >> 1])) * cv; }
            v4u o; o.x = cvtpk(y[0], y[1]); o.y = cvtpk(y[2], y[3]); o.z = cvtpk(y[4], y[5]); o.w = cvtpk(y[6], y[7]);
            *(GAS v4u*)(YAB + (size_t)(r0 + i) * DM + 512 + c) = o; }
        if (t0 == SEQ - 8) { float* co = F.out + pg8::O_CONVP + ((size_t)((r0 >> 13) * 2)) * 512 + c;
#pragma unroll
            for (int j = 0; j < 2; ++j) { *(GAS f32x4*)(co + j * 512) = (f32x4){hd[8 + j][0], hd[8 + j][1], hd[8 + j][2], hd[8 + j][3]}; *(GAS f32x4*)(co + j * 512 + 4) = (f32x4){hd[8 + j][4], hd[8 + j][5], hd[8 + j][6], hd[8 + j][7]}; } } }
    for (int row = MP + gw; row < MALL; row += NGW) { const bool samp = row >= MP; const int ms = row - MP; const int t = samp ? (ms & 3) : (row & (SEQ - 1)); const int nb = samp ? (ms >> 2) : (row >> 13);
        const int c = lane * 8; float hd[3][8];
#pragma unroll
        for (int j = 0; j < 3; ++j) { const int dt = 2 - j;
            if (dt <= t) { const bf16* zr = Z + (size_t)(row - dt) * ODIN; const v4u gi = *(const GAS v4u*)(zr + 1536 + c), xi = *(const GAS v4u*)(zr + 2048 + c); const unsigned* pg = (const unsigned*)&gi; const unsigned* px = (const unsigned*)&xi;
#pragma unroll
                for (int k = 0; k < 4; ++k) { hd[j][2 * k] = bflo(pg[k]) * bflo(px[k]); hd[j][2 * k + 1] = bfhi(pg[k]) * bfhi(px[k]); } }
            else if (samp) { const float* sp = A.in[6] + ((size_t)(nb * 2 + (t + 2 - dt))) * 512 + c; const f32x4 s0 = *(const GAS f32x4*)sp, s1 = *(const GAS f32x4*)(sp + 4);
#pragma unroll
                for (int k = 0; k < 4; ++k) { hd[j][k] = s0[k]; hd[j][4 + k] = s1[k]; } }
            else {
#pragma unroll
                for (int k = 0; k < 8; ++k) hd[j][k] = 0.f; } }
        const v4u go = *(const GAS v4u*)(Z + (size_t)row * ODIN + 1024 + c); const unsigned* pgo = (const unsigned*)&go;
        float y[8];
#pragma unroll
        for (int k = 0; k < 8; ++k) { const float cv = cw[c + k] * hd[0][k] + cw[512 + c + k] * hd[1][k] + cw[1024 + c + k] * hd[2][k]; y[k] = ((k & 1) ? bfhi(pgo[k >> 1]) : bflo(pgo[k >> 1])) * cv; }
        v4u o; o.x = cvtpk(y[0], y[1]); o.y = cvtpk(y[2], y[3]); o.z = cvtpk(y[4], y[5]); o.w = cvtpk(y[6], y[7]);
        *(GAS v4u*)(YAB + (size_t)row * DM + 512 + c) = o;
        float* co = nullptr;
        if (samp) { if (t >= 2) co = F.out + pg8::O_CONVS + ((size_t)(nb * 2 + t - 2)) * 512 + c; } else if (t >= SEQ - 2) co = F.out + pg8::O_CONVP + ((size_t)(nb * 2 + t - (SEQ - 2))) * 512 + c;
        if (co) { *(GAS f32x4*)co = (f32x4){hd[2][0], hd[2][1], hd[2][2], hd[2][3]}; *(GAS f32x4*)(co + 4) = (f32x4){hd[2][4], hd[2][5], hd[2][6], hd[2][7]}; } }
    for (int n = gw; n < 128; n += NGW) { const int c = lane * 8, g = lane >> 4; float vn[4][8];
#pragma unroll
        for (int s = 0; s < 4; ++s) { const v4u vv = *(const GAS v4u*)(Z + (size_t)(MP + n * 4 + s) * ODIN + 512 + c); const unsigned* pv = (const unsigned*)&vv; float x[8]; float sm = 0.f;
#pragma unroll
            for (int k = 0; k < 4; ++k) { x[2 * k] = bflo(pv[k]); x[2 * k + 1] = bfhi(pv[k]); sm += x[2 * k] + x[2 * k + 1]; }
            sm += __shfl_xor(sm, 1); sm += __shfl_xor(sm, 2); sm += __shfl_xor(sm, 4); sm += __shfl_xor(sm, 8);
            const float mu = sm * (1.0f / 128.0f); float q = 0.f;
#pragma unroll
            for (int k = 0; k < 8; ++k) { x[k] -= mu; q += x[k] * x[k]; }
            q += __shfl_xor(q, 1); q += __shfl_xor(q, 2); q += __shfl_xor(q, 4); q += __shfl_xor(q, 8);
            const float rstd = __builtin_amdgcn_rsqf(q * (1.0f / 128.0f) + 1e-6f);
#pragma unroll
            for (int k = 0; k < 8; ++k) vn[s][k] = x[k] * rstd * lng[c + k] + lnb[c + k];
            float* cvo = F.out + pg8::O_CVS + ((size_t)(n * 4 + s)) * 512 + c;
            *(GAS f32x4*)cvo = (f32x4){vn[s][0], vn[s][1], vn[s][2], vn[s][3]}; *(GAS f32x4*)(cvo + 4) = (f32x4){vn[s][4], vn[s][5], vn[s][6], vn[s][7]}; }
#pragma unroll
        for (int t = 0; t < 4; ++t) { float sp[8];
#pragma unroll
            for (int k = 0; k < 8; ++k) sp[k] = bs[g * 128 + t];
#pragma unroll
            for (int s = 0; s <= t; ++s) { const float wts = A.in[16][(g * 128 + t) * 128 + s];
#pragma unroll
                for (int k = 0; k < 8; ++k) sp[k] += wts * vn[s][k]; }
            const v4u uu = *(const GAS v4u*)(Z + (size_t)(MP + n * 4 + t) * ODIN + c); const unsigned* pu = (const unsigned*)&uu;
            v4u o; o.x = cvtpk(bflo(pu[0]) * sp[0], bfhi(pu[0]) * sp[1]); o.y = cvtpk(bflo(pu[1]) * sp[2], bfhi(pu[1]) * sp[3]); o.z = cvtpk(bflo(pu[2]) * sp[4], bfhi(pu[2]) * sp[5]); o.w = cvtpk(bflo(pu[3]) * sp[6], bfhi(pu[3]) * sp[7]);
            *(GAS v4u*)(YAB + (size_t)(MP + n * 4 + t) * DM + c) = o; } }
    const bf16* WT = (const bf16*)(F.ws + WS_WST);
    LAS unsigned char* lds = F.lds; const int fq = lane >> 4, a = lane & 15, q4 = a >> 2, p4 = a & 3;
    for (int un = F.vcu; un < 512; un += F.G) { const int g = un & 3, ck = un >> 2; const int row0 = ck * 128;
        { const int rn = tid >> 2, c0 = (tid & 3) * 32; const bf16* zr = Z + (size_t)(row0 + rn) * ODIN + 512 + g * 128 + c0; float x[32]; float sm = 0.f;
#pragma unroll
          for (int k4 = 0; k4 < 4; ++k4) { const v4u vv = *(const GAS v4u*)(zr + 8 * k4); const unsigned* pv = (const unsigned*)&vv;
#pragma unroll
              for (int k = 0; k < 4; ++k) { x[8 * k4 + 2 * k] = bflo(pv[k]); x[8 * k4 + 2 * k + 1] = bfhi(pv[k]); sm += x[8 * k4 + 2 * k] + x[8 * k4 + 2 * k + 1]; } }
          sm += __shfl_xor(sm, 1); sm += __shfl_xor(sm, 2); const float mu = sm * (1.0f / 128.0f); float q = 0.f;
#pragma unroll
          for (int k = 0; k < 32; ++k) { x[k] -= mu; q += x[k] * x[k]; }
          q += __shfl_xor(q, 1); q += __shfl_xor(q, 2); const float rstd = __builtin_amdgcn_rsqf(q * (1.0f / 128.0f) + 1e-6f);
          const float* gp = lng + g * 128 + c0; const float* bp = lnb + g * 128 + c0;
#pragma unroll
          for (int k4 = 0; k4 < 4; ++k4) { v4u o; unsigned* po = (unsigned*)&o;
#pragma unroll
              for (int k = 0; k < 4; ++k) po[k] = cvtpk(x[8 * k4 + 2 * k] * rstd * gp[8 * k4 + 2 * k] + bp[8 * k4 + 2 * k], x[8 * k4 + 2 * k + 1] * rstd * gp[8 * k4 + 2 * k + 1] + bp[8 * k4 + 2 * k + 1]);
              *(LAS v4u*)(lds + rn * VNS + (c0 + 8 * k4) * 2) = o; } }
        __syncthreads();
        const int t = 16 * wv + a; const int nks = (wv >> 1) + 1;
        f32x4 D[8];
#pragma unroll
        for (int cb = 0; cb < 8; ++cb) D[cb] = (f32x4){0.f, 0.f, 0.f, 0.f};
        for (int ks = 0; ks < nks; ++ks) { const bf16x8 wf = *(const GAS bf16x8*)(WT + ((size_t)(g * 128 + t)) * 128 + 32 * ks + 8 * fq);
            LAS const unsigned char* vp = lds + (32 * ks + 8 * fq + q4) * VNS + p4 * 8;
#pragma unroll
            for (int cb = 0; cb < 8; ++cb) { const v4i16_t t0 = trread(vp + cb * 32), t1 = trread(vp + 4 * VNS + cb * 32);
                const bf16x8 vf = (bf16x8){t0[0], t0[1], t0[2], t0[3], t1[0], t1[1], t1[2], t1[3]};
                D[cb] = mfma16(vf, wf, D[cb]); } }
        const float bt = bs[g * 128 + t]; const size_t row = (size_t)row0 + t;
#pragma unroll
        for (int cb = 0; cb < 8; cb += 2) { const int c = g * 128 + 16 * cb + pair16_off(fq);
            float lo[4], hi[4];
#pragma unroll
            for (int j = 0; j < 4; ++j) { const auto r = __builtin_amdgcn_permlane16_swap(__builtin_bit_cast(unsigned, D[cb][j] + bt), __builtin_bit_cast(unsigned, D[cb + 1][j] + bt), false, false);
                lo[j] = __builtin_bit_cast(float, (unsigned)r[0]); hi[j] = __builtin_bit_cast(float, (unsigned)r[1]); }
            const v4u uu = *(const GAS v4u*)(Z + row * ODIN + c);
            v4u o; o.x = cvtpk(bflo(uu.x) * lo[0], bfhi(uu.x) * lo[1]); o.y = cvtpk(bflo(uu.y) * lo[2], bfhi(uu.y) * lo[3]); o.z = cvtpk(bflo(uu.z) * hi[0], bfhi(uu.z) * hi[1]); o.w = cvtpk(bflo(uu.w) * hi[2], bfhi(uu.w) * hi[3]);
            *(GAS v4u*)(YAB + row * DM + c) = o; }
        __syncthreads(); }
}

__device__ __forceinline__ void p_final(Frame& F, const Args& A, const float* SS) {
    const int gw = F.vcu * NWAVES + F.wave, NGW = F.G * NWAVES;
    const bf16* RB = (const bf16*)(F.ws + WS_RB); const float* gf = A.in[27];
    const GAS f32x4* gg = (const GAS f32x4*)gf + F.lane; f32x4 g4[4];
#pragma unroll
    for (int j = 0; j < 4; ++j) g4[j] = gg[64 * j];
    for (int m0 = gw; m0 < MALL; m0 += 2 * NGW) { u32x2 w[2][4]; float rs[2];
#pragma unroll
        for (int r = 0; r < 2; ++r) { const int m = m0 + r * NGW < MALL ? m0 + r * NGW : m0; rs[r] = pg8::row_rs(SS, m); const GAS u32x2* xr = (const GAS u32x2*)(RB + (size_t)m * DM) + F.lane;
#pragma unroll
            for (int j = 0; j < 4; ++j) w[r][j] = __builtin_nontemporal_load(xr + 64 * j); }
#pragma unroll
        for (int r = 0; r < 2; ++r) { const int m = m0 + r * NGW; if (m < MALL) { GAS f32x4* o = (GAS f32x4*)(F.out + (size_t)m * DM) + F.lane;
#pragma unroll
            for (int j = 0; j < 4; ++j) __builtin_nontemporal_store((f32x4){bflo(w[r][j].x) * g4[j][0], bfhi(w[r][j].x) * g4[j][1], bflo(w[r][j].y) * g4[j][2], bfhi(w[r][j].y) * g4[j][3]} * rs[r], o + 64 * j); } } }
}

constexpr int N_PHASES = 15;
__global__ void __launch_bounds__(NWAVES * 64, 2) mk_fwd(Args args) {
    extern __shared__ __attribute__((aligned(16))) unsigned char lds[];
    Frame F;
    F.lds = (LAS unsigned char*)lds; F.MISC = (volatile LAS unsigned*)(F.lds + MISC_OFF);
    F.tid = threadIdx.x; F.lane = F.tid & 63; F.wave = __builtin_amdgcn_readfirstlane(F.tid >> 6);
    F.G = gridDim.x; { const int bx = blockIdx.x; F.vcu = (F.G % 8 == 0) ? (bx % 8) * (F.G / 8) + bx / 8 : bx; }
    F.out = args.out; F.ws = args.ws; F.ctl = (gu32*)(args.ws + WS_CTL);
    for (int u = F.tid; u < (LDS_BYTES - LDSCTL_OFF) / 4; u += NWAVES * 64) ((LAS unsigned*)(F.lds + LDSCTL_OFF))[u] = 0u;
    __syncthreads();
    const int lo = args.ph_lo, hi = args.ph_hi;
    XcdBarrier bar; bar.bar = (unsigned*)(F.ctl + CW_BAR); bar.x = 0; bar.st = nullptr;
    if (hi - lo > 1) bar = xcd_barrier_post((unsigned*)(F.ctl + CW_BAR), F.MISC + 8);
#define IN(k) (lo <= (k) && (k) < hi)
#define SEAM(k) do { if (IN(k) && IN((k) + 1)) xcd_barrier(bar); } while (0)
#define RSTAB ((LAS float*)(F.lds + LDSCTL_OFF + 1024))
#define SITE_PTRS unsigned char* ws = args.ws; asm volatile("" : "+s"(ws)); bf16* RBb = (bf16*)(ws + WS_RB); float* SSb = (float*)(ws + WS_SS); (void)RBb; (void)SSb;
    constexpr size_t RBN = (size_t)MALL * DM, SSN = (size_t)MALL * 16;
    const int cid = (int)blockIdx.x;
    const int stag = (cid >> 3) & 1;

    if (IN(0)) { SITE_PTRS relaunder(F); p0_prologue(F, args); } SEAM(0);

            if (IN(1)) { SITE_PTRS
                pg8::Gemm g{RBb, (const bf16*)(ws + WS_WEVIN), MP, EVIN, DM}; pg8::StaticOrder S; S.init(MP, EVIN, F.G, cid);
                pg8::EpiEvIn E{(bf16*)(ws + WS_Z), SSb, (const float*)(ws + WS_ROPE), F.out, RSTAB};
                _Pragma("unroll 1") for (int st_ = 0; st_ < 2; ++st_) { if ((st_ ^ stag) == 0) sample_gemm(F.lds, E, g.A, g.Bt, g.N, g.K);
                else pg8::gemm_phase<pg8::EpiEvIn, pg8::StaticOrder, true, true>(F.lds, g, S, E); }
            } SEAM(1);
            if (IN(2)) { SITE_PTRS relaunder(F); p2_attention(F, args); relaunder(F); p3_combine_pool<2>(F, args);
                if (F.G == 256) {
                    pg8::Gemm g2{(const bf16*)(ws + WS_PB), (const bf16*)(ws + WS_WP), MP, DM, 256}; pg8::StaticOrder S2; S2.init(MP, DM, 128, F.vcu >= 128 ? F.vcu - 128 : 256);
                    pg8::EpiPlain E2{(bf16*)(ws + WS_PROJ), DM, nullptr, nullptr};
                    pg8::gemm_phase<pg8::EpiPlain, pg8::StaticOrder, true, true>(F.lds, g2, S2, E2); }
            } SEAM(2);
            if (IN(3)) { SITE_PTRS relaunder(F); p3_combine_pool<1>(F, args); } SEAM(3);
        if (IN(4)) { SITE_PTRS
            pg8::Gemm g{(const bf16*)(ws + WS_YAB), (const bf16*)(ws + WS_WEVOUT), MP, DM, DM}; pg8::StaticOrder S; S.init(MP, DM, F.G, cid);
            pg8::EpiResid<true> E{RBb, nullptr, RBb + (RBN), SSb + (SSN), nullptr, nullptr};
            _Pragma("unroll 1") for (int st_ = 0; st_ < 2; ++st_) { if ((st_ ^ stag) == 0) sample_gemm(F.lds, E, g.A, g.Bt, g.N, g.K);
            else pg8::gemm_phase<pg8::EpiResid<true>, pg8::StaticOrder, true, true>(F.lds, g, S, E); }
        } SEAM(4);
        if (IN(4 + 1)) { SITE_PTRS
            { pg8::Gemm g{RBb + (RBN), (const bf16*)(ws + WS_W1) + (size_t)0 * 1024 * FFD, MP, FFD, DM}; pg8::StaticOrder S; S.init(MP, FFD, F.G, cid);
              pg8::EpiScaled<0> E{(bf16*)(ws + WS_F), FFD, SSb + (SSN), RSTAB};
              _Pragma("unroll 1") for (int st_ = 0; st_ < 2; ++st_) { if ((st_ ^ stag) == 0) sample_gemm(F.lds, E, g.A, g.Bt, g.N, g.K);
              else pg8::gemm_phase<pg8::EpiScaled<0>, pg8::StaticOrder, true, true>(F.lds, g, S, E); } }
        }
        if (IN(4 + 1)) { SITE_PTRS
            { pg8::Gemm g{(const bf16*)(ws + WS_PB) + (size_t)0 * MALL * 256, (const bf16*)(ws + WS_WP) + (size_t)0 * 256 * 1024, MP, DM, 256}; pg8::StaticOrder S; S.init(MP, DM, F.G, cid);
              pg8::EpiPlain E{(bf16*)(ws + WS_PROJ), DM, nullptr, nullptr};
              sample_gemm(F.lds, E, g.A, g.Bt, g.N, g.K);
              if (F.G != 256) pg8::gemm_phase<pg8::EpiPlain, pg8::StaticOrder, true, true>(F.lds, g, S, E); }
        } SEAM(4 + 1);
        if (IN(4 + 2)) { SITE_PTRS
            pg8::Gemm g{(const bf16*)(ws + WS_F), (const bf16*)(ws + WS_W2) + (size_t)0 * 1024 * FFD, MP, DM, FFD}; pg8::StaticOrder S; S.init(MP, DM, F.G, cid);
            pg8::EpiResid<true> E{RBb + RBN, nullptr, RBb + (0), SSb + (0), nullptr, nullptr};
            _Pragma("unroll 1") for (int st_ = 0; st_ < 2; ++st_) { if ((st_ ^ stag) == 0) sample_gemm(F.lds, E, g.A, g.Bt, g.N, g.K);
            else pg8::gemm_phase<pg8::EpiResid<true>, pg8::StaticOrder, true, true>(F.lds, g, S, E); }
        } SEAM(4 + 2);
        if (IN(4 + 3)) { SITE_PTRS
            pg8::Gemm g{RBb + (0), (const bf16*)(ws + WS_WG) + (size_t)0 * 1024 * 1024, MP, DM, DM}; pg8::StaticOrder S; S.init(MP, DM, F.G, cid);
            pg8::EpiPle E{SSb + (0), (const bf16*)(ws + WS_PROJ), RBb + (0), RBb + (RBN), SSb + (SSN), RSTAB};
            _Pragma("unroll 1") for (int st_ = 0; st_ < 2; ++st_) { if ((st_ ^ stag) == 0) sample_gemm(F.lds, E, g.A, g.Bt, g.N, g.K);
            else pg8::gemm_phase<pg8::EpiPle, pg8::StaticOrder, true, true>(F.lds, g, S, E); }
        } SEAM(4 + 3);
            if (IN(8)) { SITE_PTRS
                pg8::Gemm g{RBb + RBN, (const bf16*)(ws + WS_WODIN), MP, ODIN, DM}; pg8::StaticOrder S; S.init(MP, ODIN, F.G, cid);
                pg8::EpiScaled<1> E{(bf16*)(ws + WS_Z), ODIN, SSb + SSN, RSTAB};
                _Pragma("unroll 1") for (int st_ = 0; st_ < 2; ++st_) { if ((st_ ^ stag) == 0) sample_gemm(F.lds, E, g.A, g.Bt, g.N, g.K);
                else pg8::gemm_phase<pg8::EpiScaled<1>, pg8::StaticOrder, true, true>(F.lds, g, S, E); }
                if (F.G == 256) {
                    pg8::Gemm g2{(const bf16*)(ws + WS_PB) + (size_t)1 * MALL * 256, (const bf16*)(ws + WS_WP) + (size_t)1 * 256 * 1024, MP, DM, 256}; pg8::StaticOrder S2; S2.init(MP, DM, 128, cid >= 128 ? cid - 128 : 256);
                    pg8::EpiPlain E2{(bf16*)(ws + WS_PROJ), DM, nullptr, nullptr};
                    pg8::gemm_phase<pg8::EpiPlain, pg8::StaticOrder, true, true>(F.lds, g2, S2, E2); }
            } SEAM(8);
            if (IN(9)) { SITE_PTRS relaunder(F); p9_oddmix(F, args); } SEAM(9);
        if (IN(10)) { SITE_PTRS
            pg8::Gemm g{(const bf16*)(ws + WS_YAB), (const bf16*)(ws + WS_WODOUT), MP, DM, DM}; pg8::StaticOrder S; S.init(MP, DM, F.G, cid);
            pg8::EpiResid<true> E{RBb + RBN, nullptr, RBb + (0), SSb + (0), nullptr, nullptr};
            _Pragma("unroll 1") for (int st_ = 0; st_ < 2; ++st_) { if ((st_ ^ stag) == 0) sample_gemm(F.lds, E, g.A, g.Bt, g.N, g.K);
            else pg8::gemm_phase<pg8::EpiResid<true>, pg8::StaticOrder, true, true>(F.lds, g, S, E); }
        } SEAM(10);
        if (IN(10 + 1)) { SITE_PTRS
            { pg8::Gemm g{RBb + (0), (const bf16*)(ws + WS_W1) + (size_t)1 * 1024 * FFD, MP, FFD, DM}; pg8::StaticOrder S; S.init(MP, FFD, F.G, cid);
              pg8::EpiScaled<0> E{(bf16*)(ws + WS_F), FFD, SSb + (0), RSTAB};
              _Pragma("unroll 1") for (int st_ = 0; st_ < 2; ++st_) { if ((st_ ^ stag) == 0) sample_gemm(F.lds, E, g.A, g.Bt, g.N, g.K);
              else pg8::gemm_phase<pg8::EpiScaled<0>, pg8::StaticOrder, true, true>(F.lds, g, S, E); } }
        }
        if (IN(10 + 1)) { SITE_PTRS
            { pg8::Gemm g{(const bf16*)(ws + WS_PB) + (size_t)1 * MALL * 256, (const bf16*)(ws + WS_WP) + (size_t)1 * 256 * 1024, MP, DM, 256}; pg8::StaticOrder S; S.init(MP, DM, F.G, cid);
              pg8::EpiPlain E{(bf16*)(ws + WS_PROJ), DM, nullptr, nullptr};
              sample_gemm(F.lds, E, g.A, g.Bt, g.N, g.K);
              if (F.G != 256) pg8::gemm_phase<pg8::EpiPlain, pg8::StaticOrder, true, true>(F.lds, g, S, E); }
        } SEAM(10 + 1);
        if (IN(10 + 2)) { SITE_PTRS
            pg8::Gemm g{(const bf16*)(ws + WS_F), (const bf16*)(ws + WS_W2) + (size_t)1 * 1024 * FFD, MP, DM, FFD}; pg8::StaticOrder S; S.init(MP, DM, F.G, cid);
            pg8::EpiResid<true> E{RBb, nullptr, RBb + (RBN), SSb + (SSN), nullptr, nullptr};
            _Pragma("unroll 1") for (int st_ = 0; st_ < 2; ++st_) { if ((st_ ^ stag) == 0) sample_gemm(F.lds, E, g.A, g.Bt, g.N, g.K);
            else pg8::gemm_phase<pg8::EpiResid<true>, pg8::StaticOrder, true, true>(F.lds, g, S, E); }
        } SEAM(10 + 2);
        if (IN(10 + 3)) { SITE_PTRS
            pg8::Gemm g{RBb + (RBN), (const bf16*)(ws + WS_WG) + (size_t)1 * 1024 * 1024, MP, DM, DM}; pg8::StaticOrder S; S.init(MP, DM, F.G, cid);
            pg8::EpiPle E{SSb + (SSN), (const bf16*)(ws + WS_PROJ), RBb + (RBN), RBb + (0), SSb + (0), RSTAB};
            _Pragma("unroll 1") for (int st_ = 0; st_ < 2; ++st_) { if ((st_ ^ stag) == 0) sample_gemm(F.lds, E, g.A, g.Bt, g.N, g.K);
            else pg8::gemm_phase<pg8::EpiPle, pg8::StaticOrder, true, true>(F.lds, g, S, E); }
        } SEAM(10 + 3);
    if (IN(14)) { SITE_PTRS relaunder(F); p_final(F, args, SSb); }
#undef IN
#undef SEAM
}

extern "C" void kernel_launch(void* const* d_in, const int* in_sizes, int n_in, void* d_out, int out_size, void* d_ws, size_t ws_size, hipStream_t stream) {
    static int grid = 0;
    if (grid == 0) {
        if (n_in != 28 || out_size != (int)pg8::O_END || ws_size < WS_END) { fprintf(stderr, "kernel_launch: unexpected shapes n_in %d out %d ws %zu\n", n_in, out_size, ws_size); grid = -1; return; }
        int dev = 0, cus = 0, per_cu = 0;
        if (hipGetDevice(&dev) != hipSuccess || hipDeviceGetAttribute(&cus, hipDeviceAttributeMultiprocessorCount, dev) != hipSuccess) { grid = -1; return; }
        if (hipFuncSetAttribute((const void*)mk_fwd, hipFuncAttributeMaxDynamicSharedMemorySize, LDS_BYTES) != hipSuccess) { fprintf(stderr, "kernel_launch: hipFuncSetAttribute failed\n"); grid = -1; return; }
        if (hipOccupancyMaxActiveBlocksPerMultiprocessor(&per_cu, (const void*)mk_fwd, NWAVES * 64, LDS_BYTES) != hipSuccess || per_cu < 1) fprintf(stderr, "kernel_launch: occupancy query says %d\n", per_cu);
        (void)hipGetLastError();
        grid = cus;
    }
    if (grid < 0) return;
    (void)in_sizes;
    if (hipMemsetAsync((char*)d_ws + WS_CTL, 0, CTL_ZERO_BYTES, stream) != hipSuccess) return;
    Args a{};
    for (int i = 0; i < 28; ++i) a.in[i] = (const float*)d_in[i];
    a.out = (float*)d_out; a.ws = (unsigned char*)d_ws;
    a.ph_lo = 0; a.ph_hi = N_PHASES;
    hipLaunchKernelGGL(mk_fwd, dim3(grid), dim3(NWAVES * 64), LDS_BYTES, stream, a);
}
```

```cpp
#include <hip/hip_runtime.h>
#include <cstdio>
#include <cstdint>
#include <cmath>
namespace pg8 {
#define PG8_LAS __attribute__((address_space(3)))
#define PG8_GAS __attribute__((address_space(1)))
typedef unsigned short bf16_t;
typedef short bf16x8 __attribute__((ext_vector_type(8)));
typedef float f32x4 __attribute__((ext_vector_type(4)));
typedef unsigned u32x4 __attribute__((ext_vector_type(4)));
constexpr int BM = 256, BK = 64, HALF = 128, HTB = HALF * BK * 2  , STAGE_BYTES = 8 * HTB, NXCD = 8, WGM = 8;

__host__ __device__ __forceinline__ int lds_byte(int r, int c) { const int st = (r >> 4) * 2 + (c >> 5), rr = r & 15, cc = c & 31, ob = rr * 64 + cc * 2; return st * 1024 + (ob ^ (((ob >> 9) & 1) << 5)); }
__host__ __device__ __forceinline__ void stage_rc(int b, int& R, int& C) { const int st = b / 1024, sb = b % 1024, swz = sb ^ (((sb >> 9) & 1) << 5); R = (st >> 1) * 16 + swz / 64; C = (st & 1) * 32 + (swz % 64) / 2; }
__host__ __device__ __forceinline__ int perm32(int rho) { const int n = rho >> 4, i = rho & 15; return 8 * (i >> 2) + 4 * n + (i & 3); }

struct Unit { int pm, pn; };
struct Gemm { const bf16_t* A; const bf16_t* Bt; int M, N, K; };

struct StaticOrder {
    int nM, nN, nwg, G, c;
    __host__ __device__ void init(int M, int N, int G_, int c_) { nM = M / BM; nN = N / BM; nwg = nM * nN; G = G_; c = c_; }
    __host__ __device__ bool next(int i, Unit& u) const {
        const long L = (long)i * G + c; if (L >= nwg) return false;
        int wgid = (int)L; { const int q = nwg / NXCD, r = nwg % NXCD, xcd = wgid % NXCD, off = wgid / NXCD; wgid = (xcd < r ? xcd * (q + 1) : r * (q + 1) + (xcd - r) * q) + off; }
        const int nig = WGM * nN, gid = wgid / nig, fm = gid * WGM, gsz = (nM - fm) < WGM ? (nM - fm) : WGM;
        u.pm = fm + ((wgid % nig) % gsz); u.pn = (wgid % nig) / gsz; return true;
    }
    __device__ __forceinline__ void a_ready(const Unit&) const {}
    __device__ __forceinline__ void done(const Unit&) const {}
};

typedef float f32x2c __attribute__((ext_vector_type(2))); typedef __bf16 bf16x2c __attribute__((ext_vector_type(2)));
__device__ __forceinline__ unsigned cvt_pk_bf16(float lo, float hi) { const f32x2c v = {lo, hi}; return __builtin_bit_cast(unsigned, __builtin_convertvector(v, bf16x2c)); }
typedef float f32x2 __attribute__((ext_vector_type(2)));
typedef unsigned u32x2 __attribute__((ext_vector_type(2)));
constexpr int DM = 1024, SEQ = 8192, MP = 2 * SEQ, MS = 512, MALL = MP + MS;
constexpr int EVIN = 5120, ODIN = 2560, FFD = 4096;
constexpr float C2 = 0.125f * 1.4426950408889634f;
constexpr size_t O_YP = 0, O_YS = O_YP + (size_t)MP * DM, O_KVP0 = O_YS + (size_t)MS * DM, O_KVP1 = O_KVP0 + 2 * 128 * 1024, O_KVP2 = O_KVP1 + 2 * 512 * 1024,
                 O_KVS0 = O_KVP2 + 2 * 2048 * 1024, O_KVS1 = O_KVS0 + (size_t)MS * 1024, O_KVS2 = O_KVS1 + (size_t)MS * 1024, O_POOLP = O_KVS2 + (size_t)MS * 1024,
                 O_POOLS = O_POOLP + 2 * 15 * 512, O_CONVP = O_POOLS + 128 * 15 * 512, O_CONVS = O_CONVP + 2 * 2 * 512, O_CVS = O_CONVS + 128 * 2 * 512, O_END = O_CVS + (size_t)MS * 512;
static_assert(O_END == 25773056, "output size");

__device__ __forceinline__ float row_rs(const float* SS, int row) {
    const PG8_GAS f32x4* p = (const PG8_GAS f32x4*)(SS + (size_t)row * 16);
    const f32x4 a = p[0], b = p[1], c = p[2], d = p[3];
    const float s = (((a[0] + a[1]) + (a[2] + a[3])) + ((b[0] + b[1]) + (b[2] + b[3]))) + (((c[0] + c[1]) + (c[2] + c[3])) + ((d[0] + d[1]) + (d[2] + d[3])));
    return __builtin_amdgcn_rsqf(s * (1.0f / 1024.0f) + 1e-6f);
}
__device__ __forceinline__ u32x4 pack8(const f32x4 v0, const f32x4 v1) { u32x4 w; w.x = cvt_pk_bf16(v0[0], v0[1]); w.y = cvt_pk_bf16(v0[2], v0[3]); w.z = cvt_pk_bf16(v1[0], v1[1]); w.w = cvt_pk_bf16(v1[2], v1[3]); return w; }
__device__ __forceinline__ u32x2 pack4(const f32x4 v) { u32x2 w; w.x = cvt_pk_bf16(v[0], v[1]); w.y = cvt_pk_bf16(v[2], v[3]); return w; }
__device__ __forceinline__ float bf_lo(unsigned w) { return __builtin_bit_cast(float, w << 16); }
__device__ __forceinline__ float bf_hi(unsigned w) { return __builtin_bit_cast(float, w & 0xffff0000u); }

__device__ __forceinline__ void st16(void* base, size_t off, const u32x4 v) { *(PG8_GAS u32x4*)((PG8_GAS char*)base + off) = v; }
__device__ __forceinline__ void st8(void* base, size_t off, const u32x2 v) { *(PG8_GAS u32x2*)((PG8_GAS char*)base + off) = v; }
__device__ __forceinline__ void stf8(float* p, const f32x4 v0, const f32x4 v1) { *(PG8_GAS f32x4*)p = v0; *(PG8_GAS f32x4*)(p + 4) = v1; }
#define PG8_EPI_CALL \
    __device__ __forceinline__ void operator()(const f32x4 (&acc)[2][2][4][2], const Unit& u, int wr_, int wc_, int fr_, int fq_, bool fresh) const { \
        int wr = wr_, wc = wc_, fr = fr_, fq = fq_; asm volatile("" : "+s"(wr), "+s"(wc), "+v"(fr), "+v"(fq));     \
        float rsv[2][4]; \
        if constexpr (USE_RS) { PG8_LAS float* tab = rstab + (wr * 4 + wc) * 128; const int ln = fq * 16 + fr; \
            if (fresh) { _Pragma("unroll") for (int ai = 0; ai < 2; ++ai) tab[ai * 64 + ln] = row_rs(SS, u.pm * BM + ai * HALF + wr * 64 + ln);     \
                asm volatile("s_waitcnt lgkmcnt(0)" ::: "memory"); } \
            _Pragma("unroll") for (int ai = 0; ai < 2; ++ai) _Pragma("unroll") for (int m = 0; m < 4; ++m) rsv[ai][m] = tab[ai * 64 + m * 16 + fr]; \
        } else { _Pragma("unroll") for (int ai = 0; ai < 2; ++ai) _Pragma("unroll") for (int m = 0; m < 4; ++m) rsv[ai][m] = 0.f; } \
        _Pragma("unroll") for (int ai = 0; ai < 2; ++ai) _Pragma("unroll") for (int m = 0; m < 4; ++m) { \
            const f32x4 a[2][2] = {{acc[ai][0][m][0], acc[ai][0][m][1]}, {acc[ai][1][m][0], acc[ai][1][m][1]}}; \
            rg(a, u.pm * BM + ai * HALF + wr * 64 + m * 16 + fr, u.pn, wc, fq, rsv[ai][m]); } \
        if constexpr (HAS_FIN) fin(u, wr, wc, fq * 16 + fr); }

struct EpiEvIn {
    static constexpr bool PERM = true, AFTER_DRAIN = false, USE_RS = true, HAS_FIN = false;
    __device__ __forceinline__ void fin(const Unit&, int, int, int) const {}
    bf16_t* Z; const float* SS; const float* rope; float* out; PG8_LAS float* rstab;
    __device__ __forceinline__ void rg(const f32x4 (&a)[2][2], int row, int pn, int wc, int fq, float rs) const {
        const int part = pn < 2 ? 0 : (pn - 2) % 6, g = pn < 2 ? 0 : (pn - 2) / 6;
        const int kind = pn < 2 ? 3 : (part >> 1);
        const int hoff = (part & 1) * 4;
        const int keep = 128 << (2 * g);
        float* kvp = out + (g == 0 ? O_KVP0 : (g == 1 ? O_KVP1 : O_KVP2));
        float* kvs = out + (g == 0 ? O_KVS0 : (g == 1 ? O_KVS1 : O_KVS2));
        const bool samp = row >= MP; const int ms = row - MP;
        const int t = samp ? (ms & 3) : (row & (SEQ - 1));
        const int nb = samp ? (ms >> 2) : (row >> 13);
        const size_t zro = ((size_t)row * EVIN + pn * BM) * 2;
        const int cb = wc * 64 + 8 * fq;
        if (kind == 3) {
#pragma unroll
            for (int bj = 0; bj < 2; ++bj) { const f32x4 v0 = a[bj][0] * rs, v1 = a[bj][1] * rs; const int ct = cb + 32 * bj;
                st16(Z, zro + ct * 2, pack8(v0, v1));
                const int ch = pn * BM + ct;
                if (samp) stf8(out + O_POOLS + (size_t)(nb * 15 + 11 + t) * 512 + ch, v0, v1);
                else if (t >= SEQ - 15) stf8(out + O_POOLP + (size_t)(nb * 15 + (t - (SEQ - 15))) * 512 + ch, v0, v1); }
        } else if (kind == 2) {
#pragma unroll
            for (int bj = 0; bj < 2; ++bj) { const f32x4 v0 = a[bj][0] * rs, v1 = a[bj][1] * rs; const int ct = cb + 32 * bj;
                st16(Z, zro + ct * 2, pack8(v0, v1));
                const int hd = hoff * 64 + ct;
                if (samp) stf8(kvs + ((size_t)ms * 2 + 1) * 512 + hd, v0, v1);
                else if (t >= SEQ - keep) stf8(kvp + ((size_t)(nb * keep + (t - (SEQ - keep))) * 2 + 1) * 512 + hd, v0, v1); }
        } else {
            const int pos = samp ? 2048 + t : t;
            const PG8_GAS f32x4* tp = (const PG8_GAS f32x4*)(rope + ((size_t)pos * 32 + 8 * fq) * 2);
            const float sc = (kind == 0) ? C2 * rs : rs;
            f32x4 o1[2], o2[2];
#pragma unroll
            for (int n = 0; n < 2; ++n) { const f32x4 cs0 = tp[2 * n], cs1 = tp[2 * n + 1];
                const f32x4 x1 = a[0][n] * sc, x2 = a[1][n] * sc;
                o1[n][0] = x1[0] * cs0[0] - x2[0] * cs0[1]; o2[n][0] = x2[0] * cs0[0] + x1[0] * cs0[1];
                o1[n][1] = x1[1] * cs0[2] - x2[1] * cs0[3]; o2[n][1] = x2[1] * cs0[2] + x1[1] * cs0[3];
                o1[n][2] = x1[2] * cs1[0] - x2[2] * cs1[1]; o2[n][2] = x2[2] * cs1[0] + x1[2] * cs1[1];
                o1[n][3] = x1[3] * cs1[2] - x2[3] * cs1[3]; o2[n][3] = x2[3] * cs1[2] + x1[3] * cs1[3]; }
            st16(Z, zro + cb * 2, pack8(o1[0], o1[1])); st16(Z, zro + (cb + 32) * 2, pack8(o2[0], o2[1]));
            if (kind == 1) {
                const int hd = (hoff + wc) * 64 + 8 * fq;
                float* p = nullptr;
                if (samp) p = kvs + ((size_t)ms * 2) * 512 + hd; else if (t >= SEQ - keep) p = kvp + ((size_t)(nb * keep + (t - (SEQ - keep))) * 2) * 512 + hd;
                if (p) { stf8(p, o1[0], o1[1]); stf8(p + 32, o2[0], o2[1]); }
            }
        }
    }
    PG8_EPI_CALL
};
struct EpiPlain {
    static constexpr bool PERM = true, AFTER_DRAIN = false, USE_RS = false, HAS_FIN = false;
    __device__ __forceinline__ void fin(const Unit&, int, int, int) const {}
    bf16_t* O; int ldc; const float* SS; PG8_LAS float* rstab;
    __device__ __forceinline__ void rg(const f32x4 (&a)[2][2], int row, int pn, int wc, int fq, float rs) const {
        const size_t rowo = ((size_t)row * ldc + pn * BM + wc * 64 + 8 * fq) * 2;
#pragma unroll
        for (int bj = 0; bj < 2; ++bj) st16(O, rowo + bj * 32 * 2, pack8(a[bj][0], a[bj][1]));
    }
    PG8_EPI_CALL
};
template <int MODE> struct EpiScaled {
    static constexpr bool PERM = true, AFTER_DRAIN = false, USE_RS = true, HAS_FIN = false;
    __device__ __forceinline__ void fin(const Unit&, int, int, int) const {}
    bf16_t* O; int ldc; const float* SS; PG8_LAS float* rstab;
    __device__ __forceinline__ void rg(const f32x4 (&a)[2][2], int row, int pn, int wc, int fq, float rs) const {
        const bool act = (MODE == 0) || (pn < 4);
        const size_t rowo = ((size_t)row * ldc + pn * BM + wc * 64 + 8 * fq) * 2;
#pragma unroll
        for (int bj = 0; bj < 2; ++bj) { f32x4 v[2] = {a[bj][0] * rs, a[bj][1] * rs};
            if (MODE == 0) {
#pragma unroll
                for (int n = 0; n < 2; ++n)
#pragma unroll
                    for (int j = 0; j < 4; ++j) { const float x = __builtin_fmaxf(v[n][j], 0.f); v[n][j] = x * x; }
            } else if (act) {
#pragma unroll
                for (int n = 0; n < 2; ++n)
#pragma unroll
                    for (int j = 0; j < 4; ++j) { const float x = v[n][j]; const float uu = x * (0.7978845608028654f + 0.035677408136300125f * x * x);
                        v[n][j] = x * __builtin_amdgcn_rcpf(1.0f + __builtin_amdgcn_exp2f(-2.8853900817779268f * uu)); }
            }
            st16(O, rowo + bj * 32 * 2, pack8(v[0], v[1])); }
    }
    PG8_EPI_CALL
};
template <bool BASE_BF16> struct EpiResid {
    static constexpr bool PERM = true, AFTER_DRAIN = false, USE_RS = false, HAS_FIN = true;
    const void* baseP; const void* baseS; bf16_t* RB; float* SSo; const float* SS; PG8_LAS float* rstab; PG8_LAS float* sstab;
    __device__ __forceinline__ void rg(const f32x4 (&a)[2][2], int row, int pn, int wc, int fq, float rs) const {
        const int col0 = pn * BM + wc * 64 + 8 * fq;
        float sq = 0.f;
#pragma unroll
        for (int bj = 0; bj < 2; ++bj) { f32x4 v0, v1;
            if (BASE_BF16) { const u32x4 b = *(const PG8_GAS u32x4*)((const bf16_t*)baseP + (size_t)row * DM + col0 + bj * 32);
                v0 = (f32x4){bf_lo(b.x), bf_hi(b.x), bf_lo(b.y), bf_hi(b.y)} + a[bj][0]; v1 = (f32x4){bf_lo(b.z), bf_hi(b.z), bf_lo(b.w), bf_hi(b.w)} + a[bj][1]; }
            else { const float* bp = (row < MP ? (const float*)baseP + (size_t)row * DM : (const float*)baseS + (size_t)(row - MP) * DM) + col0 + bj * 32;
                v0 = *(const PG8_GAS f32x4*)bp + a[bj][0]; v1 = *(const PG8_GAS f32x4*)(bp + 4) + a[bj][1]; }
            st16(RB, ((size_t)row * DM + col0 + bj * 32) * 2, pack8(v0, v1));
            sq += ((v0[0] * v0[0] + v0[1] * v0[1]) + (v0[2] * v0[2] + v0[3] * v0[3])) + ((v1[0] * v1[0] + v1[1] * v1[1]) + (v1[2] * v1[2] + v1[3] * v1[3])); }
        sq += __shfl_xor(sq, 16); sq += __shfl_xor(sq, 32);
        if (fq == 0) { if (row >= MP) *(PG8_GAS float*)(SSo + (size_t)row * 16 + pn * 4 + wc) = sq; else sstab[(row & 255) * 4 + wc] = sq; }
    }
    __device__ __forceinline__ void fin(const Unit& u, int wr, int wc, int lane) const {
        asm volatile("s_waitcnt lgkmcnt(0)" ::: "memory"); __builtin_amdgcn_s_barrier(); asm volatile("" ::: "memory");
        if (lane < 32) { const int row = (wr * 4 + wc) * 32 + lane; const f32x4 v = *(const PG8_LAS f32x4*)(sstab + row * 4);
            *(PG8_GAS f32x4*)(SSo + ((size_t)u.pm * BM + row) * 16 + u.pn * 4) = v; }
    }
    PG8_EPI_CALL
};
struct EpiPle {
    static constexpr bool PERM = true, AFTER_DRAIN = false, USE_RS = true, HAS_FIN = true;
    const float* SS; const bf16_t* PROJ; const bf16_t* RBi; bf16_t* RB; float* SSo; PG8_LAS float* rstab; PG8_LAS float* sstab;
    __device__ __forceinline__ void rg(const f32x4 (&a)[2][2], int row, int pn, int wc, int fq, float rs) const {
        const int col0 = pn * BM + wc * 64 + 8 * fq;
        rs *= -1.4426950408889634f;
        float sq = 0.f;
#pragma unroll
        for (int bj = 0; bj < 2; ++bj) { const size_t off = (size_t)row * DM + col0 + bj * 32;
            const u32x4 pj = *(const PG8_GAS u32x4*)(PROJ + off), b = *(const PG8_GAS u32x4*)(RBi + off);
            const f32x4 a0 = a[bj][0] * rs, a1 = a[bj][1] * rs;
            f32x4 g0, g1;
#pragma unroll
            for (int j = 0; j < 4; ++j) { g0[j] = __builtin_amdgcn_rcpf(1.0f + __builtin_amdgcn_exp2f(a0[j])); g1[j] = __builtin_amdgcn_rcpf(1.0f + __builtin_amdgcn_exp2f(a1[j])); }
            f32x4 v0, v1;
            v0[0] = bf_lo(b.x) + g0[0] * bf_lo(pj.x); v0[1] = bf_hi(b.x) + g0[1] * bf_hi(pj.x); v0[2] = bf_lo(b.y) + g0[2] * bf_lo(pj.y); v0[3] = bf_hi(b.y) + g0[3] * bf_hi(pj.y);
            v1[0] = bf_lo(b.z) + g1[0] * bf_lo(pj.z); v1[1] = bf_hi(b.z) + g1[1] * bf_hi(pj.z); v1[2] = bf_lo(b.w) + g1[2] * bf_lo(pj.w); v1[3] = bf_hi(b.w) + g1[3] * bf_hi(pj.w);
            st16(RB, off * 2, pack8(v0, v1));
            sq += ((v0[0] * v0[0] + v0[1] * v0[1]) + (v0[2] * v0[2] + v0[3] * v0[3])) + ((v1[0] * v1[0] + v1[1] * v1[1]) + (v1[2] * v1[2] + v1[3] * v1[3])); }
        sq += __shfl_xor(sq, 16); sq += __shfl_xor(sq, 32);
        if (fq == 0) { if (row >= MP) *(PG8_GAS float*)(SSo + (size_t)row * 16 + pn * 4 + wc) = sq; else sstab[(row & 255) * 4 + wc] = sq; }
    }
    __device__ __forceinline__ void fin(const Unit& u, int wr, int wc, int lane) const {
        asm volatile("s_waitcnt lgkmcnt(0)" ::: "memory"); __builtin_amdgcn_s_barrier(); asm volatile("" ::: "memory");
        if (lane < 32) { const int row = (wr * 4 + wc) * 32 + lane; const f32x4 v = *(const PG8_LAS f32x4*)(sstab + row * 4);
            *(PG8_GAS f32x4*)(SSo + ((size_t)u.pm * BM + row) * 16 + u.pn * 4) = v; }
    }
    PG8_EPI_CALL
};
template <class Epi, class Sched, bool ALIGN_EPI = false, bool SP2 = false>
__device__ __forceinline__ void gemm_phase(PG8_LAS unsigned char* lds, const Gemm g, const Sched& S, const Epi& E) {
    int tid_ = threadIdx.x; asm volatile("" : "+v"(tid_));
    const int tid = tid_, wid = __builtin_amdgcn_readfirstlane(tid >> 6), lane = tid & 63, wr = wid >> 2, wc = wid & 3, fr = lane & 15, fq = lane >> 4;
    int K_ = g.K; asm volatile("" : "+s"(K_));
    const int K = K_, nt = K / BK;
    unsigned voffA[2], voffB[2];
#pragma unroll
    for (int i = 0; i < 2; ++i) { int R, C; stage_rc(tid * 16 + i * 8192, R, C); const int Rb = Epi::PERM ? (64 * (R >> 5) + perm32(R & 31)) : R;
        voffA[i] = (unsigned)(R * K + C) * 2u; voffB[i] = (unsigned)(Rb * K + C) * 2u; }
    const size_t kstep = (size_t)(BK * 2);
    const size_t hstep = (size_t)HALF * K * 2;
    const size_t tstep = 2 * hstep;
    const size_t bstep = Epi::PERM ? (size_t)32 * K * 2 : hstep;
    const unsigned ldsw = (unsigned)wid * 1024u;
    const int aoff = lds_byte(wr * 64 + fr, fq * 8), boff = lds_byte(wc * 32 + fr, fq * 8);
#define PG8_SA(b, h) (((b) * 2 + (h)) * HTB)
#define PG8_SB(b, h) ((4 + (b) * 2 + (h)) * HTB)
#define PG8_STAGE(bufoff, gbase, voff) do { _Pragma("unroll") for (int _i = 0; _i < 2; ++_i) \
        __builtin_amdgcn_global_load_lds((const unsigned*)((const char*)(gbase) + (voff)[_i]), (PG8_LAS unsigned*)(lds + (bufoff) + ldsw + _i * 8192), 16, 0, 0); } while (0)
#define PG8_LDA(dst, b, h) do { _Pragma("unroll") for (int m = 0; m < 4; ++m) _Pragma("unroll") for (int k = 0; k < 2; ++k) dst[m][k] = *(const PG8_LAS bf16x8*)(lds + PG8_SA(b, h) + aoff + m * 2048 + k * 1024); } while (0)
#define PG8_LDB(dst, b, h) do { _Pragma("unroll") for (int n = 0; n < 2; ++n) _Pragma("unroll") for (int k = 0; k < 2; ++k) dst[n][k] = *(const PG8_LAS bf16x8*)(lds + PG8_SB(b, h) + boff + n * 2048 + k * 1024); } while (0)
#define PG8_MMA(ai, bj, At, Bt) do { __builtin_amdgcn_s_setprio(1); _Pragma("unroll") for (int m = 0; m < 4; ++m) _Pragma("unroll") for (int n = 0; n < 2; ++n) _Pragma("unroll") for (int k = 0; k < 2; ++k) \
        acc[ai][bj][m][n] = __builtin_amdgcn_mfma_f32_16x16x32_bf16(Bt[n][k], At[m][k], acc[ai][bj][m][n], 0, 0, 0); __builtin_amdgcn_s_setprio(0); } while (0)
#define PG8_WAIT_V(n) asm volatile("s_waitcnt vmcnt(" #n ")" ::: "memory")
#define PG8_WAIT_L(n) asm volatile("s_waitcnt lgkmcnt(" #n ")" ::: "memory")
#define PG8_BAR __builtin_amdgcn_s_barrier()
#define PG8_SCHED __builtin_amdgcn_sched_barrier(0)
    Unit cur, nxt; int ui = 0, rs_pm = -1;
    if (!S.next(0, cur)) return;
    f32x4 acc[2][2][4][2];
#pragma unroll
    for (int a = 0; a < 2; ++a)
#pragma unroll
        for (int b = 0; b < 2; ++b)
#pragma unroll
            for (int m = 0; m < 4; ++m)
#pragma unroll
                for (int n = 0; n < 2; ++n) acc[a][b][m][n] = (f32x4){0.f, 0.f, 0.f, 0.f};
    bf16x8 At[4][2], B0[2][2], B1[2][2];
    const char* cA = (const char*)g.A + (size_t)cur.pm * tstep; const char* cB = (const char*)g.Bt + (size_t)cur.pn * tstep;
    S.a_ready(cur);
    if constexpr (SP2) {
        PG8_STAGE(PG8_SB(0, 0), cB, voffB); PG8_STAGE(PG8_SB(0, 1), cB + bstep, voffB); PG8_STAGE(PG8_SA(0, 0), cA, voffA); PG8_STAGE(PG8_SA(0, 1), cA + hstep, voffA);
        if (wr == 1) PG8_BAR;
        PG8_WAIT_V(2); PG8_BAR;
        PG8_STAGE(PG8_SB(1, 0), cB + kstep, voffB); PG8_STAGE(PG8_SA(1, 0), cA + kstep, voffA); PG8_STAGE(PG8_SB(1, 1), cB + bstep + kstep, voffB);
        PG8_WAIT_V(6); PG8_BAR;
    } else {
        PG8_STAGE(PG8_SB(0, 0), cB, voffB); PG8_STAGE(PG8_SA(0, 0), cA, voffA); PG8_STAGE(PG8_SB(0, 1), cB + bstep, voffB); PG8_STAGE(PG8_SA(0, 1), cA + hstep, voffA);
        if (wr == 1) PG8_BAR;
        PG8_WAIT_V(4); PG8_BAR;
        PG8_STAGE(PG8_SB(1, 0), cB + kstep, voffB); PG8_STAGE(PG8_SA(1, 0), cA + kstep, voffA); PG8_STAGE(PG8_SB(1, 1), cB + bstep + kstep, voffB);
        PG8_WAIT_V(6); PG8_BAR;
    }
    for (;;) {
        const bool has_next = S.next(ui + 1, nxt);
        const char* nA = has_next ? (const char*)g.A + (size_t)nxt.pm * tstep : cA; const char* nB = has_next ? (const char*)g.Bt + (size_t)nxt.pn * tstep : cB;
        for (int t = 0; t < nt; t += 2) {
            const bool last = (t == nt - 2);
            const char* a1 = cA + (size_t)(t + 1) * kstep;
            const char* a2 = last ? nA : cA + (size_t)(t + 2) * kstep; const char* b2 = last ? nB : cB + (size_t)(t + 2) * kstep;
            const char* a3 = a2 + kstep; const char* b3 = b2 + kstep;
            if (last && has_next) S.a_ready(nxt);
            if constexpr (SP2) {
            PG8_LDB(B0, 0, 0); PG8_LDB(B1, 0, 1); PG8_SCHED; PG8_LDA(At, 0, 0); PG8_STAGE(PG8_SA(1, 1), a1 + hstep, voffA);
            PG8_WAIT_V(8); PG8_WAIT_L(0); PG8_BAR; PG8_MMA(0, 0, At, B0); PG8_MMA(0, 1, At, B1); PG8_BAR; PG8_SCHED;
            PG8_LDA(At, 0, 1); PG8_STAGE(PG8_SB(0, 0), b2, voffB); PG8_STAGE(PG8_SB(0, 1), b2 + bstep, voffB); PG8_STAGE(PG8_SA(0, 0), a2, voffA);
            PG8_WAIT_V(8); PG8_WAIT_L(0); PG8_BAR; PG8_MMA(1, 0, At, B0); PG8_MMA(1, 1, At, B1); PG8_BAR; PG8_SCHED;
            PG8_LDB(B0, 1, 0); PG8_LDB(B1, 1, 1); PG8_SCHED; PG8_LDA(At, 1, 0); PG8_STAGE(PG8_SA(0, 1), a2 + hstep, voffA);
            PG8_WAIT_V(8); PG8_WAIT_L(0); PG8_BAR; PG8_MMA(0, 0, At, B0); PG8_MMA(0, 1, At, B1); PG8_BAR; PG8_SCHED;
            PG8_LDA(At, 1, 1); PG8_STAGE(PG8_SB(1, 0), b3, voffB); PG8_STAGE(PG8_SB(1, 1), b3 + bstep, voffB); PG8_STAGE(PG8_SA(1, 0), a3, voffA);
            PG8_WAIT_V(8); PG8_WAIT_L(0); PG8_BAR; PG8_MMA(1, 0, At, B0); PG8_MMA(1, 1, At, B1); PG8_BAR; PG8_SCHED;
            } else {
            PG8_LDB(B0, 0, 0); PG8_SCHED; PG8_LDA(At, 0, 0); PG8_STAGE(PG8_SA(1, 1), a1 + hstep, voffA);
            PG8_WAIT_L(8); PG8_BAR; PG8_WAIT_L(0); PG8_MMA(0, 0, At, B0); PG8_BAR; PG8_SCHED;
            PG8_LDB(B1, 0, 1); PG8_STAGE(PG8_SB(0, 0), b2, voffB);
            PG8_BAR; PG8_WAIT_L(0); PG8_MMA(0, 1, At, B1); PG8_BAR;
            PG8_LDA(At, 0, 1); PG8_STAGE(PG8_SA(0, 0), a2, voffA);
            PG8_BAR; PG8_WAIT_L(0); PG8_MMA(1, 0, At, B0); PG8_BAR; PG8_SCHED;
            PG8_STAGE(PG8_SB(0, 1), b2 + bstep, voffB);
            PG8_WAIT_V(6); PG8_BAR; PG8_MMA(1, 1, At, B1); PG8_BAR;
            PG8_LDB(B0, 1, 0); PG8_SCHED; PG8_LDA(At, 1, 0); PG8_STAGE(PG8_SA(0, 1), a2 + hstep, voffA);
            PG8_WAIT_L(8); PG8_BAR; PG8_WAIT_L(0); PG8_MMA(0, 0, At, B0); PG8_BAR; PG8_SCHED;
            PG8_LDB(B1, 1, 1); PG8_STAGE(PG8_SB(1, 0), b3, voffB);
            PG8_BAR; PG8_WAIT_L(0); PG8_MMA(0, 1, At, B1); PG8_BAR;
            PG8_LDA(At, 1, 1); PG8_STAGE(PG8_SA(1, 0), a3, voffA);
            PG8_BAR; PG8_WAIT_L(0); PG8_MMA(1, 0, At, B0); PG8_BAR; PG8_SCHED;
            PG8_STAGE(PG8_SB(1, 1), b3 + bstep, voffB);
            PG8_WAIT_V(6); PG8_BAR; PG8_MMA(1, 1, At, B1); PG8_BAR;
            }
        }
        if constexpr (ALIGN_EPI) { if (wr == 0) PG8_BAR; }
        if constexpr (!Epi::AFTER_DRAIN) { E(acc, cur, wr, wc, fr, fq, cur.pm != rs_pm); rs_pm = cur.pm; S.done(cur); }
        if (!has_next) break;
#pragma unroll
        for (int a = 0; a < 2; ++a)
#pragma unroll
            for (int b = 0; b < 2; ++b)
#pragma unroll
                for (int m = 0; m < 4; ++m)
#pragma unroll
                    for (int n = 0; n < 2; ++n) acc[a][b][m][n] = (f32x4){0.f, 0.f, 0.f, 0.f};
        cur = nxt; cA = nA; cB = nB; ++ui;
        if constexpr (ALIGN_EPI) { if (wr == 1) PG8_BAR; }
    }
    PG8_WAIT_V(0);
    if constexpr (!ALIGN_EPI) { if (wr == 0) PG8_BAR; }
    PG8_BAR;
    if constexpr (Epi::AFTER_DRAIN) { E.fused(acc, cur, wr, wc, fr, fq, lds, wid, lane); S.done(cur); }
#undef PG8_SA
#undef PG8_SB
#undef PG8_STAGE
#undef PG8_LDA
#undef PG8_LDB
#undef PG8_MMA
#undef PG8_WAIT_V
#undef PG8_WAIT_L
#undef PG8_BAR
#undef PG8_SCHED
}
}
#define GAS __attribute__((address_space(1)))
#define LAS __attribute__((address_space(3)))
typedef unsigned short bf16;
typedef unsigned v4u __attribute__((ext_vector_type(4)));
typedef float f32x4 __attribute__((ext_vector_type(4)));
typedef short bf16x8 __attribute__((ext_vector_type(8)));
typedef GAS unsigned gu32;
typedef GAS unsigned long long gu64;
#define RLX_AGENT __ATOMIC_RELAXED, __HIP_MEMORY_SCOPE_AGENT
#define LDS_WAIT() asm volatile("s_waitcnt lgkmcnt(0)" ::: "memory")
#define VM_WAIT() asm volatile("s_waitcnt vmcnt(0)" ::: "memory")
__device__ __forceinline__ unsigned long long rt() { return __builtin_amdgcn_s_memrealtime(); }
__device__ __forceinline__ unsigned f2bf(float f) { unsigned u = __builtin_bit_cast(unsigned, f); return (u + 0x7fffu + ((u >> 16) & 1u)) >> 16; }
__device__ __forceinline__ unsigned pk2(float lo, float hi) { return f2bf(lo) | (f2bf(hi) << 16); }
#define XB_TMO      128
#define XB_XCNT(j)  (256  + 64 * (j))
#define XB_XSUB(j)  (1280 + 64 * (j))
#define XB_XGEN(j)  (2304 + 64 * (j))
#define XB_TOP      3328
#define XB_TOPGEN   3392
#define XCD_BAR_WORDS 3456
#define XB_SPIN_CAP (1u << 18)

__device__ __forceinline__ unsigned xb_ld(unsigned* p)              { return __hip_atomic_load(p, __ATOMIC_RELAXED, __HIP_MEMORY_SCOPE_AGENT); }
__device__ __forceinline__ unsigned xb_add(unsigned* p, unsigned v) { return __hip_atomic_fetch_add(p, v, __ATOMIC_RELAXED, __HIP_MEMORY_SCOPE_AGENT); }
__device__ __forceinline__ unsigned xb_xcc_id() { return (unsigned)__builtin_amdgcn_s_getreg((3 << 11) | 20) & 0xFu; }
#define XB_SPIN(cond, bar) do { unsigned _sp = 0; while (cond) { __builtin_amdgcn_s_sleep(1); \
    if ((++_sp & 255u) == 0u) { if (xb_ld(&(bar)[XB_TMO])) break; if (_sp > XB_SPIN_CAP) { atomicAdd(&(bar)[XB_TMO], 1u); break; } } } } while (0)

struct XcdBarrier {
    unsigned* bar; unsigned x;
    volatile LAS unsigned* st;
};

__device__ __forceinline__ XcdBarrier xcd_barrier_post(unsigned* bar, volatile LAS unsigned* st) {
    XcdBarrier b; b.bar = bar; b.x = xb_xcc_id(); b.st = st;
    if (threadIdx.x == 0) (void)xb_add(&bar[XB_XCNT(b.x)], 1u);
    return b;
}
__device__ __forceinline__ void xcd_barrier_complete(unsigned* bar, unsigned x, unsigned& nloc, unsigned& nx) {
    const unsigned G = gridDim.x * gridDim.y * gridDim.z;
    unsigned sum, cnt, mine, sp = 0u;
    for (;;) {
        sum = 0u; cnt = 0u; mine = 0u;
#pragma unroll
        for (unsigned j = 0; j < 16; ++j) { const unsigned c = xb_ld(&bar[XB_XCNT(j)]); sum += c; cnt += (c > 0u) ? 1u : 0u; mine = (j == x) ? c : mine; }
        if (sum == G) break;
        __builtin_amdgcn_s_sleep(1);
        if ((++sp & 255u) == 0u) { if (xb_ld(&bar[XB_TMO])) break; if (sp > XB_SPIN_CAP) { atomicAdd(&bar[XB_TMO], 1u); break; } }
    }
    nloc = mine > 0u ? mine : 1u; nx = cnt > 0u ? cnt : 1u;
}

__device__ __forceinline__ void xcd_barrier(const XcdBarrier& b) {
    asm volatile("s_waitcnt vmcnt(0)" ::: "memory");
    __syncthreads();
    if (threadIdx.x == 0) {
        unsigned* bar = b.bar;
        __builtin_amdgcn_s_waitcnt(0);
        unsigned nloc = b.st[0], nx = b.st[1];
        if (nloc == 0u) { xcd_barrier_complete(bar, b.x, nloc, nx); b.st[0] = nloc; b.st[1] = nx; }
        const unsigned old = xb_add(&bar[XB_XSUB(b.x)], 1u);
        const unsigned gen = old / nloc;
        if (old + 1u == (gen + 1u) * nloc) {
            __builtin_amdgcn_fence(__ATOMIC_RELEASE, "agent");
            asm volatile("s_waitcnt vmcnt(0)" ::: "memory");
            const unsigned og = xb_add(&bar[XB_TOP], 1u);
            const unsigned tg = og / nx;
            if (og + 1u == (tg + 1u) * nx) xb_add(&bar[XB_TOPGEN], 1u);
            else XB_SPIN(xb_ld(&bar[XB_TOPGEN]) == tg, bar);
            __builtin_amdgcn_fence(__ATOMIC_ACQUIRE, "agent");
            xb_add(&bar[XB_XGEN(b.x)], 1u);
            asm volatile("s_waitcnt vmcnt(0)" ::: "memory");
        } else {
            XB_SPIN(xb_ld(&bar[XB_XGEN(b.x)]) == gen, bar);
            __builtin_amdgcn_fence(__ATOMIC_ACQUIRE, "agent");
            asm volatile("s_waitcnt vmcnt(0)" ::: "memory");
        }
    }
    __syncthreads();
}
using pg8::MP; using pg8::MS; using pg8::MALL; using pg8::DM; using pg8::SEQ; using pg8::EVIN; using pg8::ODIN; using pg8::FFD;
typedef unsigned u32x2 __attribute__((ext_vector_type(2)));
typedef short v4i16_t __attribute__((ext_vector_type(4)));
constexpr int NWAVES = 8;
constexpr size_t MiB = 1u << 20;
constexpr size_t WS_CTL = 0, CTL_ZERO_BYTES = 65536;
constexpr size_t WS_WEVIN = 2 * MiB, WS_WEVOUT = 12 * MiB, WS_WODIN = 14 * MiB, WS_WODOUT = 19 * MiB, WS_W1 = 21 * MiB  , WS_W2 = 37 * MiB  , WS_WG = 53 * MiB  ,
                 WS_WP = 57 * MiB  , WS_POOLW = 58 * MiB, WS_WST = 58 * MiB + 256 * 1024, WS_ROPE = 59 * MiB  , WS_SS = 81 * MiB  ;
constexpr size_t WS_PB = 64 * MiB  , WS_R = 84 * MiB  , WS_RB = 150 * MiB  , WS_YAB = 216 * MiB  , WS_PROJ = 249 * MiB  , WS_Z = 282 * MiB  ,
                 WS_F = 447 * MiB  , WS_OG = 579 * MiB  , WS_LSE = 629 * MiB  , WS_END = 632 * MiB;
static_assert(WS_PB + 2 * (size_t)MALL * 256 * 2 <= WS_R && WS_R + (size_t)MALL * DM * 4 <= WS_RB && WS_RB + 2 * (size_t)MALL * DM * 2 <= WS_YAB && WS_Z + (size_t)MALL * EVIN * 2 <= WS_F &&
              WS_F + (size_t)MALL * FFD * 2 <= WS_OG && WS_OG + 3 * (size_t)MALL * 512 * 2 <= WS_LSE && WS_LSE + 3 * (size_t)MALL * 8 * 4 <= WS_END && WS_ROPE + 8196 * 64 * 4 <= WS_PB &&
              WS_SS + 2 * (size_t)MALL * 16 * 4 <= WS_R && WS_PB + 2 * (size_t)MALL * 256 * 2 <= WS_SS, "d_ws map");
constexpr int CW_BAR = 4096;
constexpr int RING_BYTES = 131072, LDSCTL_OFF = RING_BYTES, MISC_OFF = LDSCTL_OFF + 320, LDS_BYTES = 147456;
constexpr int KVS = 144;
constexpr int ATT_K = 0, ATT_V = 272 * KVS, ATT_SC = 2 * 272 * KVS;
constexpr int VNS = 272;

struct Args { const float* in[28]; float* out; unsigned char* ws; int ph_lo, ph_hi; };
struct Frame {
    LAS unsigned char* lds; volatile LAS unsigned* MISC; gu32* ctl;
    int tid, lane, wave, vcu, G;
    float* out; unsigned char* ws;
};
__device__ __forceinline__ float wave_sum(float v) {
#pragma unroll
    for (int o = 1; o < 64; o <<= 1) v += __shfl_xor(v, o);
    return v;
}
__device__ __forceinline__ float wave_max(float v) {
#pragma unroll
    for (int o = 1; o < 64; o <<= 1) v = __builtin_fmaxf(v, __shfl_xor(v, o));
    return v;
}
__device__ __forceinline__ float red_max16(float x) { const unsigned u = __builtin_bit_cast(unsigned, x); const auto r = __builtin_amdgcn_permlane16_swap(u, u, false, false); return __builtin_fmaxf(__builtin_bit_cast(float, (unsigned)r[0]), __builtin_bit_cast(float, (unsigned)r[1])); }
__device__ __forceinline__ float red_max32(float x) { const unsigned u = __builtin_bit_cast(unsigned, x); const auto r = __builtin_amdgcn_permlane32_swap(u, u, false, false); return __builtin_fmaxf(__builtin_bit_cast(float, (unsigned)r[0]), __builtin_bit_cast(float, (unsigned)r[1])); }
__device__ __forceinline__ float red_add16(float x) { const unsigned u = __builtin_bit_cast(unsigned, x); const auto r = __builtin_amdgcn_permlane16_swap(u, u, false, false); return __builtin_bit_cast(float, (unsigned)r[0]) + __builtin_bit_cast(float, (unsigned)r[1]); }
__device__ __forceinline__ float red_add32(float x) { const unsigned u = __builtin_bit_cast(unsigned, x); const auto r = __builtin_amdgcn_permlane32_swap(u, u, false, false); return __builtin_bit_cast(float, (unsigned)r[0]) + __builtin_bit_cast(float, (unsigned)r[1]); }
__device__ __forceinline__ v4u pair16(u32x2 A, u32x2 B) { const auto rx = __builtin_amdgcn_permlane16_swap(A.x, B.x, false, false); const auto ry = __builtin_amdgcn_permlane16_swap(A.y, B.y, false, false);
    v4u o; o.x = rx[0]; o.y = ry[0]; o.z = rx[1]; o.w = ry[1]; return o; }
__device__ __forceinline__ int pair16_off(int fq) { return 4 * fq + ((fq & 1) ? 12 : 0); }
__device__ __forceinline__ unsigned cvtpk(float lo, float hi) { return pg8::cvt_pk_bf16(lo, hi); }
__device__ __forceinline__ float bflo(unsigned w) { return __builtin_bit_cast(float, w << 16); }
__device__ __forceinline__ float bfhi(unsigned w) { return __builtin_bit_cast(float, w & 0xffff0000u); }
__device__ __forceinline__ f32x4 mfma16(bf16x8 a, bf16x8 b, f32x4 c) { return __builtin_amdgcn_mfma_f32_16x16x32_bf16(a, b, c, 0, 0, 0); }
__device__ __forceinline__ v4i16_t trread(LAS const unsigned char* p) { return __builtin_amdgcn_ds_read_tr16_b64_v4i16((LAS v4i16_t*)p); }

constexpr int SG_NST = 5, SG_STAGE = 24576;
template <class Epi> __device__ __forceinline__ void sample_gemm_k(LAS unsigned char* lds, const Epi& E, const bf16* A, const bf16* Bt, int K_, int cb0);
template <class Epi> __device__ __forceinline__ void sample_gemm(LAS unsigned char* lds, const Epi& E, const bf16* A, const bf16* Bt, int N, int K_) {
    if (N == 1024) { sample_gemm_k(lds, E, A, Bt, K_, 0); return; }
    int t_ = threadIdx.x; asm volatile("" : "+v"(t_)); int K = K_; asm volatile("" : "+s"(K));
    const int tid = t_, lane = tid & 63, wave = __builtin_amdgcn_readfirstlane(tid >> 6), fr = lane & 15, fq = lane >> 4;
    const int b = blockIdx.x, G = gridDim.x, nkt = K / 64;
    const int ncb_big = (N == 5120 && G == 256) ? 64 : N / 64;
    const int nit = ncb_big * 4;
    const int v = (G == 256) ? (((b & 7) + 8 * (b >> 5)) * 4 + ((b >> 3) & 3)) : b;
    int R0, C0, R1, C1; pg8::stage_rc(tid * 16, R0, C0); pg8::stage_rc(tid * 16 + 8192, R1, C1);
    const unsigned ldsw = (unsigned)wave * 1024u;
    const int aoff = pg8::lds_byte(16 * wave + fr, 8 * fq);
    int boff[2][2];
#pragma unroll
    for (int bj = 0; bj < 2; ++bj)
#pragma unroll
        for (int n = 0; n < 2; ++n) boff[bj][n] = 16384 + pg8::lds_byte(32 * bj + 16 * n + fr, 8 * fq);
    for (int it = v; it < nit; it += G) {
        const int cb = it >> 2, oct = it & 3, pn = cb >> 2, wc = cb & 3;
        const int row0 = MP + oct * 128;
        const bf16* ga0 = A + (size_t)(row0 + R0) * K + C0; const bf16* ga1 = A + (size_t)(row0 + R1) * K + C1;
        const bf16* gb = Bt + (size_t)(pn * 256 + (Epi::PERM ? wc * 64 + (R0 >> 5) * 32 + pg8::perm32(R0 & 31) : (R0 >> 5) * 128 + wc * 32 + (R0 & 31))) * K + C0;
#define SG_ISSUE(kt) do { const int s_ = (kt) % SG_NST; const size_t ko_ = (size_t)(kt) * 64; \
        __builtin_amdgcn_global_load_lds((const unsigned*)(ga0 + ko_), (LAS unsigned*)(lds + s_ * SG_STAGE + ldsw), 16, 0, 0); \
        __builtin_amdgcn_global_load_lds((const unsigned*)(ga1 + ko_), (LAS unsigned*)(lds + s_ * SG_STAGE + 8192 + ldsw), 16, 0, 0); \
        __builtin_amdgcn_global_load_lds((const unsigned*)(gb + ko_), (LAS unsigned*)(lds + s_ * SG_STAGE + 16384 + ldsw), 16, 0, 0); } while (0)
        for (int kt = 0; kt < SG_NST - 1 && kt < nkt; ++kt) SG_ISSUE(kt);
        f32x4 acc[2][2];
#pragma unroll
        for (int bj = 0; bj < 2; ++bj)
#pragma unroll
            for (int n = 0; n < 2; ++n) acc[bj][n] = (f32x4){0.f, 0.f, 0.f, 0.f};
        for (int kt = 0; kt < nkt; ++kt) {
            const int ahead = (nkt - 1 - kt) < (SG_NST - 2) ? (nkt - 1 - kt) : (SG_NST - 2);
            if (ahead >= 3) asm volatile("s_waitcnt vmcnt(9)" ::: "memory"); else if (ahead == 2) asm volatile("s_waitcnt vmcnt(6)" ::: "memory");
            else if (ahead == 1) asm volatile("s_waitcnt vmcnt(3)" ::: "memory"); else asm volatile("s_waitcnt vmcnt(0)" ::: "memory");
            __builtin_amdgcn_s_barrier(); __builtin_amdgcn_sched_barrier(0); asm volatile("" ::: "memory");
            if (kt + SG_NST - 1 < nkt) SG_ISSUE(kt + SG_NST - 1);
            LAS const unsigned char* st = lds + (kt % SG_NST) * SG_STAGE;
            bf16x8 af[2], bf[2][2][2];
#pragma unroll
            for (int ks = 0; ks < 2; ++ks) { af[ks] = *(LAS const bf16x8*)(st + aoff + ks * 1024);
#pragma unroll
                for (int bj = 0; bj < 2; ++bj)
#pragma unroll
                    for (int n = 0; n < 2; ++n) bf[ks][bj][n] = *(LAS const bf16x8*)(st + boff[bj][n] + ks * 1024); }
            asm volatile("s_waitcnt lgkmcnt(0)" ::: "memory");
#pragma unroll
            for (int ks = 0; ks < 2; ++ks)
#pragma unroll
                for (int bj = 0; bj < 2; ++bj)
#pragma unroll
                    for (int n = 0; n < 2; ++n) acc[bj][n] = mfma16(bf[ks][bj][n], af[ks], acc[bj][n]);
        }
#undef SG_ISSUE
        { const int row_ = row0 + wave * 16 + fr; E.rg(acc, row_, pn, wc, fq, Epi::USE_RS ? pg8::row_rs(E.SS, row_) : 0.f); }
        asm volatile("s_waitcnt vmcnt(0) lgkmcnt(0)" ::: "memory"); __builtin_amdgcn_s_barrier(); asm volatile("" ::: "memory");
    }
    if (ncb_big < N / 64) sample_gemm_k(lds, E, A, Bt, K_, ncb_big);
}
constexpr int SK_NST = 5, SK_STAGE = 24576;
template <class Epi> __device__ __forceinline__ void sample_gemm_k(LAS unsigned char* lds, const Epi& E, const bf16* A, const bf16* Bt, int K_, int cb0) {
    int t_ = threadIdx.x; asm volatile("" : "+v"(t_)); int K = K_; asm volatile("" : "+s"(K));
    const int tid = t_, lane = tid & 63, wave = __builtin_amdgcn_readfirstlane(tid >> 6), fr = lane & 15, fq = lane >> 4, rg = wave & 1, kq = (wave >> 1) & 1, ch = wave >> 2;
    const int b = blockIdx.x, G = gridDim.x, nit = 256, nkc = K / 128;
    const int v = (G == 256) ? (((b & 7) + 8 * (b >> 5)) * 4 + ((b >> 3) & 3)) : b;
    int RA, CA; const int QA = (tid * 16) >> 12; pg8::stage_rc((tid * 16) & 4095, RA, CA);
    int RB_, CB_; pg8::stage_rc(tid * 16, RB_, CB_);
    const unsigned ldsw = (unsigned)wave * 1024u;
    const int aoff = kq * 4096 + pg8::lds_byte(16 * rg + fr, 8 * fq);
    int boff[2];
#pragma unroll
    for (int n = 0; n < 2; ++n) boff[n] = 8192 + kq * 8192 + pg8::lds_byte(32 * ch + 16 * n + fr, 8 * fq);
    for (int it = v; it < nit; it += G) {
        const int cb = cb0 + (it >> 4), rgrp = it & 15, pn = cb >> 2, wc = cb & 3;
        const int row0 = MP + rgrp * 32;
        const bf16* ga = A + (size_t)(row0 + RA) * K + QA * 64 + CA;
        const bf16* gb = Bt + (size_t)(pn * 256 + (Epi::PERM ? wc * 64 + (RB_ >> 5) * 32 + pg8::perm32(RB_ & 31) : (RB_ >> 5) * 128 + wc * 32 + (RB_ & 31))) * K + CB_;
#define SK_ISSUE(kc) do { const int s_ = (kc) % SK_NST; const size_t ko_ = (size_t)(kc) * 128; \
        __builtin_amdgcn_global_load_lds((const unsigned*)(ga + ko_), (LAS unsigned*)(lds + s_ * SK_STAGE + ldsw), 16, 0, 0); \
        __builtin_amdgcn_global_load_lds((const unsigned*)(gb + ko_), (LAS unsigned*)(lds + s_ * SK_STAGE + 8192 + ldsw), 16, 0, 0); \
        __builtin_amdgcn_global_load_lds((const unsigned*)(gb + ko_ + 64), (LAS unsigned*)(lds + s_ * SK_STAGE + 16384 + ldsw), 16, 0, 0); } while (0)
        for (int kc = 0; kc < SK_NST - 1 && kc < nkc; ++kc) SK_ISSUE(kc);
        f32x4 acc[2];
#pragma unroll
        for (int n = 0; n < 2; ++n) acc[n] = (f32x4){0.f, 0.f, 0.f, 0.f};
        for (int kc = 0; kc < nkc; ++kc) {
            const int ahead = (nkc - 1 - kc) < (SK_NST - 2) ? (nkc - 1 - kc) : (SK_NST - 2);
            if (ahead >= 3) asm volatile("s_waitcnt vmcnt(9)" ::: "memory"); else if (ahead == 2) asm volatile("s_waitcnt vmcnt(6)" ::: "memory");
            else if (ahead == 1) asm volatile("s_waitcnt vmcnt(3)" ::: "memory"); else asm volatile("s_waitcnt vmcnt(0)" ::: "memory");
            __builtin_amdgcn_s_barrier(); __builtin_amdgcn_sched_barrier(0); asm volatile("" ::: "memory");
            if (kc + SK_NST - 1 < nkc) SK_ISSUE(kc + SK_NST - 1);
            LAS const unsigned char* st = lds + (kc % SK_NST) * SK_STAGE;
            bf16x8 af[2], bf[2][2];
#pragma unroll
            for (int ks = 0; ks < 2; ++ks) { af[ks] = *(LAS const bf16x8*)(st + aoff + ks * 1024);
#pragma unroll
                for (int n = 0; n < 2; ++n) bf[ks][n] = *(LAS const bf16x8*)(st + boff[n] + ks * 1024); }
            asm volatile("s_waitcnt lgkmcnt(0)" ::: "memory");
#pragma unroll
            for (int ks = 0; ks < 2; ++ks)
#pragma unroll
                for (int n = 0; n < 2; ++n) acc[n] = mfma16(bf[ks][n], af[ks], acc[n]);
        }
#undef SK_ISSUE
        LAS float* red = (LAS float*)(lds + (nkc % SK_NST) * SK_STAGE);
        if (kq | ch) { const int slot = ch * 2 + kq - 1;
#pragma unroll
            for (int n = 0; n < 2; ++n) *(LAS f32x4*)(red + (((rg * 3 + slot) * 64 + lane) * 8 + n * 4)) = acc[n]; }
        asm volatile("s_waitcnt lgkmcnt(0)" ::: "memory"); __builtin_amdgcn_s_barrier(); asm volatile("" ::: "memory");
        if (!(kq | ch)) { f32x4 a[2][2];
#pragma unroll
            for (int n = 0; n < 2; ++n) { a[0][n] = acc[n] + *(LAS const f32x4*)(red + (((rg * 3 + 0) * 64 + lane) * 8 + n * 4));
                a[1][n] = *(LAS const f32x4*)(red + (((rg * 3 + 1) * 64 + lane) * 8 + n * 4)) + *(LAS const f32x4*)(red + (((rg * 3 + 2) * 64 + lane) * 8 + n * 4)); }
            { const int row_ = row0 + rg * 16 + fr; E.rg(a, row_, pn, wc, fq, Epi::USE_RS ? pg8::row_rs(E.SS, row_) : 0.f); } }
        asm volatile("s_waitcnt vmcnt(0) lgkmcnt(0)" ::: "memory"); __builtin_amdgcn_s_barrier(); asm volatile("" ::: "memory");
    }
}
__device__ __forceinline__ void relaunder(Frame& F) { int t = threadIdx.x; asm volatile("" : "+v"(t)); F.tid = t; F.lane = t & 63; F.wave = __builtin_amdgcn_readfirstlane(t >> 6); }
__device__ __forceinline__ void p0_transpose_item(const float* W, int K, int N, bf16* WT, const float* gain, int mode, LAS float* scr, int item, int lane) {
    const int nblk = N / 32, kb = item / nblk, nb = item % nblk, k0 = 64 * kb, n0 = 32 * nb, n4 = lane & 7, kr = lane >> 3;
    int srcc = n0 + 4 * n4;
    if (mode == 1 && n0 >= 512 && ((n0 - 512) % 1536) < 1024) srcc = (n0 & ~63) + 16 * ((n0 >> 5) & 1) + ((4 * n4) & 15) + 32 * ((4 * n4) >> 4);
    f32x4 v[8];
#pragma unroll
    for (int i = 0; i < 8; ++i) v[i] = __builtin_nontemporal_load((const GAS f32x4*)(W + (size_t)(k0 + kr + 8 * i) * N + srcc));
#pragma unroll
    for (int i = 0; i < 8; ++i) { const int kk = kr + 8 * i; const float gsc = gain ? gain[k0 + kk] : 1.0f;
#pragma unroll
        for (int j = 0; j < 4; ++j) scr[kk * 33 + 4 * n4 + j] = v[i][j] * gsc; }
    LDS_WAIT(); asm volatile("" ::: "memory");
    const int c = lane & 7;
#pragma unroll
    for (int j = 0; j < 4; ++j) { const int n = (lane >> 3) + 8 * j; const LAS float* s = scr + (8 * c) * 33 + n;
        v4u o; o.x = cvtpk(s[0 * 33], s[1 * 33]); o.y = cvtpk(s[2 * 33], s[3 * 33]); o.z = cvtpk(s[4 * 33], s[5 * 33]); o.w = cvtpk(s[6 * 33], s[7 * 33]);
        if (mode == 2) __builtin_nontemporal_store(o, (GAS v4u*)(WT + (size_t)(n0 + n) * K + k0 + 8 * c)); else *(GAS v4u*)(WT + (size_t)(n0 + n) * K + k0 + 8 * c) = o; }
    LDS_WAIT(); asm volatile("" ::: "memory");
}
__device__ __forceinline__ void p0_prologue(Frame& F, const Args& A) {
    LAS float* scr = (LAS float*)(F.lds + F.wave * 16384);
    const int gw = F.vcu * NWAVES + F.wave, NGW = F.G * NWAVES;
    unsigned char* ws = F.ws;
    constexpr int I_EVIN = 16 * 160, I_SQ = 16 * 32, I_ODIN = 16 * 80, I_W1 = 16 * 128, I_W2 = 64 * 32, I_WP = 4 * 32;
    constexpr int NITEMS = I_EVIN + 2 * I_SQ + I_ODIN + 2 * I_W1 + 2 * I_W2 + 2 * I_SQ + 2 * I_WP;
    for (int it = gw; it < NITEMS; it += NGW) {
        int r = it;
        if (r < I_EVIN) { p0_transpose_item(A.in[9], 1024, EVIN, (bf16*)(ws + WS_WEVIN), A.in[20], 0, scr, r, F.lane); continue; } r -= I_EVIN;
        if (r < I_SQ) { p0_transpose_item(A.in[12], 1024, 1024, (bf16*)(ws + WS_WEVOUT), nullptr, 2, scr, r, F.lane); continue; } r -= I_SQ;
        if (r < I_ODIN) { p0_transpose_item(A.in[13], 1024, ODIN, (bf16*)(ws + WS_WODIN), A.in[20] + 1024, 2, scr, r, F.lane); continue; } r -= I_ODIN;
        if (r < I_SQ) { p0_transpose_item(A.in[19], 1024, 1024, (bf16*)(ws + WS_WODOUT), nullptr, 2, scr, r, F.lane); continue; } r -= I_SQ;
        if (r < 2 * I_W1) { const int L = r / I_W1; p0_transpose_item(A.in[23] + (size_t)L * 1024 * FFD, 1024, FFD, (bf16*)(ws + WS_W1) + (size_t)L * 1024 * FFD, A.in[21] + L * 1024, 2, scr, r % I_W1, F.lane); continue; } r -= 2 * I_W1;
        if (r < 2 * I_W2) { const int L = r / I_W2; p0_transpose_item(A.in[24] + (size_t)L * 1024 * FFD, FFD, 1024, (bf16*)(ws + WS_W2) + (size_t)L * 1024 * FFD, nullptr, 2, scr, r % I_W2, F.lane); continue; } r -= 2 * I_W2;
        if (r < 2 * I_SQ) { const int L = r / I_SQ; p0_transpose_item(A.in[26] + (size_t)L * 1024 * 1024, 1024, 1024, (bf16*)(ws + WS_WG) + (size_t)L * 1024 * 1024, A.in[22] + L * 1024, 2, scr, r % I_SQ, F.lane); continue; } r -= 2 * I_SQ;
        { const int L = r / I_WP; p0_transpose_item(A.in[25] + (size_t)L * 256 * 1024, 256, 1024, (bf16*)(ws + WS_WP) + (size_t)L * 256 * 1024, nullptr, 2, scr, r % I_WP, F.lane); }
    }
    {
        bf16* RB0 = (bf16*)(ws + WS_RB); float* SS0 = (float*)(ws + WS_SS);
        for (int m0 = gw; m0 < MALL; m0 += 2 * NGW) {
            f32x4 v[2][4];
#pragma unroll
            for (int r = 0; r < 2; ++r) { const int m = m0 + r * NGW; if (m < MALL) { const float* xrow = m < MP ? A.in[0] + (size_t)m * DM : A.in[1] + (size_t)(m - MP) * DM;
                const GAS f32x4* xr = (const GAS f32x4*)xrow + F.lane;
#pragma unroll
                for (int j = 0; j < 4; ++j) v[r][j] = __builtin_nontemporal_load(xr + 64 * j); } }
#pragma unroll
            for (int r = 0; r < 2; ++r) { const int m = m0 + r * NGW; if (m < MALL) { float s = 0.f;
#pragma unroll
                for (int j = 0; j < 4; ++j) s += (v[r][j][0] * v[r][j][0] + v[r][j][1] * v[r][j][1]) + (v[r][j][2] * v[r][j][2] + v[r][j][3] * v[r][j][3]);
                s = wave_sum(s);
                GAS u32x2* o8 = (GAS u32x2*)(RB0 + (size_t)m * DM) + F.lane;
#pragma unroll
                for (int j = 0; j < 4; ++j) { u32x2 w; w.x = cvtpk(v[r][j][0], v[r][j][1]); w.y = cvtpk(v[r][j][2], v[r][j][3]); o8[64 * j] = w; }
                if (F.lane < 16) SS0[(size_t)m * 16 + F.lane] = F.lane == 0 ? s : 0.f; } }
        }
    }
    const int gt = gw * 64 + F.lane, NT = NGW * 64;
    { bf16* PB = (bf16*)(ws + WS_PB);
      for (int i0 = gt; i0 < 2 * MALL * 64; i0 += 4 * NT) { f32x4 v[4];
#pragma unroll
          for (int u = 0; u < 4; ++u) { const int i = i0 + u * NT; if (i < 2 * MALL * 64) { const int L = i / (MALL * 64), rem = i % (MALL * 64), row = rem >> 6, c4 = rem & 63;
              const float* src = row < MP ? A.in[7] + ((size_t)L * MP + row) * 256 + c4 * 4 : A.in[8] + ((size_t)L * MS + (row - MP)) * 256 + c4 * 4; v[u] = __builtin_nontemporal_load((const GAS f32x4*)src); } }
#pragma unroll
          for (int u = 0; u < 4; ++u) { const int i = i0 + u * NT; if (i < 2 * MALL * 64) { const int L = i / (MALL * 64), rem = i % (MALL * 64), row = rem >> 6, c4 = rem & 63;
              u32x2 w; w.x = cvtpk(v[u][0], v[u][1]); w.y = cvtpk(v[u][2], v[u][3]); *(GAS u32x2*)(PB + ((size_t)L * MALL + row) * 256 + c4 * 4) = w; } } } }
    { float* tab = (float*)(ws + WS_ROPE);
      for (int i = gt; i < 8196 * 32; i += NT) { const int pos = i >> 5, k = i & 31;
          const float inv = (float)exp2(-(double)k * (13.287712379549449 / 32.0));
          const float ang = (float)pos * inv;
          const double rev = (double)ang * 0.15915494309189535; const float fr = (float)(rev - rint(rev));
          tab[2 * i] = __builtin_amdgcn_cosf(fr); tab[2 * i + 1] = __builtin_amdgcn_sinf(fr); } }
    { bf16* PW = (bf16*)(ws + WS_POOLW); bf16* WT = (bf16*)(ws + WS_WST);
      for (int i = gt; i < 4 * 128 * 128; i += NT) { const int g = i >> 14, d = (i >> 7) & 127, c = i & 127;
          PW[i] = (bf16)(cvtpk(A.in[10][(g * 128 + c) * 128 + d] * A.in[11][g * 128 + d], 0.f) & 0xffffu);
          const int t = d, s = c; WT[i] = (bf16)(cvtpk(s <= t ? A.in[16][i] : 0.f, 0.f) & 0xffffu); } }
    { for (int i = gt; i < 128 * 11 * 128; i += NT) { const int n = i / (11 * 128), rem = i % (11 * 128), j = rem >> 7, c4 = rem & 127;
          *(GAS f32x4*)(F.out + pg8::O_POOLS + ((size_t)(n * 15 + j) * 512 + c4 * 4)) = *(const GAS f32x4*)(A.in[5] + ((size_t)(n * 15 + j + 4) * 512 + c4 * 4)); } }
}

template <int W> __device__ __forceinline__ void pool_unit(Frame& F, const Args& A, int gi, int slab) {
    const int w = 2 << gi;
    int lane_ = F.lane; asm volatile("" : "+v"(lane_));
    const int lane = lane_, fq = lane >> 4, a = lane & 15;
    const bf16* Z = (const bf16*)(F.ws + WS_Z); const bf16* PW = (const bf16*)(F.ws + WS_POOLW); const float* SP = A.in[5]; bf16* YAB = (bf16*)(F.ws + WS_YAB);
    const int row = slab * 16 + a; const bool samp = slab >= MP / 16; const int ms = row - MP; const int t = samp ? (ms & 3) : (row & (SEQ - 1)); const int nsq = ms >> 2;
    const float rc = 1.0f / (float)(samp ? w : (w < t + 1 ? w : t + 1));
    bf16x8 pf[4];
#pragma unroll
    for (int ks = 0; ks < 4; ++ks) { const int c = gi * 128 + 32 * ks + 8 * fq; float acc[8], x0[8];
        if (!samp) {
            v4u zz[W];
            const int jmax = t < w - 1 ? t : w - 1;
#pragma unroll
            for (int j = 0; j < W; ++j) { const int jj = j < jmax ? j : jmax; zz[j] = *(const GAS v4u*)(Z + (size_t)(row - jj) * EVIN + c); }
#pragma unroll
            for (int k = 0; k < 4; ++k) { x0[2 * k] = bflo(zz[0][k]); x0[2 * k + 1] = bfhi(zz[0][k]); acc[2 * k] = x0[2 * k]; acc[2 * k + 1] = x0[2 * k + 1]; }
#pragma unroll
            for (int j = 1; j < W; ++j) { const float wgt = j <= jmax ? 1.0f : 0.0f;
#pragma unroll
                for (int k = 0; k < 4; ++k) { acc[2 * k] += wgt * bflo(zz[j][k]); acc[2 * k + 1] += wgt * bfhi(zz[j][k]); } }
        } else {
            { const v4u z0 = *(const GAS v4u*)(Z + (size_t)row * EVIN + c);
#pragma unroll
              for (int k = 0; k < 4; ++k) { x0[2 * k] = bflo(z0[k]); x0[2 * k + 1] = bfhi(z0[k]); acc[2 * k] = x0[2 * k]; acc[2 * k + 1] = x0[2 * k + 1]; } }
            for (int j = 1; j < w; ++j) {
                if (j <= t) { const v4u z1 = *(const GAS v4u*)(Z + (size_t)(row - j) * EVIN + c);
#pragma unroll
                    for (int k = 0; k < 4; ++k) { acc[2 * k] += bflo(z1[k]); acc[2 * k + 1] += bfhi(z1[k]); } }
                else if (samp) { const float* sp = SP + ((size_t)(nsq * 15 + 15 + t - j)) * 512 + c; const f32x4 s0 = *(const GAS f32x4*)sp, s1 = *(const GAS f32x4*)(sp + 4);
#pragma unroll
                    for (int k = 0; k < 4; ++k) { acc[k] += s0[k]; acc[4 + k] += s1[k]; } } }
        }
        v4u pw; pw.x = cvtpk(acc[0] * rc - x0[0], acc[1] * rc - x0[1]); pw.y = cvtpk(acc[2] * rc - x0[2], acc[3] * rc - x0[3]);
        pw.z = cvtpk(acc[4] * rc - x0[4], acc[5] * rc - x0[5]); pw.w = cvtpk(acc[6] * rc - x0[6], acc[7] * rc - x0[7]);
        pf[ks] = __builtin_bit_cast(bf16x8, pw); }
#pragma unroll
    for (int nb = 0; nb < 8; ++nb) { f32x4 d = (f32x4){0.f, 0.f, 0.f, 0.f}; asm volatile("" : "+v"(d));
#pragma unroll
        for (int ks = 0; ks < 4; ++ks) { const bf16x8 wf = *(const GAS bf16x8*)(PW + ((size_t)(gi * 128 + 16 * nb + a)) * 128 + 32 * ks + 8 * fq); d = mfma16(wf, pf[ks], d); }
        u32x2 o; o.x = cvtpk(d[0], d[1]); o.y = cvtpk(d[2], d[3]);
        *(GAS u32x2*)(YAB + (size_t)row * DM + gi * 128 + 16 * nb + 4 * fq) = o; }
}
struct KvRegs { v4u k[4], v[4]; bf16x8 qa, qb; };
__device__ __forceinline__ void attn_prompt_load(Frame& F, int u, int tid, KvRegs& R) {
    const int rb = u & 63, h = (u >> 6) & 7, ng = u >> 9, g = ng % 3, n = ng / 3;
    const int dsh = 2 * g, nbk = 64 >> dsh, r = rb >> (6 - dsh), b = rb & (nbk - 1);
    const size_t rowbase = (size_t)n * SEQ; const bf16* Z = (const bf16*)(F.ws + WS_Z);
    const int colK = 512 + g * 1536 + h * 64 + 512, colV = colK + 512;
#pragma unroll
    for (int i = 0; i < 4; ++i) { const int c = tid + 512 * i, key = c >> 3, ch = c & 7; const int kb = (b - 1) * 128 + key;
        R.k[i] = (v4u){0u, 0u, 0u, 0u}; R.v[i] = R.k[i];
        if (kb >= 0) { const bf16* p = Z + (rowbase + ((size_t)kb << dsh) + r) * EVIN; R.k[i] = *(const GAS v4u*)(p + colK + ch * 8); R.v[i] = *(const GAS v4u*)(p + colV + ch * 8); } }
    { const int lane = tid & 63, w = tid >> 6, fq = lane >> 4, a = lane & 15; const size_t qrow = rowbase + ((size_t)(b * 128 + 16 * w + a) << dsh) + r; const bf16* qp = Z + qrow * EVIN + (colK - 512) + 8 * fq;
      R.qa = *(const GAS bf16x8*)qp; R.qb = *(const GAS bf16x8*)(qp + 32); }
}
__device__ __forceinline__ void attn_prompt_unit(Frame& F, const Args& A, int u, int unext, KvRegs& R) {
    const int rb = u & 63, h = (u >> 6) & 7, ng = u >> 9, g = ng % 3, n = ng / 3;
    const int dsh = 2 * g, nbk = 64 >> dsh, r = rb >> (6 - dsh), b = rb & (nbk - 1);
    const size_t rowbase = (size_t)n * SEQ;
    const bf16* Z = (const bf16*)(F.ws + WS_Z);
    const int colQ = 512 + g * 1536 + h * 64;
    LAS unsigned char* lds = F.lds;
    int tid_ = F.tid; asm volatile("" : "+v"(tid_));
    const int tid = tid_, lane = tid & 63, w = F.wave, fq = lane >> 4, a = lane & 15;
#pragma unroll
    for (int i = 0; i < 4; ++i) { const int c = tid + 512 * i, key = c >> 3, ch = c & 7;
        *(LAS v4u*)(lds + ATT_K + key * KVS + ch * 16) = R.k[i]; *(LAS v4u*)(lds + ATT_V + key * KVS + ch * 16) = R.v[i]; }
    const bf16x8 qa = R.qa, qb = R.qb;
    if (unext >= 0) attn_prompt_load(F, unext, tid, R);
    const int qi = 16 * w + a; const size_t qrow = rowbase + ((size_t)(b * 128 + qi) << dsh) + r;
    asm volatile("s_waitcnt lgkmcnt(0)" ::: "memory"); __builtin_amdgcn_s_barrier(); asm volatile("" ::: "memory");
    f32x4 S[5][2];
    const int krow = 8 * (a >> 2) + (a & 3);
#pragma unroll
    for (int s = 0; s < 5; ++s) { LAS const unsigned char* kp = lds + ATT_K + (16 * w + 32 * s + krow) * KVS + fq * 16;
        const bf16x8 k0a = *(LAS const bf16x8*)kp, k0b = *(LAS const bf16x8*)(kp + 64), k1a = *(LAS const bf16x8*)(kp + 4 * KVS), k1b = *(LAS const bf16x8*)(kp + 4 * KVS + 64);
        const f32x4 z4 = (f32x4){0.f, 0.f, 0.f, 0.f};
        S[s][0] = mfma16(k0a, qa, z4); S[s][0] = mfma16(k0b, qb, S[s][0]); S[s][1] = mfma16(k1a, qa, z4); S[s][1] = mfma16(k1b, qb, S[s][1]); }
    float mx = -INFINITY;
    if (b > 0) {
#pragma unroll
        for (int tt = 0; tt < 2; ++tt)
#pragma unroll
            for (int j = 0; j < 4; ++j) { const int o = 8 * fq + 4 * tt + j;
                S[0][tt][j] = o >= a ? S[0][tt][j] : -INFINITY; S[4][tt][j] = o <= a ? S[4][tt][j] : -INFINITY; }
#pragma unroll
        for (int s = 0; s < 5; ++s)
#pragma unroll
            for (int tt = 0; tt < 2; ++tt)
#pragma unroll
                for (int j = 0; j < 4; ++j) mx = __builtin_fmaxf(mx, S[s][tt][j]);
    } else {
#pragma unroll
        for (int s = 0; s < 5; ++s)
#pragma unroll
            for (int tt = 0; tt < 2; ++tt)
#pragma unroll
                for (int j = 0; j < 4; ++j) { const int kk = 16 * w + 32 * s + 8 * fq + 4 * tt + j; const bool ok = (kk >= qi) && (kk <= qi + 128) && (kk >= 128);
                    const float v = ok ? S[s][tt][j] : -INFINITY; S[s][tt][j] = v; mx = __builtin_fmaxf(mx, v); }
    }
    mx = red_max16(mx); mx = red_max32(mx);
    float l = 0.f;
#pragma unroll
    for (int s = 0; s < 5; ++s)
#pragma unroll
        for (int tt = 0; tt < 2; ++tt)
#pragma unroll
            for (int j = 0; j < 4; ++j) { const float p = __builtin_amdgcn_exp2f(S[s][tt][j] - mx); S[s][tt][j] = p; l += p; }
    l = red_add16(l); l = red_add32(l);
    f32x4 O[4];
#pragma unroll
    for (int db = 0; db < 4; ++db) O[db] = (f32x4){0.f, 0.f, 0.f, 0.f};
    const int q4 = a >> 2, p4 = a & 3;
#pragma unroll
    for (int s = 0; s < 5; ++s) {
        v4u pw; pw.x = cvtpk(S[s][0][0], S[s][0][1]); pw.y = cvtpk(S[s][0][2], S[s][0][3]); pw.z = cvtpk(S[s][1][0], S[s][1][1]); pw.w = cvtpk(S[s][1][2], S[s][1][3]);
        const bf16x8 pf = __builtin_bit_cast(bf16x8, pw);
        LAS const unsigned char* vp = lds + ATT_V + (16 * w + 32 * s + 8 * fq + q4) * KVS + p4 * 8;
#pragma unroll
        for (int db = 0; db < 4; ++db) { const v4i16_t t0 = trread(vp + db * 32), t1 = trread(vp + 4 * KVS + db * 32);
            const bf16x8 vf = (bf16x8){t0[0], t0[1], t0[2], t0[3], t1[0], t1[1], t1[2], t1[3]};
            O[db] = mfma16(vf, pf, O[db]); } }
    const float inv = 1.0f / l;
    bf16* og = (bf16*)(F.ws + WS_OG) + ((size_t)g * MALL + qrow) * 512 + h * 64 + pair16_off(fq);
#pragma unroll
    for (int db = 0; db < 4; db += 2) { u32x2 oa, ob; oa.x = cvtpk(O[db][0] * inv, O[db][1] * inv); oa.y = cvtpk(O[db][2] * inv, O[db][3] * inv);
        ob.x = cvtpk(O[db + 1][0] * inv, O[db + 1][1] * inv); ob.y = cvtpk(O[db + 1][2] * inv, O[db + 1][3] * inv); *(GAS v4u*)(og + 16 * db) = pair16(oa, ob); }
    if (fq == 0) ((float*)(F.ws + WS_LSE))[((size_t)g * MALL + qrow) * 8 + h] = (mx + __builtin_amdgcn_logf(l)) * 0.6931471805599453f;
    asm volatile("s_waitcnt lgkmcnt(0)" ::: "memory"); __builtin_amdgcn_s_barrier(); asm volatile("" ::: "memory");
}
__device__ __forceinline__ float red16(float x) {
    x += __builtin_bit_cast(float, __builtin_amdgcn_update_dpp(0, __builtin_bit_cast(int, x), 0xB1, 0xF, 0xF, false));
    x += __builtin_bit_cast(float, __builtin_amdgcn_update_dpp(0, __builtin_bit_cast(int, x), 0x4E, 0xF, 0xF, false));
    x += __builtin_bit_cast(float, __builtin_amdgcn_update_dpp(0, __builtin_bit_cast(int, x), 0x141, 0xF, 0xF, false));
    x += __builtin_bit_cast(float, __builtin_amdgcn_update_dpp(0, __builtin_bit_cast(int, x), 0x140, 0xF, 0xF, false));
    return x;
}
template <int NQ, int J> __device__ __forceinline__ void sattn_batch(const f32x4 (&q)[NQ], const f32x4 (&kx)[J], const f32x4 (&vx)[J], int m0, int mstep, int tq, bool isnew,
                                                                   float (&mrun)[NQ], float (&lrun)[NQ], f32x4 (&o)[NQ]) {
#pragma unroll
    for (int t = 0; t < NQ; ++t) { const int tt = NQ == 4 ? t : tq; float sv[J]; float bm = -INFINITY;
#pragma unroll
        for (int j = 0; j < J; ++j) { const float d = red16((q[t][0] * kx[j][0] + q[t][1] * kx[j][1]) + (q[t][2] * kx[j][2] + q[t][3] * kx[j][3])); const int m = m0 + j * mstep;
            const bool ok = isnew ? (NQ == 4 ? m <= tt : m == tt) : (NQ == 4 ? m >= tt : true);
            sv[j] = ok ? d : -INFINITY; bm = __builtin_fmaxf(bm, sv[j]); }
        bm = __builtin_fmaxf(bm, __shfl_xor(bm, 16)); bm = __builtin_fmaxf(bm, __shfl_xor(bm, 32));
        const float mnew = __builtin_fmaxf(mrun[t], bm); const float scl = __builtin_amdgcn_exp2f(mrun[t] - mnew); mrun[t] = mnew;
        float ls = 0.f; f32x4 ov = o[t] * scl;
#pragma unroll
        for (int j = 0; j < J; ++j) { const float pj = __builtin_amdgcn_exp2f(sv[j] - mnew); ls += pj; ov += vx[j] * pj; }
        lrun[t] = lrun[t] * scl + ls; o[t] = ov; }
}
template <int NQ> __device__ __forceinline__ void attn_sample_item(Frame& F, const Args& A, int n, int g, int tq, int h) {
    int lane_ = F.lane; asm volatile("" : "+v"(lane_));
    const int lane = lane_, ks = lane >> 4, dc = lane & 15;
    const int Lb = 128 << (2 * g), stride = 1 << (2 * g), first = NQ == 4 ? 0 : tq;
    const float* cache = A.in[2 + g] + (size_t)n * Lb * 1024 + (size_t)(first + ks * stride) * 1024 + h * 64 + dc * 4;
    const size_t itstep = (size_t)4 * stride * 1024;
    const float* newkv = F.out + (g == 0 ? pg8::O_KVS0 : (g == 1 ? pg8::O_KVS1 : pg8::O_KVS2)) + (size_t)(n * 4 + ks) * 1024 + h * 64 + dc * 4;
    const bf16* Z = (const bf16*)(F.ws + WS_Z);
    f32x4 q[NQ];
#pragma unroll
    for (int t = 0; t < NQ; ++t) { const int tt = NQ == 4 ? t : tq; const u32x2 wq = *(const GAS u32x2*)(Z + (size_t)(MP + n * 4 + tt) * EVIN + 512 + g * 1536 + h * 64 + dc * 4);
        q[t] = (f32x4){bflo(wq.x), bfhi(wq.x), bflo(wq.y), bfhi(wq.y)}; }
    float mrun[NQ], lrun[NQ]; f32x4 o[NQ];
#pragma unroll
    for (int t = 0; t < NQ; ++t) { mrun[t] = -INFINITY; lrun[t] = 0.f; o[t] = (f32x4){0.f, 0.f, 0.f, 0.f}; }
    constexpr int J = NQ == 4 ? 4 : 8;
    f32x4 kA[J], vA[J], kB[J], vB[J];
#define SA_LOAD(KX, VX, b) do { _Pragma("unroll") for (int j = 0; j < J; ++j) { const float* p_ = cache + (size_t)((b) * J + j) * itstep; \
        KX[j] = __builtin_nontemporal_load((const GAS f32x4*)p_); VX[j] = __builtin_nontemporal_load((const GAS f32x4*)(p_ + 512)); } } while (0)
    SA_LOAD(kA, vA, 0);
    { f32x4 kn[1], vn[1]; kn[0] = *(const GAS f32x4*)newkv; vn[0] = *(const GAS f32x4*)(newkv + 512);
      sattn_batch<NQ, 1>(q, kn, vn, ks, 0, tq, true, mrun, lrun, o); }
#pragma unroll 1
    for (int bb = 0; bb < 16 / J; ++bb) {
        SA_LOAD(kB, vB, 2 * bb + 1); sattn_batch<NQ, J>(q, kA, vA, 8 * J * bb + ks, 4, tq, false, mrun, lrun, o);
        if (bb < 16 / J - 1) SA_LOAD(kA, vA, 2 * bb + 2);
        sattn_batch<NQ, J>(q, kB, vB, 8 * J * bb + 4 * J + ks, 4, tq, false, mrun, lrun, o);
    }
#undef SA_LOAD
#pragma unroll
    for (int t = 0; t < NQ; ++t) { const int tt = NQ == 4 ? t : tq; f32x4 ov = o[t]; float l = lrun[t];
        l += __shfl_xor(l, 16); l += __shfl_xor(l, 32);
#pragma unroll
        for (int j = 0; j < 4; ++j) { ov[j] += __shfl_xor(ov[j], 16); ov[j] += __shfl_xor(ov[j], 32); }
        const float inv = 1.0f / l; const size_t row = (size_t)MP + n * 4 + tt;
        if (ks == 0) { u32x2 ow; ow.x = cvtpk(ov[0] * inv, ov[1] * inv); ow.y = cvtpk(ov[2] * inv, ov[3] * inv); *(GAS u32x2*)((bf16*)(F.ws + WS_OG) + ((size_t)g * MALL + row) * 512 + h * 64 + dc * 4) = ow; }
        if (lane == 0) ((float*)(F.ws + WS_LSE))[((size_t)g * MALL + row) * 8 + h] = (mrun[t] + __builtin_amdgcn_logf(l)) * 0.6931471805599453f; }
}
__device__ __forceinline__ void p2_attention(Frame& F, const Args& A) {
    for (int i = F.tid; i < 2 * 16 * KVS / 4; i += 512) { const int which = i / (16 * KVS / 4), o = i % (16 * KVS / 4); *(LAS unsigned*)(F.lds + (which ? ATT_V : ATT_K) + 256 * KVS + o * 4) = 0u; }
    __syncthreads();
    const int first_prompt = F.vcu & 1;
    for (int pass = 0; pass < 2; ++pass) {
        if ((pass ^ first_prompt) == 0) {
            if (F.wave < 4) {
                for (int it = F.vcu; it < 1152; it += F.G) { const int n = it / 9, kind = it % 9;
#pragma unroll 1
                    for (int hh = 0; hh < 2; ++hh) { const int h = 2 * F.wave + hh;
                        if (kind == 0) attn_sample_item<4>(F, A, n, 0, 0, h); else attn_sample_item<1>(F, A, n, kind < 5 ? 1 : 2, (kind - 1) & 3, h); } }
            } else {
                for (int pu = F.vcu * 4 + (F.wave - 4); pu < (MP / 16 + 32) * 4; pu += F.G * 4) if ((pu >> 2) >= MP / 16) pool_unit<16>(F, A, pu & 3, pu >> 2);
            }
        } else {
            { KvRegs R; attn_prompt_load(F, F.vcu, F.tid, R);
              for (int u = F.vcu; u < 3072; u += F.G) attn_prompt_unit(F, A, u, u + F.G < 3072 ? u + F.G : -1, R); }
        }
        __syncthreads();
    }
}

template <int PART> __device__ __forceinline__ void p3_combine_pool(Frame& F, const Args& A) {
    const int gw = F.vcu * NWAVES + F.wave, NGW = F.G * NWAVES, lane = F.lane;
    bf16* YAB = (bf16*)(F.ws + WS_YAB); const bf16* OG = (const bf16*)(F.ws + WS_OG); const float* LSE = (const float*)(F.ws + WS_LSE);
    if (PART & 1)
    for (int row0 = gw; row0 < MALL; row0 += 2 * NGW) { const int h = lane >> 3;
        float ls[2][3]; v4u ov[2][3];
#pragma unroll
        for (int r = 0; r < 2; ++r) { const int row = row0 + r * NGW < MALL ? row0 + r * NGW : row0;
#pragma unroll
            for (int g = 0; g < 3; ++g) { ls[r][g] = LSE[((size_t)g * MALL + row) * 8 + h]; ov[r][g] = *(const GAS v4u*)(OG + ((size_t)g * MALL + row) * 512 + lane * 8); } }
#pragma unroll
        for (int r = 0; r < 2; ++r) { const int row = row0 + r * NGW; if (row < MALL) {
            const float mx = __builtin_fmaxf(__builtin_fmaxf(ls[r][0], ls[r][1]), ls[r][2]);
            float wg[3]; float den = 0.f;
#pragma unroll
            for (int g = 0; g < 3; ++g) { wg[g] = __expf(ls[r][g] - mx); den += wg[g]; }
            const float inv = 1.0f / den; float y[8];
#pragma unroll
            for (int k = 0; k < 8; ++k) y[k] = 0.f;
#pragma unroll
            for (int g = 0; g < 3; ++g) { const float ww = wg[g] * inv;
#pragma unroll
                for (int k = 0; k < 4; ++k) { y[2 * k] += ww * bflo(ov[r][g][k]); y[2 * k + 1] += ww * bfhi(ov[r][g][k]); } }
            v4u o; o.x = cvtpk(y[0], y[1]); o.y = cvtpk(y[2], y[3]); o.z = cvtpk(y[4], y[5]); o.w = cvtpk(y[6], y[7]);
            *(GAS v4u*)(YAB + (size_t)row * DM + 512 + lane * 8) = o; } } }
    if (PART & 2) {
        constexpr int TS = 320, TW = 32 * TS  , PWO = 8 * TW, PWS = 272;
        const bf16* Z = (const bf16*)(F.ws + WS_Z); const bf16* PW = (const bf16*)(F.ws + WS_POOLW);
        const int b = blockIdx.x, gi = b & 3, blk = b >> 2, w = 2 << gi, fq = lane >> 4, a = lane & 15, q4 = a >> 2, p4 = a & 3;
        LAS unsigned char* lds = F.lds; LAS unsigned char* tile = lds + F.wave * TW;
        for (int i = F.tid; i < 2048; i += 512) { const int d = i >> 4, ch = i & 15; *(LAS v4u*)(lds + PWO + d * PWS + ch * 16) = *(const GAS v4u*)(PW + ((size_t)(gi * 128 + d)) * 128 + ch * 8); }
        __syncthreads();
        const int slstep = (F.G >> 2) * NWAVES;
        v4u ld[8];
#define POOL_LOAD(sl_) do { const int row0_ = (sl_) * 16, t0_ = row0_ & (SEQ - 1); _Pragma("unroll") for (int i = 0; i < 8; ++i) { const int ri = 4 * i + fq; int dt = t0_ - 15 + ri; dt = dt < 0 ? 0 : dt; \
            ld[i] = *(const GAS v4u*)(Z + (size_t)(row0_ - t0_ + (ri < 31 ? dt : t0_ + 15)) * EVIN + gi * 128 + a * 8); } } while (0)
        { const int sl0 = blk * NWAVES + F.wave; if (sl0 < MP / 16) POOL_LOAD(sl0); }
        for (int sl = blk * NWAVES + F.wave; sl < MP / 16; sl += slstep) {
            const int row0 = sl * 16, t0 = row0 & (SEQ - 1);
#pragma unroll
            for (int i = 0; i < 8; ++i) { const int ri = 4 * i + fq; *(LAS v4u*)(tile + ri * TS + a * 16) = ld[i]; }
            if (sl + slstep < MP / 16) POOL_LOAD(sl + slstep);
            LDS_WAIT(); asm volatile("" ::: "memory");
            const int t = t0 + a; const int jmax = t < w - 1 ? t : w - 1; const float rc = 1.0f / (float)(jmax + 1);
            bf16x8 tf;
            { unsigned tw[4];
#pragma unroll
              for (int e2 = 0; e2 < 4; ++e2) { const int j0 = a + 15 - 8 * fq - 2 * e2, j1 = j0 - 1;
                  const float v0 = (j0 >= 0 && j0 <= jmax) ? (j0 == 0 ? rc - 1.0f : rc) : 0.0f, v1 = (j1 >= 0 && j1 <= jmax) ? (j1 == 0 ? rc - 1.0f : rc) : 0.0f;
                  tw[e2] = cvtpk(v0, v1); }
              v4u tv; tv.x = tw[0]; tv.y = tw[1]; tv.z = tw[2]; tv.w = tw[3]; tf = __builtin_bit_cast(bf16x8, tv); }
            bf16x8 pf[4];
            LAS const unsigned char* tp = tile + (8 * fq + q4) * TS + p4 * 16;
#pragma unroll
            for (int ks = 0; ks < 4; ++ks) {
                const v4i16_t a0 = trread(tp + ks * 64), a1 = trread(tp + 4 * TS + ks * 64), b0 = trread(tp + ks * 64 + 8), b1 = trread(tp + 4 * TS + ks * 64 + 8);
                const bf16x8 fa = (bf16x8){a0[0], a0[1], a0[2], a0[3], a1[0], a1[1], a1[2], a1[3]}, fb = (bf16x8){b0[0], b0[1], b0[2], b0[3], b1[0], b1[1], b1[2], b1[3]};
                const f32x4 z4 = (f32x4){0.f, 0.f, 0.f, 0.f};
                const f32x4 da = mfma16(fa, tf, z4), db = mfma16(fb, tf, z4);
                v4u pw; pw.x = cvtpk(da[0], da[1]); pw.y = cvtpk(da[2], da[3]); pw.z = cvtpk(db[0], db[1]); pw.w = cvtpk(db[2], db[3]);
                pf[ks] = __builtin_bit_cast(bf16x8, pw); }
            const size_t row = (size_t)row0 + a;
#pragma unroll
            for (int nb = 0; nb < 8; nb += 2) { f32x4 d0 = (f32x4){0.f, 0.f, 0.f, 0.f}, d1 = d0;
#pragma unroll
                for (int ks = 0; ks < 4; ++ks) { const bf16x8 w0 = *(LAS const bf16x8*)(lds + PWO + (16 * nb + a) * PWS + (32 * ks + 8 * fq) * 2), w1 = *(LAS const bf16x8*)(lds + PWO + (16 * nb + 16 + a) * PWS + (32 * ks + 8 * fq) * 2);
                    d0 = mfma16(w0, pf[ks], d0); d1 = mfma16(w1, pf[ks], d1); }
                u32x2 oa, ob; oa.x = cvtpk(d0[0], d0[1]); oa.y = cvtpk(d0[2], d0[3]); ob.x = cvtpk(d1[0], d1[1]); ob.y = cvtpk(d1[2], d1[3]);
                *(GAS v4u*)(YAB + row * DM + gi * 128 + 16 * nb + pair16_off(fq)) = pair16(oa, ob); }
            LDS_WAIT(); asm volatile("" ::: "memory");
        }
        __syncthreads();
    }
}

__device__ __forceinline__ void p9_oddmix(Frame& F, const Args& A) {
    const int gw = F.vcu * NWAVES + F.wave, NGW = F.G * NWAVES, lane = F.lane, tid = F.tid, wv = F.wave;
    const bf16* Z = (const bf16*)(F.ws + WS_Z); bf16* YAB = (bf16*)(F.ws + WS_YAB);
    const float* lng = A.in[14]; const float* lnb = A.in[15]; const float* bs = A.in[17]; const float* cw = A.in[18];
    for (int blk8 = gw; blk8 < MP / 8; blk8 += NGW) { const int r0 = blk8 * 8, t0 = r0 & (SEQ - 1), c = lane * 8;
        v4u gi[10], xi[10], go[8];
#pragma unroll
        for (int i = 0; i < 10; ++i) { const int rr = (t0 == 0 && i < 2) ? r0 : r0 - 2 + i; const bf16* zr = Z + (size_t)rr * ODIN; gi[i] = *(const GAS v4u*)(zr + 1536 + c); xi[i] = *(const GAS v4u*)(zr + 2048 + c); }
#pragma unroll
        for (int i = 0; i < 8; ++i) go[i] = *(const GAS v4u*)(Z + (size_t)(r0 + i) * ODIN + 1024 + c);
        float cwv[3][8];
#pragma unroll
        for (int j = 0; j < 3; ++j)
#pragma unroll
            for (int k = 0; k < 8; ++k) cwv[j][k] = cw[j * 512 + c + k];
        float hd[10][8]; const float z01 = t0 == 0 ? 0.f : 1.f;
#pragma unroll
        for (int i = 0; i < 10; ++i) { const float m = i < 2 ? z01 : 1.f;
#pragma unroll
            for (int k = 0; k < 4; ++k) { hd[i][2 * k] = m * bflo(gi[i][k]) * bflo(xi[i][k]); hd[i][2 * k + 1] = m * bfhi(gi[i][k]) * bfhi(xi[i][k]); } }
#pragma unroll
        for (int i = 0; i < 8; ++i) { float y[8];
#pragma unroll
            for (int k = 0; k < 8; ++k) { const float cv = cwv[0][k] * hd[i][k] + cwv[1][k] * hd[i + 1][k] + cwv[2][k] * hd[i + 2][k]; y[k] = ((k & 1) ? bfhi(go[i][k >> 1]) : bflo(go[i][k >> 1])) * cv; }
            v4u o; o.x = cvtpk(y[0], y[1]); o.y = cvtpk(y[2], y[3]); o.z = cvtpk(y[4], y[5]); o.w = cvtpk(y[6], y[7]);
            *(GAS v4u*)(YAB + (size_t)(r0 + i) * DM + 512 + c) = o; }
        if (t0 == SEQ - 8) { float* co = F.out + pg8::O_CONVP + ((size_t)((r0 >> 13) * 2)) * 512 + c;
#pragma unroll
            for (int j = 0; j < 2; ++j) { *(GAS f32x4*)(co + j * 512) = (f32x4){hd[8 + j][0], hd[8 + j][1], hd[8 + j][2], hd[8 + j][3]}; *(GAS f32x4*)(co + j * 512 + 4) = (f32x4){hd[8 + j][4], hd[8 + j][5], hd[8 + j][6], hd[8 + j][7]}; } } }
    for (int row = MP + gw; row < MALL; row += NGW) { const bool samp = row >= MP; const int ms = row - MP; const int t = samp ? (ms & 3) : (row & (SEQ - 1)); const int nb = samp ? (ms >> 2) : (row >> 13);
        const int c = lane * 8; float hd[3][8];
#pragma unroll
        for (int j = 0; j < 3; ++j) { const int dt = 2 - j;
            if (dt <= t) { const bf16* zr = Z + (size_t)(row - dt) * ODIN; const v4u gi = *(const GAS v4u*)(zr + 1536 + c), xi = *(const GAS v4u*)(zr + 2048 + c); const unsigned* pg = (const unsigned*)&gi; const unsigned* px = (const unsigned*)&xi;
#pragma unroll
                for (int k = 0; k < 4; ++k) { hd[j][2 * k] = bflo(pg[k]) * bflo(px[k]); hd[j][2 * k + 1] = bfhi(pg[k]) * bfhi(px[k]); } }
            else if (samp) { const float* sp = A.in[6] + ((size_t)(nb * 2 + (t + 2 - dt))) * 512 + c; const f32x4 s0 = *(const GAS f32x4*)sp, s1 = *(const GAS f32x4*)(sp + 4);
#pragma unroll
                for (int k = 0; k < 4; ++k) { hd[j][k] = s0[k]; hd[j][4 + k] = s1[k]; } }
            else {
#pragma unroll
                for (int k = 0; k < 8; ++k) hd[j][k] = 0.f; } }
        const v4u go = *(const GAS v4u*)(Z + (size_t)row * ODIN + 1024 + c); const unsigned* pgo = (const unsigned*)&go;
        float y[8];
#pragma unroll
        for (int k = 0; k < 8; ++k) { const float cv = cw[c + k] * hd[0][k] + cw[512 + c + k] * hd[1][k] + cw[1024 + c + k] * hd[2][k]; y[k] = ((k & 1) ? bfhi(pgo[k >> 1]) : bflo(pgo[k >> 1])) * cv; }
        v4u o; o.x = cvtpk(y[0], y[1]); o.y = cvtpk(y[2], y[3]); o.z = cvtpk(y[4], y[5]); o.w = cvtpk(y[6], y[7]);
        *(GAS v4u*)(YAB + (size_t)row * DM + 512 + c) = o;
        float* co = nullptr;
        if (samp) { if (t >= 2) co = F.out + pg8::O_CONVS + ((size_t)(nb * 2 + t - 2)) * 512 + c; } else if (t >= SEQ - 2) co = F.out + pg8::O_CONVP + ((size_t)(nb * 2 + t - (SEQ - 2))) * 512 + c;
        if (co) { *(GAS f32x4*)co = (f32x4){hd[2][0], hd[2][1], hd[2][2], hd[2][3]}; *(GAS f32x4*)(co + 4) = (f32x4){hd[2][4], hd[2][5], hd[2][6], hd[2][7]}; } }
    for (int n = gw; n < 128; n += NGW) { const int c = lane * 8, g = lane >> 4; float vn[4][8];
#pragma unroll
        for (int s = 0; s < 4; ++s) { const v4u vv = *(const GAS v4u*)(Z + (size_t)(MP + n * 4 + s) * ODIN + 512 + c); const unsigned* pv = (const unsigned*)&vv; float x[8]; float sm = 0.f;
#pragma unroll
            for (int k = 0; k < 4; ++k) { x[2 * k] = bflo(pv[k]); x[2 * k + 1] = bfhi(pv[k]); sm += x[2 * k] + x[2 * k + 1]; }
            sm += __shfl_xor(sm, 1); sm += __shfl_xor(sm, 2); sm += __shfl_xor(sm, 4); sm += __shfl_xor(sm, 8);
            const float mu = sm * (1.0f / 128.0f); float q = 0.f;
#pragma unroll
            for (int k = 0; k < 8; ++k) { x[k] -= mu; q += x[k] * x[k]; }
            q += __shfl_xor(q, 1); q += __shfl_xor(q, 2); q += __shfl_xor(q, 4); q += __shfl_xor(q, 8);
            const float rstd = __builtin_amdgcn_rsqf(q * (1.0f / 128.0f) + 1e-6f);
#pragma unroll
            for (int k = 0; k < 8; ++k) vn[s][k] = x[k] * rstd * lng[c + k] + lnb[c + k];
            float* cvo = F.out + pg8::O_CVS + ((size_t)(n * 4 + s)) * 512 + c;
            *(GAS f32x4*)cvo = (f32x4){vn[s][0], vn[s][1], vn[s][2], vn[s][3]}; *(GAS f32x4*)(cvo + 4) = (f32x4){vn[s][4], vn[s][5], vn[s][6], vn[s][7]}; }
#pragma unroll
        for (int t = 0; t < 4; ++t) { float sp[8];
#pragma unroll
            for (int k = 0; k < 8; ++k) sp[k] = bs[g * 128 + t];
#pragma unroll
            for (int s = 0; s <= t; ++s) { const float wts = A.in[16][(g * 128 + t) * 128 + s];
#pragma unroll
                for (int k = 0; k < 8; ++k) sp[k] += wts * vn[s][k]; }
            const v4u uu = *(const GAS v4u*)(Z + (size_t)(MP + n * 4 + t) * ODIN + c); const unsigned* pu = (const unsigned*)&uu;
            v4u o; o.x = cvtpk(bflo(pu[0]) * sp[0], bfhi(pu[0]) * sp[1]); o.y = cvtpk(bflo(pu[1]) * sp[2], bfhi(pu[1]) * sp[3]); o.z = cvtpk(bflo(pu[2]) * sp[4], bfhi(pu[2]) * sp[5]); o.w = cvtpk(bflo(pu[3]) * sp[6], bfhi(pu[3]) * sp[7]);
            *(GAS v4u*)(YAB + (size_t)(MP + n * 4 + t) * DM + c) = o; } }
    const bf16* WT = (const bf16*)(F.ws + WS_WST);
    LAS unsigned char* lds = F.lds; const int fq = lane >> 4, a = lane & 15, q4 = a >> 2, p4 = a & 3;
    for (int un = F.vcu; un < 512; un += F.G) { const int g = un & 3, ck = un >> 2; const int row0 = ck * 128;
        { const int rn = tid >> 2, c0 = (tid & 3) * 32; const bf16* zr = Z + (size_t)(row0 + rn) * ODIN + 512 + g * 128 + c0; float x[32]; float sm = 0.f;
#pragma unroll
          for (int k4 = 0; k4 < 4; ++k4) { const v4u vv = *(const GAS v4u*)(zr + 8 * k4); const unsigned* pv = (const unsigned*)&vv;
#pragma unroll
              for (int k = 0; k < 4; ++k) { x[8 * k4 + 2 * k] = bflo(pv[k]); x[8 * k4 + 2 * k + 1] = bfhi(pv[k]); sm += x[8 * k4 + 2 * k] + x[8 * k4 + 2 * k + 1]; } }
          sm += __shfl_xor(sm, 1); sm += __shfl_xor(sm, 2); const float mu = sm * (1.0f / 128.0f); float q = 0.f;
#pragma unroll
          for (int k = 0; k < 32; ++k) { x[k] -= mu; q += x[k] * x[k]; }
          q += __shfl_xor(q, 1); q += __shfl_xor(q, 2); const float rstd = __builtin_amdgcn_rsqf(q * (1.0f / 128.0f) + 1e-6f);
          const float* gp = lng + g * 128 + c0; const float* bp = lnb + g * 128 + c0;
#pragma unroll
          for (int k4 = 0; k4 < 4; ++k4) { v4u o; unsigned* po = (unsigned*)&o;
#pragma unroll
              for (int k = 0; k < 4; ++k) po[k] = cvtpk(x[8 * k4 + 2 * k] * rstd * gp[8 * k4 + 2 * k] + bp[8 * k4 + 2 * k], x[8 * k4 + 2 * k + 1] * rstd * gp[8 * k4 + 2 * k + 1] + bp[8 * k4 + 2 * k + 1]);
              *(LAS v4u*)(lds + rn * VNS + (c0 + 8 * k4) * 2) = o; } }
        __syncthreads();
        const int t = 16 * wv + a; const int nks = (wv >> 1) + 1;
        f32x4 D[8];
#pragma unroll
        for (int cb = 0; cb < 8; ++cb) D[cb] = (f32x4){0.f, 0.f, 0.f, 0.f};
        for (int ks = 0; ks < nks; ++ks) { const bf16x8 wf = *(const GAS bf16x8*)(WT + ((size_t)(g * 128 + t)) * 128 + 32 * ks + 8 * fq);
            LAS const unsigned char* vp = lds + (32 * ks + 8 * fq + q4) * VNS + p4 * 8;
#pragma unroll
            for (int cb = 0; cb < 8; ++cb) { const v4i16_t t0 = trread(vp + cb * 32), t1 = trread(vp + 4 * VNS + cb * 32);
                const bf16x8 vf = (bf16x8){t0[0], t0[1], t0[2], t0[3], t1[0], t1[1], t1[2], t1[3]};
                D[cb] = mfma16(vf, wf, D[cb]); } }
        const float bt = bs[g * 128 + t]; const size_t row = (size_t)row0 + t;
#pragma unroll
        for (int cb = 0; cb < 8; cb += 2) { const int c = g * 128 + 16 * cb + pair16_off(fq);
            float lo[4], hi[4];
#pragma unroll
            for (int j = 0; j < 4; ++j) { const auto r = __builtin_amdgcn_permlane16_swap(__builtin_bit_cast(unsigned, D[cb][j] + bt), __builtin_bit_cast(unsigned, D[cb + 1][j] + bt), false, false);
                lo[j] = __builtin_bit_cast(float, (unsigned)r[0]); hi[j] = __builtin_bit_cast(float, (unsigned)r[1]); }
            const v4u uu = *(const GAS v4u*)(Z + row * ODIN + c);
            v4u o; o.x = cvtpk(bflo(uu.x) * lo[0], bfhi(uu.x) * lo[1]); o.y = cvtpk(bflo(uu.y) * lo[2], bfhi(uu.y) * lo[3]); o.z = cvtpk(bflo(uu.z) * hi[0], bfhi(uu.z) * hi[1]); o.w = cvtpk(bflo(uu.w) * hi[2], bfhi(uu.w) * hi[3]);
            *(GAS v4u*)(YAB + row * DM + c) = o; }
        __syncthreads(); }
}

__device__ __forceinline__ void p_final(Frame& F, const Args& A, const float* SS) {
    const int gw = F.vcu * NWAVES + F.wave, NGW = F.G * NWAVES;
    const bf16* RB = (const bf16*)(F.ws + WS_RB); const float* gf = A.in[27];
    const GAS f32x4* gg = (const GAS f32x4*)gf + F.lane; f32x4 g4[4];
#pragma unroll
    for (int j = 0; j < 4; ++j) g4[j] = gg[64 * j];
    for (int m0 = gw; m0 < MALL; m0 += 2 * NGW) { u32x2 w[2][4]; float rs[2];
#pragma unroll
        for (int r = 0; r < 2; ++r) { const int m = m0 + r * NGW < MALL ? m0 + r * NGW : m0; rs[r] = pg8::row_rs(SS, m); const GAS u32x2* xr = (const GAS u32x2*)(RB + (size_t)m * DM) + F.lane;
#pragma unroll
            for (int j = 0; j < 4; ++j) w[r][j] = __builtin_nontemporal_load(xr + 64 * j); }
#pragma unroll
        for (int r = 0; r < 2; ++r) { const int m = m0 + r * NGW; if (m < MALL) { GAS f32x4* o = (GAS f32x4*)(F.out + (size_t)m * DM) + F.lane;
#pragma unroll
            for (int j = 0; j < 4; ++j) __builtin_nontemporal_store((f32x4){bflo(w[r][j].x) * g4[j][0], bfhi(w[r][j].x) * g4[j][1], bflo(w[r][j].y) * g4[j][2], bfhi(w[r][j].y) * g4[j][3]} * rs[r], o + 64 * j); } } }
}

constexpr int N_PHASES = 15;
__global__ void __launch_bounds__(NWAVES * 64, 2) mk_fwd(Args args) {
    extern __shared__ __attribute__((aligned(16))) unsigned char lds[];
    Frame F;
    F.lds = (LAS unsigned char*)lds; F.MISC = (volatile LAS unsigned*)(F.lds + MISC_OFF);
    F.tid = threadIdx.x; F.lane = F.tid & 63; F.wave = __builtin_amdgcn_readfirstlane(F.tid >> 6);
    F.G = gridDim.x; { const int bx = blockIdx.x; F.vcu = (F.G % 8 == 0) ? (bx % 8) * (F.G / 8) + bx / 8 : bx; }
    F.out = args.out; F.ws = args.ws; F.ctl = (gu32*)(args.ws + WS_CTL);
    for (int u = F.tid; u < (LDS_BYTES - LDSCTL_OFF) / 4; u += NWAVES * 64) ((LAS unsigned*)(F.lds + LDSCTL_OFF))[u] = 0u;
    __syncthreads();
    const int lo = args.ph_lo, hi = args.ph_hi;
    XcdBarrier bar; bar.bar = (unsigned*)(F.ctl + CW_BAR); bar.x = 0; bar.st = nullptr;
    if (hi - lo > 1) bar = xcd_barrier_post((unsigned*)(F.ctl + CW_BAR), F.MISC + 8);
#define IN(k) (lo <= (k) && (k) < hi)
#define SEAM(k) do { if (IN(k) && IN((k) + 1)) xcd_barrier(bar); } while (0)
#define RSTAB ((LAS float*)(F.lds + LDSCTL_OFF + 1024))
#define SSTAB ((LAS float*)(F.lds + LDSCTL_OFF + 6144))
#define SITE_PTRS unsigned char* ws = args.ws; asm volatile("" : "+s"(ws)); bf16* RBb = (bf16*)(ws + WS_RB); float* SSb = (float*)(ws + WS_SS); (void)RBb; (void)SSb;
    constexpr size_t RBN = (size_t)MALL * DM, SSN = (size_t)MALL * 16;
    const int cid = (int)blockIdx.x;
    const int stag = (cid >> 3) & 1;

    if (IN(0)) { SITE_PTRS relaunder(F); p0_prologue(F, args); } SEAM(0);

            if (IN(1)) { SITE_PTRS
                pg8::Gemm g{RBb, (const bf16*)(ws + WS_WEVIN), MP, EVIN, DM}; pg8::StaticOrder S; S.init(MP, EVIN, F.G, cid);
                pg8::EpiEvIn E{(bf16*)(ws + WS_Z), SSb, (const float*)(ws + WS_ROPE), F.out, RSTAB};
                _Pragma("unroll 1") for (int st_ = 0; st_ < 2; ++st_) { if ((st_ ^ stag) == 0) sample_gemm(F.lds, E, g.A, g.Bt, g.N, g.K);
                else pg8::gemm_phase<pg8::EpiEvIn, pg8::StaticOrder, true, true>(F.lds, g, S, E); }
            } SEAM(1);
            if (IN(2)) { SITE_PTRS relaunder(F); p2_attention(F, args); relaunder(F); p3_combine_pool<2>(F, args);
                if (F.G == 256) {
                    pg8::Gemm g2{(const bf16*)(ws + WS_PB), (const bf16*)(ws + WS_WP), MP, DM, 256}; pg8::StaticOrder S2; S2.init(MP, DM, 128, F.vcu >= 128 ? F.vcu - 128 : 256);
                    pg8::EpiPlain E2{(bf16*)(ws + WS_PROJ), DM, nullptr, nullptr};
                    pg8::gemm_phase<pg8::EpiPlain, pg8::StaticOrder, true, true>(F.lds, g2, S2, E2); }
            } SEAM(2);
            if (IN(3)) { SITE_PTRS relaunder(F); p3_combine_pool<1>(F, args); } SEAM(3);
        if (IN(4)) { SITE_PTRS
            pg8::Gemm g{(const bf16*)(ws + WS_YAB), (const bf16*)(ws + WS_WEVOUT), MP, DM, DM}; pg8::StaticOrder S; S.init(MP, DM, F.G, cid);
            pg8::EpiResid<true> E{RBb, nullptr, RBb + (RBN), SSb + (SSN), nullptr, nullptr, SSTAB};
            _Pragma("unroll 1") for (int st_ = 0; st_ < 2; ++st_) { if ((st_ ^ stag) == 0) sample_gemm(F.lds, E, g.A, g.Bt, g.N, g.K);
            else pg8::gemm_phase<pg8::EpiResid<true>, pg8::StaticOrder, true, true>(F.lds, g, S, E); }
        } SEAM(4);
        if (IN(4 + 1)) { SITE_PTRS
            { pg8::Gemm g{RBb + (RBN), (const bf16*)(ws + WS_W1) + (size_t)0 * 1024 * FFD, MP, FFD, DM}; pg8::StaticOrder S; S.init(MP, FFD, F.G, cid);
              pg8::EpiScaled<0> E{(bf16*)(ws + WS_F), FFD, SSb + (SSN), RSTAB};
              _Pragma("unroll 1") for (int st_ = 0; st_ < 2; ++st_) { if ((st_ ^ stag) == 0) sample_gemm(F.lds, E, g.A, g.Bt, g.N, g.K);
              else pg8::gemm_phase<pg8::EpiScaled<0>, pg8::StaticOrder, true, true>(F.lds, g, S, E); } }
        }
        if (IN(4 + 1)) { SITE_PTRS
            { pg8::Gemm g{(const bf16*)(ws + WS_PB) + (size_t)0 * MALL * 256, (const bf16*)(ws + WS_WP) + (size_t)0 * 256 * 1024, MP, DM, 256}; pg8::StaticOrder S; S.init(MP, DM, F.G, cid);
              pg8::EpiPlain E{(bf16*)(ws + WS_PROJ), DM, nullptr, nullptr};
              sample_gemm(F.lds, E, g.A, g.Bt, g.N, g.K);
              if (F.G != 256) pg8::gemm_phase<pg8::EpiPlain, pg8::StaticOrder, true, true>(F.lds, g, S, E); }
        } SEAM(4 + 1);
        if (IN(4 + 2)) { SITE_PTRS
            pg8::Gemm g{(const bf16*)(ws + WS_F), (const bf16*)(ws + WS_W2) + (size_t)0 * 1024 * FFD, MP, DM, FFD}; pg8::StaticOrder S; S.init(MP, DM, F.G, cid);
            pg8::EpiResid<true> E{RBb + RBN, nullptr, RBb + (0), SSb + (0), nullptr, nullptr, SSTAB};
            _Pragma("unroll 1") for (int st_ = 0; st_ < 2; ++st_) { if ((st_ ^ stag) == 0) sample_gemm(F.lds, E, g.A, g.Bt, g.N, g.K);
            else pg8::gemm_phase<pg8::EpiResid<true>, pg8::StaticOrder, true, true>(F.lds, g, S, E); }
        } SEAM(4 + 2);
        if (IN(4 + 3)) { SITE_PTRS
            pg8::Gemm g{RBb + (0), (const bf16*)(ws + WS_WG) + (size_t)0 * 1024 * 1024, MP, DM, DM}; pg8::StaticOrder S; S.init(MP, DM, F.G, cid);
            pg8::EpiPle E{SSb + (0), (const bf16*)(ws + WS_PROJ), RBb + (0), RBb + (RBN), SSb + (SSN), RSTAB, SSTAB};
            _Pragma("unroll 1") for (int st_ = 0; st_ < 2; ++st_) { if ((st_ ^ stag) == 0) sample_gemm(F.lds, E, g.A, g.Bt, g.N, g.K);
            else pg8::gemm_phase<pg8::EpiPle, pg8::StaticOrder, true, true>(F.lds, g, S, E); }
        } SEAM(4 + 3);
            if (IN(8)) { SITE_PTRS
                pg8::Gemm g{RBb + RBN, (const bf16*)(ws + WS_WODIN), MP, ODIN, DM}; pg8::StaticOrder S; S.init(MP, ODIN, F.G, cid);
                pg8::EpiScaled<1> E{(bf16*)(ws + WS_Z), ODIN, SSb + SSN, RSTAB};
                _Pragma("unroll 1") for (int st_ = 0; st_ < 2; ++st_) { if ((st_ ^ stag) == 0) sample_gemm(F.lds, E, g.A, g.Bt, g.N, g.K);
                else pg8::gemm_phase<pg8::EpiScaled<1>, pg8::StaticOrder, true, true>(F.lds, g, S, E); }
                if (F.G == 256) {
                    pg8::Gemm g2{(const bf16*)(ws + WS_PB) + (size_t)1 * MALL * 256, (const bf16*)(ws + WS_WP) + (size_t)1 * 256 * 1024, MP, DM, 256}; pg8::StaticOrder S2; S2.init(MP, DM, 128, cid >= 128 ? cid - 128 : 256);
                    pg8::EpiPlain E2{(bf16*)(ws + WS_PROJ), DM, nullptr, nullptr};
                    pg8::gemm_phase<pg8::EpiPlain, pg8::StaticOrder, true, true>(F.lds, g2, S2, E2); }
            } SEAM(8);
            if (IN(9)) { SITE_PTRS relaunder(F); p9_oddmix(F, args); } SEAM(9);
        if (IN(10)) { SITE_PTRS
            pg8::Gemm g{(const bf16*)(ws + WS_YAB), (const bf16*)(ws + WS_WODOUT), MP, DM, DM}; pg8::StaticOrder S; S.init(MP, DM, F.G, cid);
            pg8::EpiResid<true> E{RBb + RBN, nullptr, RBb + (0), SSb + (0), nullptr, nullptr, SSTAB};
            _Pragma("unroll 1") for (int st_ = 0; st_ < 2; ++st_) { if ((st_ ^ stag) == 0) sample_gemm(F.lds, E, g.A, g.Bt, g.N, g.K);
            else pg8::gemm_phase<pg8::EpiResid<true>, pg8::StaticOrder, true, true>(F.lds, g, S, E); }
        } SEAM(10);
        if (IN(10 + 1)) { SITE_PTRS
            { pg8::Gemm g{RBb + (0), (const bf16*)(ws + WS_W1) + (size_t)1 * 1024 * FFD, MP, FFD, DM}; pg8::StaticOrder S; S.init(MP, FFD, F.G, cid);
              pg8::EpiScaled<0> E{(bf16*)(ws + WS_F), FFD, SSb + (0), RSTAB};
              _Pragma("unroll 1") for (int st_ = 0; st_ < 2; ++st_) { if ((st_ ^ stag) == 0) sample_gemm(F.lds, E, g.A, g.Bt, g.N, g.K);
              else pg8::gemm_phase<pg8::EpiScaled<0>, pg8::StaticOrder, true, true>(F.lds, g, S, E); } }
        }
        if (IN(10 + 1)) { SITE_PTRS
            { pg8::Gemm g{(const bf16*)(ws + WS_PB) + (size_t)1 * MALL * 256, (const bf16*)(ws + WS_WP) + (size_t)1 * 256 * 1024, MP, DM, 256}; pg8::StaticOrder S; S.init(MP, DM, F.G, cid);
              pg8::EpiPlain E{(bf16*)(ws + WS_PROJ), DM, nullptr, nullptr};
              sample_gemm(F.lds, E, g.A, g.Bt, g.N, g.K);
              if (F.G != 256) pg8::gemm_phase<pg8::EpiPlain, pg8::StaticOrder, true, true>(F.lds, g, S, E); }
        } SEAM(10 + 1);
        if (IN(10 + 2)) { SITE_PTRS
            pg8::Gemm g{(const bf16*)(ws + WS_F), (const bf16*)(ws + WS_W2) + (size_t)1 * 1024 * FFD, MP, DM, FFD}; pg8::StaticOrder S; S.init(MP, DM, F.G, cid);
            pg8::EpiResid<true> E{RBb, nullptr, RBb + (RBN), SSb + (SSN), nullptr, nullptr, SSTAB};
            _Pragma("unroll 1") for (int st_ = 0; st_ < 2; ++st_) { if ((st_ ^ stag) == 0) sample_gemm(F.lds, E, g.A, g.Bt, g.N, g.K);
            else pg8::gemm_phase<pg8::EpiResid<true>, pg8::StaticOrder, true, true>(F.lds, g, S, E); }
        } SEAM(10 + 2);
        if (IN(10 + 3)) { SITE_PTRS
            pg8::Gemm g{RBb + (RBN), (const bf16*)(ws + WS_WG) + (size_t)1 * 1024 * 1024, MP, DM, DM}; pg8::StaticOrder S; S.init(MP, DM, F.G, cid);
            pg8::EpiPle E{SSb + (SSN), (const bf16*)(ws + WS_PROJ), RBb + (RBN), RBb + (0), SSb + (0), RSTAB, SSTAB};
            _Pragma("unroll 1") for (int st_ = 0; st_ < 2; ++st_) { if ((st_ ^ stag) == 0) sample_gemm(F.lds, E, g.A, g.Bt, g.N, g.K);
            else pg8::gemm_phase<pg8::EpiPle, pg8::StaticOrder, true, true>(F.lds, g, S, E); }
        } SEAM(10 + 3);
    if (IN(14)) { SITE_PTRS relaunder(F); p_final(F, args, SSb); }
#undef IN
#undef SEAM
}

extern "C" void kernel_launch(void* const* d_in, const int* in_sizes, int n_in, void* d_out, int out_size, void* d_ws, size_t ws_size, hipStream_t stream) {
    static int grid = 0;
    if (grid == 0) {
        if (n_in != 28 || out_size != (int)pg8::O_END || ws_size < WS_END) { fprintf(stderr, "kernel_launch: unexpected shapes n_in %d out %d ws %zu\n", n_in, out_size, ws_size); grid = -1; return; }
        int dev = 0, cus = 0, per_cu = 0;
        if (hipGetDevice(&dev) != hipSuccess || hipDeviceGetAttribute(&cus, hipDeviceAttributeMultiprocessorCount, dev) != hipSuccess) { grid = -1; return; }
        if (hipFuncSetAttribute((const void*)mk_fwd, hipFuncAttributeMaxDynamicSharedMemorySize, LDS_BYTES) != hipSuccess) { fprintf(stderr, "kernel_launch: hipFuncSetAttribute failed\n"); grid = -1; return; }
        if (hipOccupancyMaxActiveBlocksPerMultiprocessor(&per_cu, (const void*)mk_fwd, NWAVES * 64, LDS_BYTES) != hipSuccess || per_cu < 1) fprintf(stderr, "kernel_launch: occupancy query says %d\n", per_cu);
        (void)hipGetLastError();
        grid = cus;
    }
    if (grid < 0) return;
    (void)in_sizes;
    if (hipMemsetAsync((char*)d_ws + WS_CTL, 0, CTL_ZERO_BYTES, stream) != hipSuccess) return;
    Args a{};
    for (int i = 0; i < 28; ++i) a.in[i] = (const float*)d_in[i];
    a.out = (float*)d_out; a.ws = (unsigned char*)d_ws;
    a.ph_lo = 0; a.ph_hi = N_PHASES;
    hipLaunchKernelGGL(mk_fwd, dim3(grid), dim3(NWAVES * 64), LDS_BYTES, stream, a);
}
```
